# Optimizing an MI355X kernel written in HIP

```python
import math
import functools
import jax
import jax.numpy as jnp
from jax import lax
import numpy as np

D_MODEL = 1024
BATCH = 16
SEQ = 2048
DEPTH = 2
DEC_BATCH = 128
DEC_SEQ = 1
PAST_LEN = 8192
PAGE_SIZE = 128

N_META = 16
N_A_LAYERS = DEPTH // 2
N_B_LAYERS = DEPTH - N_A_LAYERS
NORM_EPS = 1e-6

GDN_HEADS = 8
GDN_DK = 128
GDN_DV = 128
GDN_CONV = 4
GDN_CHUNK = 64
GDN_KEY = GDN_HEADS * GDN_DK
GDN_VAL = GDN_HEADS * GDN_DV
GDN_QKV = 2 * GDN_KEY + GDN_VAL
GDN_IN = GDN_QKV + GDN_VAL + 2 * GDN_HEADS

MLA_HEADS = 8
MLA_Q_LORA = 384
MLA_KV_LORA = 256
MLA_NOPE = 128
MLA_ROPE = 64
MLA_V = 128
MLA_SCALE = 1.0 / math.sqrt(MLA_NOPE + MLA_ROPE)
ROPE_THETA = 10000.0
Q_BLOCK = 128

D_FF = 2816
FFN_CONV = 3

kernel_name = 'yoco_gdn_mla_convffn_step'


def rmsnorm(x, w):
    xf = x.astype(jnp.float32)
    y = xf * lax.rsqrt(jnp.mean(xf * xf, axis=-1, keepdims=True) + NORM_EPS)
    return (y * w.astype(jnp.float32)).astype(x.dtype)


def l2norm(x):
    xf = x.astype(jnp.float32)
    return xf * lax.rsqrt(jnp.sum(xf * xf, axis=-1, keepdims=True) + NORM_EPS)


def rope(x, positions):
    half = x.shape[-1] // 2
    inv = ROPE_THETA ** (-jnp.arange(half, dtype=jnp.float32) / half)
    ang = positions.astype(jnp.float32)[:, None] * inv[None, :]
    cos = jnp.cos(ang)[None, :, None, :]
    sin = jnp.sin(ang)[None, :, None, :]
    x1 = x[..., :half].astype(jnp.float32)
    x2 = x[..., half:].astype(jnp.float32)
    return jnp.concatenate([x1 * cos - x2 * sin, x2 * cos + x1 * sin], axis=-1).astype(x.dtype)


def causal_dwconv(x, prev, w):
    width = w.shape[0]
    L = x.shape[1]
    xp = jnp.concatenate([prev.astype(x.dtype), x], axis=1)
    out = sum(xp[:, j:j + L] * w[j] for j in range(width))
    return out, xp[:, L:]


def gated_delta_chunked(q, k, v, g, beta, S0, chunk):
    f32 = jnp.float32
    B, L, H, DK = q.shape
    DV = v.shape[-1]
    n = L // chunk

    def blocks(t):
        t = t.astype(f32).reshape((B, n, chunk, H) + t.shape[3:])
        return jnp.moveaxis(t, (1, 3), (0, 2))

    qc = blocks(q) * (DK ** -0.5)
    kc = blocks(k)
    vc = blocks(v)
    bc = blocks(beta)
    gc = jnp.cumsum(blocks(g), axis=-1)
    idx = jnp.arange(chunk)
    causal = idx[:, None] >= idx[None, :]
    decay = jnp.exp(jnp.where(causal, gc[..., :, None] - gc[..., None, :], -jnp.inf))
    kb = kc * bc[..., None]
    strict = jnp.where(idx[:, None] > idx[None, :],
                       jnp.einsum('nbhcd,nbhed->nbhce', kb, kc) * decay, 0.0)
    rhs = jnp.concatenate([vc * bc[..., None], kb * jnp.exp(gc)[..., None]], axis=-1)
    uw = lax.linalg.triangular_solve(strict, rhs, left_side=True, lower=True, unit_diagonal=True)
    u, w = uw[..., :DV], uw[..., DV:]
    attn = jnp.einsum('nbhcd,nbhed->nbhce', qc, kc) * decay
    g_last = gc[..., -1]
    q_dec = qc * jnp.exp(gc)[..., None]
    k_tail = kc * jnp.exp(g_last[..., None] - gc)[..., None]

    def step(S, xs):
        attn_n, u_n, w_n, q_n, k_n, gl_n = xs
        v_new = u_n - jnp.einsum('bhcd,bhdv->bhcv', w_n, S)
        o_n = jnp.einsum('bhcd,bhdv->bhcv', q_n, S) + jnp.einsum('bhce,bhev->bhcv', attn_n, v_new)
        S = S * jnp.exp(gl_n)[..., None, None] + jnp.einsum('bhcd,bhcv->bhdv', k_n, v_new)
        return S, o_n

    S, o = lax.scan(step, S0.astype(f32), (attn, u, w, q_dec, k_tail, g_last))
    return jnp.moveaxis(o, (0, 2), (1, 3)).reshape(B, L, H, DV), S


def gated_delta_mixer(h, conv_prev, S0, segments, w_in, conv_w, a_log, dt_bias, out_norm, w_out):
    B, L, _ = h.shape
    proj = h @ w_in
    qkv, z, a, b = jnp.split(proj, [GDN_QKV, GDN_QKV + GDN_VAL, GDN_QKV + GDN_VAL + GDN_HEADS], axis=-1)
    qkv, conv_new = causal_dwconv(qkv, conv_prev, conv_w)
    qkv = jax.nn.silu(qkv)
    q, k, v = jnp.split(qkv, [GDN_KEY, 2 * GDN_KEY], axis=-1)
    q = l2norm(q.reshape(B, L, GDN_HEADS, GDN_DK))
    k = l2norm(k.reshape(B, L, GDN_HEADS, GDN_DK))
    v = v.reshape(B, L, GDN_HEADS, GDN_DV)
    beta = jax.nn.sigmoid(b.astype(jnp.float32))
    g = -jnp.exp(a_log.astype(jnp.float32)) * jax.nn.softplus(a.astype(jnp.float32) + dt_bias.astype(jnp.float32))
    S = S0
    outs = []
    for start, stop, chunk in segments:
        o_seg, S = gated_delta_chunked(q[:, start:stop], k[:, start:stop], v[:, start:stop],
                                       g[:, start:stop], beta[:, start:stop], S, chunk)
        outs.append(o_seg)
    o = jnp.concatenate(outs, axis=1)
    o = rmsnorm(o, out_norm) * jax.nn.silu(z.reshape(B, L, GDN_HEADS, GDN_DV).astype(jnp.float32))
    return o.reshape(B, L, GDN_VAL).astype(h.dtype) @ w_out, conv_new, S.astype(S0.dtype)


def mla_shared_kv(x, positions, kv_norm, kv_w_a, kv_a_norm):
    ckv = rmsnorm(x, kv_norm) @ kv_w_a
    c = rmsnorm(ckv[..., :MLA_KV_LORA], kv_a_norm)
    k_rope = rope(ckv[..., None, MLA_KV_LORA:], positions)[..., 0, :]
    return c, k_rope


def latent_scores(q_lat, q_pe, c, k_rope):
    s = jnp.einsum('bqhr,bkr->bhqk', q_lat, c) + jnp.einsum('bqhd,bkd->bhqk', q_pe, k_rope)
    return s.astype(jnp.float32) * MLA_SCALE


def masked_latent_attention(q_lat, q_pe, q_pos, c, k_rope, k_pos):
    s = latent_scores(q_lat, q_pe, c, k_rope)
    s = jnp.where(k_pos[None, None, None, :] <= q_pos[None, None, :, None], s, -jnp.inf)
    prob = jax.nn.softmax(s, axis=-1).astype(c.dtype)
    return jnp.einsum('bhqk,bkr->bqhr', prob, c)


def prompt_attend(q_lat, q_pe, c, k_rope):
    B, L, H, R = q_lat.shape
    pos = jnp.arange(L, dtype=jnp.int32)
    o_meta = masked_latent_attention(q_lat[:, :N_META], q_pe[:, :N_META], pos[:N_META],
                                     c[:, :N_META], k_rope[:, :N_META], pos[:N_META])
    nb = (L - N_META) // Q_BLOCK

    def blocks(t):
        return jnp.moveaxis(t[:, N_META:].reshape((B, nb, Q_BLOCK) + t.shape[2:]), 1, 0)

    o_real = lax.map(lambda a: masked_latent_attention(a[0], a[1], a[2], c, k_rope, pos),
                     (blocks(q_lat), blocks(q_pe), pos[N_META:].reshape(nb, Q_BLOCK)))
    o_real = jnp.moveaxis(o_real, 0, 1).reshape(B, L - N_META, H, R)
    return jnp.concatenate([o_meta, o_real], axis=1)


def sample_attend(q_lat, q_pe, c, k_rope, c_past, k_past):
    T = q_lat.shape[1]
    P = c_past.shape[1]
    s_past = latent_scores(q_lat, q_pe, c_past, k_past)
    idx = jnp.arange(T)
    s_new = jnp.where(idx[None, None, None, :] <= idx[None, None, :, None],
                      latent_scores(q_lat, q_pe, c, k_rope), -jnp.inf)
    prob = jax.nn.softmax(jnp.concatenate([s_past, s_new], axis=-1), axis=-1).astype(c.dtype)
    return (jnp.einsum('bhqk,bkr->bqhr', prob[..., :P], c_past)
            + jnp.einsum('bhqk,bkr->bqhr', prob[..., P:], c))


def mla_mixer(h, positions, c, k_rope, attend, w_q_a, q_a_norm, w_q_b, w_uk, w_uv, w_out):
    B, L, _ = h.shape
    q = (rmsnorm(h @ w_q_a, q_a_norm) @ w_q_b).reshape(B, L, MLA_HEADS, MLA_NOPE + MLA_ROPE)
    q_pe = rope(q[..., MLA_NOPE:], positions)
    q_lat = jnp.einsum('blhn,rhn->blhr', q[..., :MLA_NOPE], w_uk)
    o_lat = attend(q_lat, q_pe, c, k_rope)
    o = jnp.einsum('blhr,rhv->blhv', o_lat, w_uv).reshape(B, L, MLA_HEADS * MLA_V)
    return o @ w_out


def conv_ffn(h, prev, w_up, conv_w, conv_b, w_down):
    u, new_prev = causal_dwconv(h @ w_up, prev, conv_w)
    gate, val = jnp.split(u + conv_b, 2, axis=-1)
    return (jax.nn.silu(gate) * val) @ w_down, new_prev


def trunk(x, positions, segments, delta_S0, delta_conv0, ffn_conv0, attend, p):
    new_S, new_dconv, new_fconv = [], [], []
    c_kv, k_rope = None, None
    for layer in range(DEPTH):
        if layer < N_A_LAYERS:
            i = layer
            o, dconv, S = gated_delta_mixer(rmsnorm(x, p['a_norm_pre'][i]), delta_conv0[i], delta_S0[i], segments,
                                            p['a_w_in'][i], p['a_conv_w'][i], p['a_log'][i], p['a_dt_bias'][i],
                                            p['a_out_norm'][i], p['a_w_out'][i])
            x = x + rmsnorm(o, p['a_norm_post'][i])
            new_S.append(S)
            new_dconv.append(dconv)
        else:
            j = layer - N_A_LAYERS
            if j == 0:
                c_kv, k_rope = mla_shared_kv(x, positions, p['kv_norm'], p['kv_w_a'], p['kv_a_norm'])
            o = mla_mixer(rmsnorm(x, p['b_norm_pre'][j]), positions, c_kv, k_rope, attend,
                          p['b_w_q_a'][j], p['b_q_a_norm'][j], p['b_w_q_b'][j],
                          p['kv_w_uk'], p['kv_w_uv'], p['b_w_out'][j])
            x = x + rmsnorm(o, p['b_norm_post'][j])
        o, fconv = conv_ffn(rmsnorm(x, p['f_norm_pre'][layer]), ffn_conv0[layer],
                            p['f_w_up'][layer], p['f_conv_w'][layer], p['f_conv_b'][layer], p['f_w_down'][layer])
        x = x + rmsnorm(o, p['f_norm_post'][layer])
        new_fconv.append(fconv)
    return x, jnp.stack(new_S), jnp.stack(new_dconv), jnp.stack(new_fconv), c_kv, k_rope


def setup_inputs(seed: int = 0) -> dict:
    key = jax.random.key(seed)
    keys = iter(jax.random.split(key, 48))
    f32 = jnp.float32
    n_pages = PAST_LEN // PAGE_SIZE
    n_pool = (DEC_BATCH * n_pages * 5) // 4

    def normal(shape, scale=1.0):
        return jax.random.normal(next(keys), shape, f32) * scale

    def gain(shape):
        return 1.0 + normal(shape, 0.02)

    perm = jax.random.permutation(next(keys), n_pool)
    dt = jnp.exp(jax.random.uniform(next(keys), (N_A_LAYERS, GDN_HEADS), f32, math.log(1e-3), math.log(1e-1)))
    a_log = jnp.log(jax.random.uniform(next(keys), (N_A_LAYERS, GDN_HEADS), f32, 1.0, 16.0))
    return {
        'x_prompt': normal((BATCH, SEQ, D_MODEL)),
        'x_sample': normal((DEC_BATCH, DEC_SEQ, D_MODEL)),
        'state_delta_S': normal((N_A_LAYERS, DEC_BATCH, GDN_HEADS, GDN_DK, GDN_DV), 0.1),
        'state_delta_conv': normal((N_A_LAYERS, DEC_BATCH, GDN_CONV - 1, GDN_QKV)),
        'state_ffn_conv': normal((DEPTH, DEC_BATCH, FFN_CONV - 1, 2 * D_FF)),
        'cache_kv_latent': normal((n_pool, PAGE_SIZE, MLA_KV_LORA)),
        'cache_k_rope': normal((n_pool, PAGE_SIZE, MLA_ROPE)),
        'page_table': perm[:DEC_BATCH * n_pages].reshape(DEC_BATCH, n_pages).astype(jnp.int32),
        'meta_tokens': normal((N_META, D_MODEL)),
        'a_norm_pre': gain((N_A_LAYERS, D_MODEL)),
        'a_norm_post': gain((N_A_LAYERS, D_MODEL)),
        'a_w_in': normal((N_A_LAYERS, D_MODEL, GDN_IN), D_MODEL ** -0.5),
        'a_conv_w': normal((N_A_LAYERS, GDN_CONV, GDN_QKV), GDN_CONV ** -0.5),
        'a_log': a_log,
        'a_dt_bias': dt + jnp.log(-jnp.expm1(-dt)),
        'a_out_norm': gain((N_A_LAYERS, GDN_DV)),
        'a_w_out': normal((N_A_LAYERS, GDN_VAL, D_MODEL), GDN_VAL ** -0.5),
        'kv_norm': gain((D_MODEL,)),
        'kv_w_a': normal((D_MODEL, MLA_KV_LORA + MLA_ROPE), D_MODEL ** -0.5),
        'kv_a_norm': gain((MLA_KV_LORA,)),
        'kv_w_uk': normal((MLA_KV_LORA, MLA_HEADS, MLA_NOPE), MLA_KV_LORA ** -0.5),
        'kv_w_uv': normal((MLA_KV_LORA, MLA_HEADS, MLA_V), MLA_KV_LORA ** -0.5),
        'b_norm_pre': gain((N_B_LAYERS, D_MODEL)),
        'b_norm_post': gain((N_B_LAYERS, D_MODEL)),
        'b_w_q_a': normal((N_B_LAYERS, D_MODEL, MLA_Q_LORA), D_MODEL ** -0.5),
        'b_q_a_norm': gain((N_B_LAYERS, MLA_Q_LORA)),
        'b_w_q_b': normal((N_B_LAYERS, MLA_Q_LORA, MLA_HEADS * (MLA_NOPE + MLA_ROPE)), MLA_Q_LORA ** -0.5),
        'b_w_out': normal((N_B_LAYERS, MLA_HEADS * MLA_V, D_MODEL), (MLA_HEADS * MLA_V) ** -0.5),
        'f_norm_pre': gain((DEPTH, D_MODEL)),
        'f_norm_post': gain((DEPTH, D_MODEL)),
        'f_w_up': normal((DEPTH, D_MODEL, 2 * D_FF), D_MODEL ** -0.5),
        'f_conv_w': normal((DEPTH, FFN_CONV, 2 * D_FF), FFN_CONV ** -0.5),
        'f_conv_b': normal((DEPTH, 2 * D_FF), 0.01),
        'f_w_down': normal((DEPTH, D_FF, D_MODEL), D_FF ** -0.5),
    }


def reference(x_prompt, x_sample, state_delta_S, state_delta_conv, state_ffn_conv, cache_kv_latent, cache_k_rope,
              page_table, meta_tokens, a_norm_pre, a_norm_post, a_w_in, a_conv_w, a_log, a_dt_bias, a_out_norm,
              a_w_out, kv_norm, kv_w_a, kv_a_norm, kv_w_uk, kv_w_uv, b_norm_pre, b_norm_post, b_w_q_a, b_q_a_norm,
              b_w_q_b, b_w_out, f_norm_pre, f_norm_post, f_w_up, f_conv_w, f_conv_b, f_w_down):
    p = {
        'a_norm_pre': a_norm_pre, 'a_norm_post': a_norm_post, 'a_w_in': a_w_in, 'a_conv_w': a_conv_w,
        'a_log': a_log, 'a_dt_bias': a_dt_bias, 'a_out_norm': a_out_norm, 'a_w_out': a_w_out,
        'kv_norm': kv_norm, 'kv_w_a': kv_w_a, 'kv_a_norm': kv_a_norm, 'kv_w_uk': kv_w_uk, 'kv_w_uv': kv_w_uv,
        'b_norm_pre': b_norm_pre, 'b_norm_post': b_norm_post, 'b_w_q_a': b_w_q_a, 'b_q_a_norm': b_q_a_norm,
        'b_w_q_b': b_w_q_b, 'b_w_out': b_w_out,
        'f_norm_pre': f_norm_pre, 'f_norm_post': f_norm_post, 'f_w_up': f_w_up, 'f_conv_w': f_conv_w,
        'f_conv_b': f_conv_b, 'f_w_down': f_w_down,
    }
    bp = x_prompt.shape[0]
    L = N_META + x_prompt.shape[1]
    xp = jnp.concatenate([jnp.broadcast_to(meta_tokens.astype(x_prompt.dtype)[None], (bp, N_META, D_MODEL)),
                          x_prompt], axis=1)
    pos_p = jnp.arange(L, dtype=jnp.int32)
    segs_p = ((0, N_META, N_META), (N_META, L, GDN_CHUNK))
    zS = jnp.zeros((N_A_LAYERS, bp, GDN_HEADS, GDN_DK, GDN_DV), state_delta_S.dtype)
    zdc = jnp.zeros((N_A_LAYERS, bp, GDN_CONV - 1, GDN_QKV), x_prompt.dtype)
    zfc = jnp.zeros((DEPTH, bp, FFN_CONV - 1, 2 * D_FF), x_prompt.dtype)
    yp, p_delta_S, p_delta_conv, p_ffn_conv, p_kv_latent, p_k_rope = trunk(
        xp, pos_p, segs_p, zS, zdc, zfc, prompt_attend, p)

    bs, t_new = x_sample.shape[0], x_sample.shape[1]
    past_len = page_table.shape[1] * cache_kv_latent.shape[1]
    c_past = cache_kv_latent[page_table].reshape(bs, past_len, MLA_KV_LORA)
    k_past = cache_k_rope[page_table].reshape(bs, past_len, MLA_ROPE)
    pos_s = past_len + jnp.arange(t_new, dtype=jnp.int32)
    attend_s = functools.partial(sample_attend, c_past=c_past, k_past=k_past)
    ys, s_delta_S, s_delta_conv, s_ffn_conv, s_kv_latent, s_k_rope = trunk(
        x_sample, pos_s, ((0, t_new, t_new),), state_delta_S, state_delta_conv, state_ffn_conv, attend_s, p)

    y_prompt = yp[:, N_META:]
    return (y_prompt, ys, p_delta_S, p_delta_conv, p_ffn_conv, p_kv_latent, p_k_rope,
            s_delta_S, s_delta_conv, s_ffn_conv, s_kv_latent, s_k_rope)
```

```cpp
#include <hip/hip_runtime.h>
#include <cstdio>
#include <cstdint>
namespace pg8 {
#define PG8_LAS __attribute__((address_space(3)))
typedef unsigned short bf16_t;
typedef short bf16x8 __attribute__((ext_vector_type(8)));
typedef float f32x4 __attribute__((ext_vector_type(4)));
typedef unsigned u32x4 __attribute__((ext_vector_type(4)));
constexpr int BM = 256, BK = 64, HALF = 128, HTB = HALF * BK * 2  , STAGE_BYTES = 8 * HTB, NXCD = 8, WGM = 8;

__host__ __device__ __forceinline__ int lds_byte(int r, int c) { const int st = (r >> 4) * 2 + (c >> 5), rr = r & 15, cc = c & 31, ob = rr * 64 + cc * 2; return st * 1024 + (ob ^ (((ob >> 9) & 1) << 5)); }
__host__ __device__ __forceinline__ void stage_rc(int b, int& R, int& C) { const int st = b / 1024, sb = b % 1024, swz = sb ^ (((sb >> 9) & 1) << 5); R = (st >> 1) * 16 + swz / 64; C = (st & 1) * 32 + (swz % 64) / 2; }
__host__ __device__ __forceinline__ int perm32(int rho) { const int n = rho >> 4, i = rho & 15; return 8 * (i >> 2) + 4 * n + (i & 3); }

struct Unit { int pm, pn; };
struct Gemm { const bf16_t* A; const bf16_t* Bt; int M, N, K; };

struct StaticOrder {
    int nM, nN, nwg, G, c;
    __host__ __device__ void init(int M, int N, int G_, int c_) { nM = M / BM; nN = N / BM; nwg = nM * nN; G = G_; c = c_; }
    __host__ __device__ bool next(int i, Unit& u) const {
        const long L = (long)i * G + c; if (L >= nwg) return false;
        int wgid = (int)L; { const int q = nwg / NXCD, r = nwg % NXCD, xcd = wgid % NXCD, off = wgid / NXCD; wgid = (xcd < r ? xcd * (q + 1) : r * (q + 1) + (xcd - r) * q) + off; }
        const int nig = WGM * nN, gid = wgid / nig, fm = gid * WGM, gsz = (nM - fm) < WGM ? (nM - fm) : WGM;
        u.pm = fm + ((wgid % nig) % gsz); u.pn = (wgid % nig) / gsz; return true;
    }
    __device__ __forceinline__ void a_ready(const Unit&) const {}
    __device__ __forceinline__ void done(const Unit&) const {}
};
__device__ __forceinline__ unsigned cvt_pk_bf16(float lo, float hi) { unsigned r; asm volatile("v_cvt_pk_bf16_f32 %0, %1, %2" : "=v"(r) : "v"(lo), "v"(hi)); return r; }
typedef float f32x2 __attribute__((ext_vector_type(2)));
struct EpiF32 {
    static constexpr bool PERM = false, AFTER_DRAIN = false;
    float* C; int ldc;
    __device__ __forceinline__ void operator()(const f32x4 (&acc)[2][2][4][2], const Unit& u, int wr, int wc, int fr, int fq) const {
        const int row0 = u.pm * BM + wr * 64 + fr, col0 = u.pn * BM + wc * 32 + 4 * fq;
#pragma unroll
        for (int ai = 0; ai < 2; ++ai)
#pragma unroll
            for (int m = 0; m < 4; ++m) { float* rowp = C + (size_t)(row0 + ai * HALF + m * 16) * ldc + col0;
#pragma unroll
                for (int bj = 0; bj < 2; ++bj)
#pragma unroll
                    for (int n = 0; n < 2; ++n) *(f32x4*)(rowp + bj * HALF + n * 16) = acc[ai][bj][m][n]; }
    }
};
struct EpiBf16 {
    static constexpr bool PERM = true, AFTER_DRAIN = false;
    bf16_t* O; int ldc;
    __device__ __forceinline__ void operator()(const f32x4 (&acc)[2][2][4][2], const Unit& u, int wr, int wc, int fr, int fq) const {
        const int row0 = u.pm * BM + wr * 64 + fr, col0 = u.pn * BM + wc * 32 + 8 * fq;
#pragma unroll
        for (int ai = 0; ai < 2; ++ai)
#pragma unroll
            for (int m = 0; m < 4; ++m) { bf16_t* rowp = O + (size_t)(row0 + ai * HALF + m * 16) * ldc + col0;
#pragma unroll
                for (int bj = 0; bj < 2; ++bj) { const f32x4 v0 = acc[ai][bj][m][0], v1 = acc[ai][bj][m][1];
                    u32x4 w; w.x = cvt_pk_bf16(v0[0], v0[1]); w.y = cvt_pk_bf16(v0[2], v0[3]); w.z = cvt_pk_bf16(v1[0], v1[1]); w.w = cvt_pk_bf16(v1[2], v1[3]);
                    *(u32x4*)(rowp + bj * HALF) = w; } }
    }
};
template <class Epi, class Sched, bool ALIGN_EPI = false, bool SP2 = false>
__device__ __forceinline__ void gemm_phase(PG8_LAS unsigned char* lds, const Gemm g, const Sched& S, const Epi& E) {
    const int tid = threadIdx.x, wid = __builtin_amdgcn_readfirstlane(tid >> 6), lane = tid & 63, wr = wid >> 2, wc = wid & 3, fr = lane & 15, fq = lane >> 4;
    const int K = g.K, nt = K / BK;
    unsigned voffA[2], voffB[2];
#pragma unroll
    for (int i = 0; i < 2; ++i) { int R, C; stage_rc(tid * 16 + i * 8192, R, C); const int Rb = Epi::PERM ? ((R & ~31) + perm32(R & 31)) : R;
        voffA[i] = (unsigned)(R * K + C) * 2u; voffB[i] = (unsigned)(Rb * K + C) * 2u; }
    const size_t kstep = (size_t)(BK * 2);
    const size_t hstep = (size_t)HALF * K * 2;
    const size_t tstep = 2 * hstep;
    const unsigned ldsw = (unsigned)wid * 1024u;
    const int aoff = lds_byte(wr * 64 + fr, fq * 8), boff = lds_byte(wc * 32 + fr, fq * 8);
#define PG8_SA(b, h) (((b) * 2 + (h)) * HTB)
#define PG8_SB(b, h) ((4 + (b) * 2 + (h)) * HTB)
#define PG8_STAGE(bufoff, gbase, voff) do { _Pragma("unroll") for (int _i = 0; _i < 2; ++_i) \
        __builtin_amdgcn_global_load_lds((const unsigned*)((const char*)(gbase) + (voff)[_i]), (PG8_LAS unsigned*)(lds + (bufoff) + ldsw + _i * 8192), 16, 0, 0); } while (0)
#define PG8_LDA(dst, b, h) do { _Pragma("unroll") for (int m = 0; m < 4; ++m) _Pragma("unroll") for (int k = 0; k < 2; ++k) dst[m][k] = *(const PG8_LAS bf16x8*)(lds + PG8_SA(b, h) + aoff + m * 2048 + k * 1024); } while (0)
#define PG8_LDB(dst, b, h) do { _Pragma("unroll") for (int n = 0; n < 2; ++n) _Pragma("unroll") for (int k = 0; k < 2; ++k) dst[n][k] = *(const PG8_LAS bf16x8*)(lds + PG8_SB(b, h) + boff + n * 2048 + k * 1024); } while (0)
#define PG8_MMA(ai, bj, At, Bt) do { __builtin_amdgcn_s_setprio(1); _Pragma("unroll") for (int m = 0; m < 4; ++m) _Pragma("unroll") for (int n = 0; n < 2; ++n) _Pragma("unroll") for (int k = 0; k < 2; ++k) \
        acc[ai][bj][m][n] = __builtin_amdgcn_mfma_f32_16x16x32_bf16(Bt[n][k], At[m][k], acc[ai][bj][m][n], 0, 0, 0); __builtin_amdgcn_s_setprio(0); } while (0)
#define PG8_WAIT_V(n) asm volatile("s_waitcnt vmcnt(" #n ")" ::: "memory")
#define PG8_WAIT_L(n) asm volatile("s_waitcnt lgkmcnt(" #n ")" ::: "memory")
#define PG8_BAR __builtin_amdgcn_s_barrier()
#define PG8_SCHED __builtin_amdgcn_sched_barrier(0)
    Unit cur, nxt; int ui = 0;
    if (!S.next(0, cur)) return;
    f32x4 acc[2][2][4][2];
#pragma unroll
    for (int a = 0; a < 2; ++a)
#pragma unroll
        for (int b = 0; b < 2; ++b)
#pragma unroll
            for (int m = 0; m < 4; ++m)
#pragma unroll
                for (int n = 0; n < 2; ++n) acc[a][b][m][n] = (f32x4){0.f, 0.f, 0.f, 0.f};
    bf16x8 At[4][2], B0[2][2], B1[2][2];
    const char* cA = (const char*)g.A + (size_t)cur.pm * tstep; const char* cB = (const char*)g.Bt + (size_t)cur.pn * tstep;
    S.a_ready(cur);
    if constexpr (SP2) {
        PG8_STAGE(PG8_SB(0, 0), cB, voffB); PG8_STAGE(PG8_SB(0, 1), cB + hstep, voffB); PG8_STAGE(PG8_SA(0, 0), cA, voffA); PG8_STAGE(PG8_SA(0, 1), cA + hstep, voffA);
        if (wr == 1) PG8_BAR;
        PG8_WAIT_V(2); PG8_BAR;
        PG8_STAGE(PG8_SB(1, 0), cB + kstep, voffB); PG8_STAGE(PG8_SA(1, 0), cA + kstep, voffA); PG8_STAGE(PG8_SB(1, 1), cB + hstep + kstep, voffB);
        PG8_WAIT_V(6); PG8_BAR;
    } else {
        PG8_STAGE(PG8_SB(0, 0), cB, voffB); PG8_STAGE(PG8_SA(0, 0), cA, voffA); PG8_STAGE(PG8_SB(0, 1), cB + hstep, voffB); PG8_STAGE(PG8_SA(0, 1), cA + hstep, voffA);
        if (wr == 1) PG8_BAR;
        PG8_WAIT_V(4); PG8_BAR;
        PG8_STAGE(PG8_SB(1, 0), cB + kstep, voffB); PG8_STAGE(PG8_SA(1, 0), cA + kstep, voffA); PG8_STAGE(PG8_SB(1, 1), cB + hstep + kstep, voffB);
        PG8_WAIT_V(6); PG8_BAR;
    }
    for (;;) {
        const bool has_next = S.next(ui + 1, nxt);
        const char* nA = has_next ? (const char*)g.A + (size_t)nxt.pm * tstep : cA; const char* nB = has_next ? (const char*)g.Bt + (size_t)nxt.pn * tstep : cB;
        for (int t = 0; t < nt; t += 2) {
            const bool last = (t == nt - 2);
            const char* a1 = cA + (size_t)(t + 1) * kstep;
            const char* a2 = last ? nA : cA + (size_t)(t + 2) * kstep; const char* b2 = last ? nB : cB + (size_t)(t + 2) * kstep;
            const char* a3 = a2 + kstep; const char* b3 = b2 + kstep;
            if (last && has_next) S.a_ready(nxt);
            if constexpr (SP2) {
            PG8_LDB(B0, 0, 0); PG8_LDB(B1, 0, 1); PG8_SCHED; PG8_LDA(At, 0, 0); PG8_STAGE(PG8_SA(1, 1), a1 + hstep, voffA);
            PG8_WAIT_V(8); PG8_WAIT_L(0); PG8_BAR; PG8_MMA(0, 0, At, B0); PG8_MMA(0, 1, At, B1); PG8_BAR; PG8_SCHED;
            PG8_LDA(At, 0, 1); PG8_STAGE(PG8_SB(0, 0), b2, voffB); PG8_STAGE(PG8_SB(0, 1), b2 + hstep, voffB); PG8_STAGE(PG8_SA(0, 0), a2, voffA);
            PG8_WAIT_V(8); PG8_WAIT_L(0); PG8_BAR; PG8_MMA(1, 0, At, B0); PG8_MMA(1, 1, At, B1); PG8_BAR; PG8_SCHED;
            PG8_LDB(B0, 1, 0); PG8_LDB(B1, 1, 1); PG8_SCHED; PG8_LDA(At, 1, 0); PG8_STAGE(PG8_SA(0, 1), a2 + hstep, voffA);
            PG8_WAIT_V(8); PG8_WAIT_L(0); PG8_BAR; PG8_MMA(0, 0, At, B0); PG8_MMA(0, 1, At, B1); PG8_BAR; PG8_SCHED;
            PG8_LDA(At, 1, 1); PG8_STAGE(PG8_SB(1, 0), b3, voffB); PG8_STAGE(PG8_SB(1, 1), b3 + hstep, voffB); PG8_STAGE(PG8_SA(1, 0), a3, voffA);
            PG8_WAIT_V(8); PG8_WAIT_L(0); PG8_BAR; PG8_MMA(1, 0, At, B0); PG8_MMA(1, 1, At, B1); PG8_BAR; PG8_SCHED;
            } else {
            PG8_LDB(B0, 0, 0); PG8_SCHED; PG8_LDA(At, 0, 0); PG8_STAGE(PG8_SA(1, 1), a1 + hstep, voffA);
            PG8_WAIT_L(8); PG8_BAR; PG8_WAIT_L(0); PG8_MMA(0, 0, At, B0); PG8_BAR; PG8_SCHED;
            PG8_LDB(B1, 0, 1); PG8_STAGE(PG8_SB(0, 0), b2, voffB);
            PG8_BAR; PG8_WAIT_L(0); PG8_MMA(0, 1, At, B1); PG8_BAR;
            PG8_LDA(At, 0, 1); PG8_STAGE(PG8_SA(0, 0), a2, voffA);
            PG8_BAR; PG8_WAIT_L(0); PG8_MMA(1, 0, At, B0); PG8_BAR; PG8_SCHED;
            PG8_STAGE(PG8_SB(0, 1), b2 + hstep, voffB);
            PG8_WAIT_V(6); PG8_BAR; PG8_MMA(1, 1, At, B1); PG8_BAR;
            PG8_LDB(B0, 1, 0); PG8_SCHED; PG8_LDA(At, 1, 0); PG8_STAGE(PG8_SA(0, 1), a2 + hstep, voffA);
            PG8_WAIT_L(8); PG8_BAR; PG8_WAIT_L(0); PG8_MMA(0, 0, At, B0); PG8_BAR; PG8_SCHED;
            PG8_LDB(B1, 1, 1); PG8_STAGE(PG8_SB(1, 0), b3, voffB);
            PG8_BAR; PG8_WAIT_L(0); PG8_MMA(0, 1, At, B1); PG8_BAR;
            PG8_LDA(At, 1, 1); PG8_STAGE(PG8_SA(1, 0), a3, voffA);
            PG8_BAR; PG8_WAIT_L(0); PG8_MMA(1, 0, At, B0); PG8_BAR; PG8_SCHED;
            PG8_STAGE(PG8_SB(1, 1), b3 + hstep, voffB);
            PG8_WAIT_V(6); PG8_BAR; PG8_MMA(1, 1, At, B1); PG8_BAR;
            }
        }
        if constexpr (ALIGN_EPI) { if (wr == 0) PG8_BAR; }
        if constexpr (!Epi::AFTER_DRAIN) { E(acc, cur, wr, wc, fr, fq); S.done(cur); }
        if (!has_next) break;
#pragma unroll
        for (int a = 0; a < 2; ++a)
#pragma unroll
            for (int b = 0; b < 2; ++b)
#pragma unroll
                for (int m = 0; m < 4; ++m)
#pragma unroll
                    for (int n = 0; n < 2; ++n) acc[a][b][m][n] = (f32x4){0.f, 0.f, 0.f, 0.f};
        cur = nxt; cA = nA; cB = nB; ++ui;
        if constexpr (ALIGN_EPI) { if (wr == 1) PG8_BAR; }
    }
    PG8_WAIT_V(0);
    if constexpr (!ALIGN_EPI) { if (wr == 0) PG8_BAR; }
    PG8_BAR;
    if constexpr (Epi::AFTER_DRAIN) { E.fused(acc, cur, wr, wc, fr, fq, lds, wid, lane); S.done(cur); }
#undef PG8_SA
#undef PG8_SB
#undef PG8_STAGE
#undef PG8_LDA
#undef PG8_LDB
#undef PG8_MMA
#undef PG8_WAIT_V
#undef PG8_WAIT_L
#undef PG8_BAR
#undef PG8_SCHED
}
}

constexpr int DM = 1024, NB = 16, SEQ = 2048, TR = NB * SEQ, NMETA = 16, NS = 128;
constexpr int XM = TR, XS = TR + NMETA, NVALID = TR + NMETA + NS, TM = 33024;
constexpr int LP = NMETA + SEQ;
constexpr int GH = 8, GDK = 128, GDV = 128, GQKV = 3072, GIN = 4112;
constexpr int QL = 384, KVL = 256, NOPE = 128, ROPE = 64, HD = 192, MH = 8;
constexpr int FF = 2816, FF2 = 5632;
constexpr int PAST = 8192, PAGE = 128, NPAGE = 64;
constexpr float EPS = 1e-6f;
constexpr float MLA_SCALE = 0.07216878364870322f;
static_assert(TM % 256 == 0 && TM >= NVALID, "row padding");

enum { I_XP = 0, I_XS, I_SDS, I_SDC, I_SFC, I_CKV, I_CKR, I_PT, I_META, I_ANPRE, I_ANPOST, I_AWIN, I_ACONV, I_ALOG, I_ADT, I_AONORM, I_AWOUT,
       I_KVNORM, I_KVWA, I_KVANORM, I_WUK, I_WUV, I_BNPRE, I_BNPOST, I_BWQA, I_BQANORM, I_BWQB, I_BWOUT, I_FNPRE, I_FNPOST, I_FWUP, I_FCONVW, I_FCONVB, I_FWDOWN, N_IN };
constexpr size_t O_YP = 0, O_YS = O_YP + (size_t)TR * DM, O_PDS = O_YS + (size_t)NS * DM, O_PDC = O_PDS + (size_t)NB * GH * GDK * GDV, O_PFC = O_PDC + (size_t)NB * 3 * GQKV,
                 O_PKV = O_PFC + (size_t)2 * NB * 2 * FF2, O_PKR = O_PKV + (size_t)NB * LP * KVL, O_SDS = O_PKR + (size_t)NB * LP * ROPE, O_SDC = O_SDS + (size_t)NS * GH * GDK * GDV,
                 O_SFC = O_SDC + (size_t)NS * 3 * GQKV, O_SKV = O_SFC + (size_t)2 * NS * 2 * FF2, O_SKR = O_SKV + (size_t)NS * KVL, O_END = O_SKR + (size_t)NS * ROPE;

constexpr size_t MiB = 1u << 20;
constexpr size_t WS_CTL = 0, CTL_ZERO_BYTES = 1 * MiB;
constexpr size_t WS_ROPE = 1 * MiB;
constexpr size_t WS_WIN = 2 * MiB, WS_WGOUT = 10 * MiB, WS_WUP0 = 12 * MiB, WS_WUP1 = 23 * MiB, WS_WDN0 = 34 * MiB, WS_WDN1 = 40 * MiB, WS_WKVQA = 46 * MiB,
                 WS_WQB = 48 * MiB, WS_WUKV = 50 * MiB, WS_WMOUT = 52 * MiB, WS_AB = 54 * MiB, WS_PART = 57 * MiB, WS_QLAT = 60 * MiB;
constexpr size_t WS_XRES = 64 * MiB, WS_XH = 193 * MiB, WS_TMP = 258 * MiB, WS_QKVZ = 387 * MiB, WS_GO = 645 * MiB, WS_UP = 710 * MiB, WS_ACT = 1065 * MiB,
                 WS_CKVQ = 1243 * MiB, WS_CB = 1340 * MiB, WS_KRB = 1357 * MiB, WS_QAN = 1362 * MiB, WS_Q = 1387 * MiB, WS_KNV = 1484 * MiB, WS_AO = 1613 * MiB, WS_END = 1678 * MiB;
constexpr int CW_BAR = 4096;
constexpr int NPOSTAB = LP + 1;

constexpr int RING_BYTES = 131072, MISC_OFF = RING_BYTES + 320, LDS_BYTES = 147456;

#define LAS __attribute__((address_space(3)))
typedef unsigned short bf16;
typedef unsigned v4u __attribute__((ext_vector_type(4)));
typedef unsigned v2u __attribute__((ext_vector_type(2)));
typedef float f32x4 __attribute__((ext_vector_type(4)));
typedef float f32x16 __attribute__((ext_vector_type(16)));
typedef short bf16x8 __attribute__((ext_vector_type(8)));
typedef short s16x4 __attribute__((ext_vector_type(4)));
#define LDS_WAIT() asm volatile("s_waitcnt lgkmcnt(0)" ::: "memory")
#define VM_WAIT() asm volatile("s_waitcnt vmcnt(0)" ::: "memory")
__device__ __forceinline__ unsigned f2bf(float f) { unsigned u = __builtin_bit_cast(unsigned, f); return (u + 0x7fffu + ((u >> 16) & 1u)) >> 16; }
__device__ __forceinline__ unsigned pk2(float lo, float hi) { return f2bf(lo) | (f2bf(hi) << 16); }
__device__ __forceinline__ float bf2f(bf16 b) { return __builtin_bit_cast(float, (unsigned)b << 16); }
__device__ __forceinline__ float bflo(unsigned w) { return __builtin_bit_cast(float, w << 16); }
__device__ __forceinline__ float bfhi(unsigned w) { return __builtin_bit_cast(float, w & 0xffff0000u); }
__device__ __forceinline__ float wave_sum(float v) {
#pragma unroll
    for (int o = 1; o < 64; o <<= 1) v += __shfl_xor(v, o);
    return v;
}
__device__ __forceinline__ float siluf(float x) { return x / (1.f + __expf(-x)); }

#define XB_TMO      128
#define XB_XCNT(j)  (256  + 64 * (j))
#define XB_XSUB(j)  (1280 + 64 * (j))
#define XB_XGEN(j)  (2304 + 64 * (j))
#define XB_TOP      3328
#define XB_TOPGEN   3392
#define XCD_BAR_WORDS 3456
#define XB_SPIN_CAP (1u << 18)
__device__ __forceinline__ unsigned xb_ld(unsigned* p)              { return __hip_atomic_load(p, __ATOMIC_RELAXED, __HIP_MEMORY_SCOPE_AGENT); }
__device__ __forceinline__ unsigned xb_add(unsigned* p, unsigned v) { return __hip_atomic_fetch_add(p, v, __ATOMIC_RELAXED, __HIP_MEMORY_SCOPE_AGENT); }
__device__ __forceinline__ unsigned xb_xcc_id() { return (unsigned)__builtin_amdgcn_s_getreg((3 << 11) | 20) & 0xFu; }
#define XB_SPIN(cond, bar) do { unsigned _sp = 0; while (cond) { __builtin_amdgcn_s_sleep(1); \
    if ((++_sp & 255u) == 0u) { if (xb_ld(&(bar)[XB_TMO])) break; if (_sp > XB_SPIN_CAP) { atomicAdd(&(bar)[XB_TMO], 1u); break; } } } } while (0)
struct XcdBarrier { unsigned* bar; unsigned x; volatile LAS unsigned* st; };
__device__ __forceinline__ XcdBarrier xcd_barrier_post(unsigned* bar, volatile LAS unsigned* st) {
    XcdBarrier b; b.bar = bar; b.x = xb_xcc_id(); b.st = st;
    if (threadIdx.x == 0) (void)xb_add(&bar[XB_XCNT(b.x)], 1u);
    return b;
}
__device__ __forceinline__ void xcd_barrier_complete(unsigned* bar, unsigned x, unsigned& nloc, unsigned& nx) {
    const unsigned G = gridDim.x * gridDim.y * gridDim.z;
    unsigned sum, cnt, mine, sp = 0u;
    for (;;) {
        sum = 0u; cnt = 0u; mine = 0u;
#pragma unroll
        for (unsigned j = 0; j < 16; ++j) { const unsigned c = xb_ld(&bar[XB_XCNT(j)]); sum += c; cnt += (c > 0u) ? 1u : 0u; mine = (j == x) ? c : mine; }
        if (sum == G) break;
        __builtin_amdgcn_s_sleep(1);
        if ((++sp & 255u) == 0u) { if (xb_ld(&bar[XB_TMO])) break; if (sp > XB_SPIN_CAP) { atomicAdd(&bar[XB_TMO], 1u); break; } }
    }
    nloc = mine > 0u ? mine : 1u; nx = cnt > 0u ? cnt : 1u;
}
__device__ __forceinline__ void xcd_barrier(const XcdBarrier& b) {
    asm volatile("s_waitcnt vmcnt(0)" ::: "memory");
    __syncthreads();
    if (threadIdx.x == 0) {
        unsigned* bar = b.bar;
        __builtin_amdgcn_s_waitcnt(0);
        unsigned nloc = b.st[0], nx = b.st[1];
        if (nloc == 0u) { xcd_barrier_complete(bar, b.x, nloc, nx); b.st[0] = nloc; b.st[1] = nx; }
        const unsigned old = xb_add(&bar[XB_XSUB(b.x)], 1u);
        const unsigned gen = old / nloc;
        if (old + 1u == (gen + 1u) * nloc) {
            __builtin_amdgcn_fence(__ATOMIC_RELEASE, "agent");
            asm volatile("s_waitcnt vmcnt(0)" ::: "memory");
            const unsigned og = xb_add(&bar[XB_TOP], 1u);
            const unsigned tg = og / nx;
            if (og + 1u == (tg + 1u) * nx) xb_add(&bar[XB_TOPGEN], 1u);
            else XB_SPIN(xb_ld(&bar[XB_TOPGEN]) == tg, bar);
            __builtin_amdgcn_fence(__ATOMIC_ACQUIRE, "agent");
            xb_add(&bar[XB_XGEN(b.x)], 1u);
            asm volatile("s_waitcnt vmcnt(0)" ::: "memory");
        } else {
            XB_SPIN(xb_ld(&bar[XB_XGEN(b.x)]) == gen, bar);
            __builtin_amdgcn_fence(__ATOMIC_ACQUIRE, "agent");
            asm volatile("s_waitcnt vmcnt(0)" ::: "memory");
        }
    }
    __syncthreads();
}

struct ConvJob { const float* src; const float* gain; bf16* dst; int K, N, ld, row_off; };
constexpr int NJOBS = 12;
struct Params {
    const float* in[N_IN];
    float* out; unsigned char* ws;
    ConvJob jobs[NJOBS];
    int ph_lo, ph_hi;
};
struct Frame {
    LAS unsigned char* lds;
    int tid, lane, wave, G, bid;
    const float* const* in; float* out; unsigned char* ws;
};
__device__ __forceinline__ int prow(int b, int pos) { return pos < NMETA ? XM + pos : b * SEQ + (pos - NMETA); }

__device__ __forceinline__ void p0_transpose_item(const ConvJob& J, LAS float* scr, int item, int lane) {
    const int nblk = J.N / 32, kb = item / nblk, nb = item % nblk, k0 = 64 * kb, n0 = 32 * nb;
#pragma unroll 8
    for (int i = 0; i < 32; ++i) { const int kk = 2 * i + (lane >> 5); const float g = J.gain ? J.gain[k0 + kk] : 1.f;
        scr[kk * 33 + (lane & 31)] = J.src[(size_t)(k0 + kk) * J.ld + n0 + (lane & 31)] * g; }
    LDS_WAIT(); asm volatile("" ::: "memory");
    const int c = lane & 7;
#pragma unroll
    for (int j = 0; j < 4; ++j) { const int n = (lane >> 3) + 8 * j; const LAS float* s = scr + (8 * c) * 33 + n;
        v4u o; o.x = pk2(s[0 * 33], s[1 * 33]); o.y = pk2(s[2 * 33], s[3 * 33]); o.z = pk2(s[4 * 33], s[5 * 33]); o.w = pk2(s[6 * 33], s[7 * 33]);
        *(v4u*)(J.dst + (size_t)(J.row_off + n0 + n) * J.K + k0 + 8 * c) = o; }
    LDS_WAIT(); asm volatile("" ::: "memory");
}
__device__ __forceinline__ void p0_prologue(Frame& F, const Params& P) {
    const int gw = F.bid * 8 + F.wave, NGW = F.G * 8;
    {
        LAS float* scr = (LAS float*)(F.lds + F.wave * 16384);
        int base = 0;
#pragma unroll 1
        for (int j = 0; j < NJOBS; ++j) {
            const ConvJob J = P.jobs[j]; const int nit = (J.K / 64) * (J.N / 32);
            int first = (gw - base % NGW + NGW) % NGW;
#pragma unroll 1
            for (int it = first; it < nit; it += NGW) p0_transpose_item(J, scr, it, F.lane);
            base += nit;
        }
        bf16* wz = (bf16*)(F.ws + WS_WKVQA) + (size_t)704 * DM;
        for (int i = F.bid * 512 + F.tid; i < 64 * DM / 8; i += F.G * 512) ((v4u*)wz)[i] = (v4u){0u, 0u, 0u, 0u};
    }
    {
        float* ctab = (float*)(F.ws + WS_ROPE); float* stab = ctab + NPOSTAB * 32;
        for (int idx = F.bid * 512 + F.tid; idx < NPOSTAB * 32; idx += F.G * 512) {
            const int pi = idx >> 5, i = idx & 31; const int pos = pi < LP ? pi : PAST;
            double inv = 1.0; for (int k = 0; k < i; ++k) inv *= 0.74989420933245582730;
            double c1 = 1.0, s1 = inv, tc = 1.0, ts = inv; const double x2 = inv * inv;
            for (int k = 1; k < 14; ++k) { tc *= -x2 / (double)((2 * k - 1) * (2 * k)); ts *= -x2 / (double)((2 * k) * (2 * k + 1)); c1 += tc; s1 += ts; }
            double rc = 1.0, rs = 0.0, bc = c1, bs = s1; int e = pos;
            for (int k = 0; k < 14; ++k) { if (e & 1) { const double t = rc * bc - rs * bs; rs = rc * bs + rs * bc; rc = t; } const double t2 = bc * bc - bs * bs; bs = 2.0 * bc * bs; bc = t2; e >>= 1; }
            ctab[idx] = (float)rc; stab[idx] = (float)rs;
        }
    }
    __syncthreads();
    LAS float* wab = (LAS float*)F.lds;
    { const float* win = F.in[I_AWIN]; const float* g = F.in[I_ANPRE];
      for (int idx = F.tid; idx < DM * 16; idx += 512) { const int k = idx >> 4, j = idx & 15; wab[idx] = win[(size_t)k * GIN + 4096 + j] * g[k]; } }
    __syncthreads();
    float* XRES = (float*)(F.ws + WS_XRES); bf16* XH = (bf16*)(F.ws + WS_XH); float* AB = (float*)(F.ws + WS_AB);
    for (int row = gw; row < TM; row += NGW) {
        const float* src = nullptr;
        if (row < TR) src = F.in[I_XP] + (size_t)row * DM; else if (row < XS) src = F.in[I_META] + (size_t)(row - XM) * DM; else if (row < NVALID) src = F.in[I_XS] + (size_t)(row - XS) * DM;
        f32x4 v[4]; float ss = 0.f;
#pragma unroll
        for (int j = 0; j < 4; ++j) { v[j] = src ? ((const f32x4*)src)[64 * j + F.lane] : (f32x4){0.f, 0.f, 0.f, 0.f}; ss += (v[j].x * v[j].x + v[j].y * v[j].y) + (v[j].z * v[j].z + v[j].w * v[j].w); }
        ss = wave_sum(ss); const float rstd = rsqrtf(ss * (1.f / DM) + EPS);
        f32x4* xr = (f32x4*)(XRES + (size_t)row * DM); unsigned long long* xh = (unsigned long long*)(XH + (size_t)row * DM);
#pragma unroll
        for (int j = 0; j < 4; ++j) { xr[64 * j + F.lane] = v[j]; v[j] = v[j] * rstd; xh[64 * j + F.lane] = (unsigned long long)pk2(v[j].x, v[j].y) | ((unsigned long long)pk2(v[j].z, v[j].w) << 32); }
        if (!src) continue;
        float a[16];
#pragma unroll
        for (int q = 0; q < 16; ++q) a[q] = 0.f;
#pragma unroll
        for (int j = 0; j < 4; ++j)
#pragma unroll
            for (int i = 0; i < 4; ++i) { const int k = 256 * j + 4 * F.lane + i; const float xv = v[j][i]; const LAS f32x4* wr = (const LAS f32x4*)(wab + k * 16);
#pragma unroll
                for (int q4 = 0; q4 < 4; ++q4) { const f32x4 w = wr[q4]; a[4 * q4 + 0] += xv * w.x; a[4 * q4 + 1] += xv * w.y; a[4 * q4 + 2] += xv * w.z; a[4 * q4 + 3] += xv * w.w; } }
#pragma unroll
        for (int s = 0; s < 4; ++s) { const int M = 32 >> s, n = 8 >> s; const bool bit = (F.lane & M) != 0;
#pragma unroll
            for (int i = 0; i < n; ++i) { const float keep = bit ? a[i + n] : a[i], send = bit ? a[i] : a[i + n]; a[i] = keep + __shfl_xor(send, M); } }
        a[0] += __shfl_xor(a[0], 2); a[0] += __shfl_xor(a[0], 1);
        if ((F.lane & 3) == 0) { const int idx = ((F.lane >> 5) & 1) * 8 + ((F.lane >> 4) & 1) * 4 + ((F.lane >> 3) & 1) * 2 + ((F.lane >> 2) & 1); AB[(size_t)row * 16 + idx] = a[0]; }
    }
}

__device__ __forceinline__ void gdn_item(Frame& F, int item) {
    const bool is_p = item < NB * GH;
    const int b = is_p ? item >> 3 : 0, h = item & 7, s = is_p ? 0 : (item - NB * GH) >> 3;
    const int dv = F.tid & 127, qd = __builtin_amdgcn_readfirstlane(F.tid >> 7);
    LAS float* qs = (LAS float*)F.lds; LAS float* ks = qs + 16 * 128; LAS float* vs = ks + 16 * 128; LAS float* red = vs + 16 * 128; LAS float* red2 = red + 512; LAS float* egs = red2 + 512; LAS float* bes = egs + 16;
    const bf16* QKVZ = (const bf16*)(F.ws + WS_QKVZ); const float* AB = (const float*)(F.ws + WS_AB); float* OB = (float*)(F.ws + WS_TMP);
    const float* cw = F.in[I_ACONV]; const float* sdc = F.in[I_SDC];
    float S[32];
    if (is_p) {
#pragma unroll
        for (int i = 0; i < 32; ++i) S[i] = 0.f;
    } else { const float* s0 = F.in[I_SDS] + ((size_t)(s * GH + h) * GDK + 32 * qd) * GDV + dv;
#pragma unroll
        for (int i = 0; i < 32; ++i) S[i] = s0[(size_t)i * GDV]; }
    const float Ah = __expf(F.in[I_ALOG][h]), dtb = F.in[I_ADT][h];
    const int nchunk = is_p ? LP / 16 : 1, ntok = is_p ? 16 : 1;
#pragma unroll 1
    for (int ch = 0; ch < nchunk; ++ch) {
        for (int idx = F.tid; idx < ntok * 384; idx += 512) {
            const int ti = idx / 384, c = idx - ti * 384, part = c >> 7, cc = c & 127, col = part * 1024 + h * 128 + cc;
            float acc = 0.f;
#pragma unroll
            for (int j = 0; j < 4; ++j) {
                float xv;
                if (is_p) { const int pos = ch * 16 + ti - 3 + j; xv = pos < 0 ? 0.f : bf2f(QKVZ[(size_t)prow(b, pos) * 4096 + col]); }
                else xv = j < 3 ? sdc[(size_t)(s * 3 + j) * GQKV + col] : bf2f(QKVZ[(size_t)(XS + s) * 4096 + col]);
                acc += cw[j * GQKV + col] * xv;
            }
            acc = siluf(acc);
            (part == 0 ? qs : part == 1 ? ks : vs)[ti * 128 + cc] = acc;
        }
        if (F.tid < ntok) { const int row = is_p ? prow(b, ch * 16 + F.tid) : XS + s; const float a = AB[(size_t)row * 16 + h], bb = AB[(size_t)row * 16 + 8 + h];
            const float x = a + dtb, sp = x > 20.f ? x : log1pf(__expf(x)); egs[F.tid] = __expf(-Ah * sp); bes[F.tid] = 1.f / (1.f + __expf(-bb)); }
        __syncthreads();
        for (int vv = F.wave; vv < 2 * ntok; vv += 8) { const int ti = vv >> 1, isk = vv & 1; LAS float* p = (isk ? ks : qs) + ti * 128; const float x0 = p[F.lane], x1 = p[F.lane + 64];
            const float ss = wave_sum(x0 * x0 + x1 * x1); const float r = rsqrtf(ss + EPS) * (isk ? 1.f : 0.08838834764831845f); p[F.lane] = x0 * r; p[F.lane + 64] = x1 * r; }
        __syncthreads();
#pragma unroll 1
        for (int ti = 0; ti < ntok; ++ti) {
            float kk[32]; float p = 0.f;
#pragma unroll
            for (int i = 0; i < 32; ++i) { kk[i] = ks[ti * 128 + 32 * qd + i]; p += kk[i] * S[i]; }
            red[qd * 128 + dv] = p; __syncthreads();
            const float kS = (red[dv] + red[128 + dv]) + (red[256 + dv] + red[384 + dv]);
            const float eg = egs[ti], be = bes[ti], u = be * (vs[ti * 128 + dv] - eg * kS);
            float op = 0.f;
#pragma unroll
            for (int i = 0; i < 32; ++i) { S[i] = eg * S[i] + kk[i] * u; op += qs[ti * 128 + 32 * qd + i] * S[i]; }
            red2[qd * 128 + dv] = op; __syncthreads();
            if (qd == 0) { const float o = (red2[dv] + red2[128 + dv]) + (red2[256 + dv] + red2[384 + dv]);
                const int row = is_p ? prow(b, ch * 16 + ti) : XS + s;
                if (!is_p || ch > 0 || b == 0) OB[(size_t)row * DM + h * 128 + dv] = o; }
        }
        __syncthreads();
    }
    float* so = is_p ? F.out + O_PDS + ((size_t)(b * GH + h) * GDK + 32 * qd) * GDV + dv : F.out + O_SDS + ((size_t)(s * GH + h) * GDK + 32 * qd) * GDV + dv;
#pragma unroll
    for (int i = 0; i < 32; ++i) so[(size_t)i * GDV] = S[i];
}

__device__ __forceinline__ void p3_gate(Frame& F) {
    const int gw = F.bid * 8 + F.wave, NGW = F.G * 8;
    const float* OB = (const float*)(F.ws + WS_TMP); const bf16* QKVZ = (const bf16*)(F.ws + WS_QKVZ); bf16* GO = (bf16*)(F.ws + WS_GO);
    const float* on = F.in[I_AONORM];
    f32x4 g4[4];
#pragma unroll
    for (int j = 0; j < 4; ++j) g4[j] = ((const f32x4*)on)[((16 * F.lane) & 127) / 4 + j];
    for (int row = gw; row < NVALID; row += NGW) {
        const f32x4* op = (const f32x4*)(OB + (size_t)row * DM + 16 * F.lane); const v4u* zp = (const v4u*)(QKVZ + (size_t)row * 4096 + 3072 + 16 * F.lane);
        f32x4 o[4]; float ss = 0.f;
#pragma unroll
        for (int j = 0; j < 4; ++j) { o[j] = op[j]; ss += (o[j].x * o[j].x + o[j].y * o[j].y) + (o[j].z * o[j].z + o[j].w * o[j].w); }
        ss += __shfl_xor(ss, 1); ss += __shfl_xor(ss, 2); ss += __shfl_xor(ss, 4);
        const float rstd = rsqrtf(ss * (1.f / 128.f) + EPS);
        const v4u z0 = zp[0], z1 = zp[1]; const unsigned zw[8] = {z0.x, z0.y, z0.z, z0.w, z1.x, z1.y, z1.z, z1.w};
        unsigned w[8];
#pragma unroll
        for (int j = 0; j < 4; ++j) { const f32x4 y = o[j] * rstd * g4[j];
            w[2 * j] = pk2(y.x * siluf(bflo(zw[2 * j])), y.y * siluf(bfhi(zw[2 * j]))); w[2 * j + 1] = pk2(y.z * siluf(bflo(zw[2 * j + 1])), y.w * siluf(bfhi(zw[2 * j + 1]))); }
        v4u* gp = (v4u*)(GO + (size_t)row * DM + 16 * F.lane); gp[0] = (v4u){w[0], w[1], w[2], w[3]}; gp[1] = (v4u){w[4], w[5], w[6], w[7]};
    }
    const int gt = F.bid * 512 + F.tid, NGT = F.G * 512;
    for (int i = gt; i < NB * 3 * GQKV; i += NGT) { const int c = i % GQKV, j = (i / GQKV) % 3, b = i / (3 * GQKV); F.out[O_PDC + i] = bf2f(QKVZ[(size_t)(b * SEQ + SEQ - 3 + j) * 4096 + c]); }
    for (int i = gt; i < NS * 3 * GQKV; i += NGT) { const int c = i % GQKV, j = (i / GQKV) % 3, s = i / (3 * GQKV);
        F.out[O_SDC + i] = j < 2 ? F.in[I_SDC][(size_t)(s * 3 + j + 1) * GQKV + c] : bf2f(QKVZ[(size_t)(XS + s) * 4096 + c]); }
}

template <bool LAST> __device__ __forceinline__ void p_postnorm(Frame& F, const float* gpost) {
    const int gw = F.bid * 8 + F.wave, NGW = F.G * 8;
    const float* TMP = (const float*)(F.ws + WS_TMP); float* XRES = (float*)(F.ws + WS_XRES); bf16* XH = (bf16*)(F.ws + WS_XH);
    f32x4 g[4];
#pragma unroll
    for (int j = 0; j < 4; ++j) g[j] = ((const f32x4*)gpost)[64 * j + F.lane];
    for (int row = gw; row < NVALID; row += NGW) {
        const f32x4* tp = (const f32x4*)(TMP + (size_t)row * DM); f32x4* xp = (f32x4*)(XRES + (size_t)row * DM);
        f32x4 t[4], x[4]; float ss = 0.f;
#pragma unroll
        for (int j = 0; j < 4; ++j) { t[j] = tp[64 * j + F.lane]; x[j] = xp[64 * j + F.lane]; ss += (t[j].x * t[j].x + t[j].y * t[j].y) + (t[j].z * t[j].z + t[j].w * t[j].w); }
        ss = wave_sum(ss); const float rstd = rsqrtf(ss * (1.f / DM) + EPS); float s2 = 0.f;
#pragma unroll
        for (int j = 0; j < 4; ++j) { x[j] = x[j] + t[j] * rstd * g[j]; s2 += (x[j].x * x[j].x + x[j].y * x[j].y) + (x[j].z * x[j].z + x[j].w * x[j].w); }
        if (LAST) {
            float* yo = row < TR ? F.out + O_YP + (size_t)row * DM : (row >= XS ? F.out + O_YS + (size_t)(row - XS) * DM : nullptr);
            if (yo) {
#pragma unroll
                for (int j = 0; j < 4; ++j) ((f32x4*)yo)[64 * j + F.lane] = x[j]; }
        } else {
            s2 = wave_sum(s2); const float r2 = rsqrtf(s2 * (1.f / DM) + EPS);
            unsigned long long* xh = (unsigned long long*)(XH + (size_t)row * DM);
#pragma unroll
            for (int j = 0; j < 4; ++j) { xp[64 * j + F.lane] = x[j]; const f32x4 y = x[j] * r2; xh[64 * j + F.lane] = (unsigned long long)pk2(y.x, y.y) | ((unsigned long long)pk2(y.z, y.w) << 32); }
        }
    }
}

__device__ __forceinline__ void ld8(const bf16* p, float (&o)[8]) { const v4u w = *(const v4u*)p; o[0] = bflo(w.x); o[1] = bfhi(w.x); o[2] = bflo(w.y); o[3] = bfhi(w.y); o[4] = bflo(w.z); o[5] = bfhi(w.z); o[6] = bflo(w.w); o[7] = bfhi(w.w); }
__device__ __forceinline__ void ld8f(const float* p, float (&o)[8]) { const f32x4 a = ((const f32x4*)p)[0], b = ((const f32x4*)p)[1]; o[0] = a.x; o[1] = a.y; o[2] = a.z; o[3] = a.w; o[4] = b.x; o[5] = b.y; o[6] = b.z; o[7] = b.w; }
__device__ __forceinline__ void p_ffn_act(Frame& F, int layer) {
    const bf16* UP = (const bf16*)(F.ws + WS_UP); bf16* ACT = (bf16*)(F.ws + WS_ACT);
    const float* cw = F.in[I_FCONVW] + (size_t)layer * 3 * FF2; const float* cb = F.in[I_FCONVB] + (size_t)layer * FF2; const float* sfc = F.in[I_SFC] + (size_t)layer * NS * 2 * FF2;
    const int gt = F.bid * 512 + F.tid, NGT = F.G * 512; constexpr int CG = FF / 8;
    for (int i = gt; i < NVALID * CG; i += NGT) {
        const int row = i / CG, c0 = (i - row * CG) * 8;
        float x0g[8], x0v[8], x1g[8], x1v[8], x2g[8], x2v[8];
        ld8(UP + (size_t)row * FF2 + c0, x2g); ld8(UP + (size_t)row * FF2 + FF + c0, x2v);
        int r1 = -1, r2 = -1;
        if (row < TR) { const int t = row & (SEQ - 1); r1 = t >= 1 ? row - 1 : XM + 15; r2 = t >= 2 ? row - 2 : XM + 14 + t; }
        else if (row < XS) { const int m = row - XM; r1 = m >= 1 ? row - 1 : -1; r2 = m >= 2 ? row - 2 : -1; }
        if (row >= XS) { const int s = row - XS; ld8f(sfc + (size_t)(s * 2 + 1) * FF2 + c0, x1g); ld8f(sfc + (size_t)(s * 2 + 1) * FF2 + FF + c0, x1v); ld8f(sfc + (size_t)(s * 2) * FF2 + c0, x0g); ld8f(sfc + (size_t)(s * 2) * FF2 + FF + c0, x0v); }
        else {
            if (r1 >= 0) { ld8(UP + (size_t)r1 * FF2 + c0, x1g); ld8(UP + (size_t)r1 * FF2 + FF + c0, x1v); } else {
#pragma unroll
                for (int k = 0; k < 8; ++k) { x1g[k] = 0.f; x1v[k] = 0.f; } }
            if (r2 >= 0) { ld8(UP + (size_t)r2 * FF2 + c0, x0g); ld8(UP + (size_t)r2 * FF2 + FF + c0, x0v); } else {
#pragma unroll
                for (int k = 0; k < 8; ++k) { x0g[k] = 0.f; x0v[k] = 0.f; } }
        }
        float w0g[8], w1g[8], w2g[8], w0v[8], w1v[8], w2v[8], bg[8], bv[8];
        ld8f(cw + c0, w0g); ld8f(cw + FF2 + c0, w1g); ld8f(cw + 2 * FF2 + c0, w2g); ld8f(cw + FF + c0, w0v); ld8f(cw + FF2 + FF + c0, w1v); ld8f(cw + 2 * FF2 + FF + c0, w2v); ld8f(cb + c0, bg); ld8f(cb + FF + c0, bv);
        float a[8];
#pragma unroll
        for (int k = 0; k < 8; ++k) { const float ug = w0g[k] * x0g[k] + w1g[k] * x1g[k] + w2g[k] * x2g[k] + bg[k], uv = w0v[k] * x0v[k] + w1v[k] * x1v[k] + w2v[k] * x2v[k] + bv[k]; a[k] = siluf(ug) * uv; }
        *(v4u*)(ACT + (size_t)row * FF + c0) = (v4u){pk2(a[0], a[1]), pk2(a[2], a[3]), pk2(a[4], a[5]), pk2(a[6], a[7])};
    }
    float* pfc = F.out + O_PFC + (size_t)layer * NB * 2 * FF2; float* sfo = F.out + O_SFC + (size_t)layer * NS * 2 * FF2;
    for (int i = gt; i < NB * 2 * FF2; i += NGT) { const int c = i % FF2, j = (i / FF2) & 1, b = i / (2 * FF2); pfc[i] = bf2f(UP[(size_t)(b * SEQ + SEQ - 2 + j) * FF2 + c]); }
    for (int i = gt; i < NS * 2 * FF2; i += NGT) { const int c = i % FF2, j = (i / FF2) & 1, s = i / (2 * FF2); sfo[i] = j == 0 ? sfc[(size_t)(s * 2 + 1) * FF2 + c] : bf2f(UP[(size_t)(XS + s) * FF2 + c]); }
}

__device__ __forceinline__ void p_kvq(Frame& F) {
    const int gw = F.bid * 8 + F.wave, NGW = F.G * 8;
    const float* CK = (const float*)(F.ws + WS_CKVQ); bf16* CB = (bf16*)(F.ws + WS_CB); bf16* KRB = (bf16*)(F.ws + WS_KRB); bf16* QAN = (bf16*)(F.ws + WS_QAN);
    const float* ctab = (const float*)(F.ws + WS_ROPE); const float* stab = ctab + NPOSTAB * 32;
    const f32x4 gk = ((const f32x4*)F.in[I_KVANORM])[F.lane];
    float gq[6];
#pragma unroll
    for (int j = 0; j < 6; ++j) gq[j] = F.in[I_BQANORM][F.lane + 64 * j];
    for (int row = gw; row < NVALID; row += NGW) {
        const float* cr = CK + (size_t)row * 768;
        f32x4 lat = ((const f32x4*)cr)[F.lane]; float ss = wave_sum((lat.x * lat.x + lat.y * lat.y) + (lat.z * lat.z + lat.w * lat.w));
        lat = lat * rsqrtf(ss * (1.f / KVL) + EPS) * gk;
        const int posidx = row < TR ? NMETA + (row & (SEQ - 1)) : (row < XS ? row - XM : LP);
        const int i = F.lane & 31; const float x1 = cr[256 + i], x2 = cr[288 + i], cs = ctab[posidx * 32 + i], sn = stab[posidx * 32 + i];
        const float kr = F.lane < 32 ? x1 * cs - x2 * sn : x2 * cs + x1 * sn;
        ((v2u*)(CB + (size_t)row * KVL))[F.lane] = (v2u){pk2(lat.x, lat.y), pk2(lat.z, lat.w)};
        KRB[(size_t)row * ROPE + F.lane] = (bf16)f2bf(kr);
        if (row < TR) { const int b = row >> 11, t = row & (SEQ - 1); ((f32x4*)(F.out + O_PKV + ((size_t)b * LP + NMETA + t) * KVL))[F.lane] = lat; F.out[O_PKR + ((size_t)b * LP + NMETA + t) * ROPE + F.lane] = kr; }
        else if (row < XS) { const int m = row - XM;
            for (int b = 0; b < NB; ++b) { ((f32x4*)(F.out + O_PKV + ((size_t)b * LP + m) * KVL))[F.lane] = lat; F.out[O_PKR + ((size_t)b * LP + m) * ROPE + F.lane] = kr; } }
        else { const int s = row - XS; ((f32x4*)(F.out + O_SKV + (size_t)s * KVL))[F.lane] = lat; F.out[O_SKR + (size_t)s * ROPE + F.lane] = kr; }
        float qa[6]; float sq = 0.f;
#pragma unroll
        for (int j = 0; j < 6; ++j) { qa[j] = cr[320 + F.lane + 64 * j]; sq += qa[j] * qa[j]; }
        sq = wave_sum(sq); const float rq = rsqrtf(sq * (1.f / QL) + EPS);
#pragma unroll
        for (int j = 0; j < 6; ++j) QAN[(size_t)row * QL + F.lane + 64 * j] = (bf16)f2bf(qa[j] * rq * gq[j]);
    }
}
__device__ __forceinline__ void p_qrope(Frame& F) {
    const int gw = F.bid * 8 + F.wave, NGW = F.G * 8;
    bf16* Q = (bf16*)(F.ws + WS_Q); const float* ctab = (const float*)(F.ws + WS_ROPE); const float* stab = ctab + NPOSTAB * 32;
    for (int row = gw; row < NVALID; row += NGW) {
        const int posidx = row < TR ? NMETA + (row & (SEQ - 1)) : (row < XS ? row - XM : LP);
#pragma unroll
        for (int j = 0; j < 4; ++j) { const int idx = F.lane + 64 * j, h = idx >> 5, i = idx & 31; bf16* q = Q + (size_t)row * 1536 + h * HD + NOPE + i;
            const float x1 = bf2f(q[0]), x2 = bf2f(q[32]), cs = ctab[posidx * 32 + i], sn = stab[posidx * 32 + i];
            q[0] = (bf16)f2bf(x1 * cs - x2 * sn); q[32] = (bf16)f2bf(x2 * cs + x1 * sn); }
    }
}

constexpr int SHM_K = 64 * HD * 2, SHM_V = 64 * 128 * 2;
constexpr int ATT_V = 0, ATT_K = 2 * SHM_V, ATT_WS = ATT_K + 2 * SHM_K, ATT_QPE = ATT_WS + 8 * 64 * 4;
static_assert(ATT_QPE + 8 * 4096 <= RING_BYTES, "attention LDS");
#define KSWZ(row, colB) ((row) * 384 + ((colB) ^ ((((row) >> 1) & 7) << 4)))
__device__ __forceinline__ int v_st(int k, int c) { const int kk = (k & ~0xC) | ((k & 4) << 1) | ((k & 8) >> 1); return ((kk >> 3) * 4 + (c >> 5)) * 512 + ((kk & 7) * 32 + (c & 31)) * 2; }
__device__ __forceinline__ int v_rd_base(int lane) { return ((lane & 3) << 3) | (((lane >> 2) & 3) << 6) | (((lane >> 4) & 1) << 5) | (((lane >> 5) & 1) << 8); }
constexpr int v_rd_off(int d0, int ks, int half) { return d0 * 512 + ks * 4096 + half * 2048; }
__device__ __forceinline__ int crow(int r, int hi) { return (r & 3) + 8 * (r >> 2) + 4 * hi; }
__device__ __forceinline__ unsigned cvtpk(float lo, float hi) { unsigned r; asm volatile("v_cvt_pk_bf16_f32 %0, %1, %2" : "=v"(r) : "v"(lo), "v"(hi)); return r; }
constexpr float ATT_THR = 8.f;
__device__ __forceinline__ void partialSM(f32x16& p0, f32x16& p1, float& m_reg, float& mn, float& alpha) {
    float pmax = p0[0];
#pragma unroll
    for (int r = 1; r < 16; ++r) pmax = fmaxf(pmax, p0[r]);
#pragma unroll
    for (int r = 0; r < 16; ++r) pmax = fmaxf(pmax, p1[r]);
    { auto rr = __builtin_amdgcn_permlane32_swap(__float_as_uint(pmax), __float_as_uint(pmax), false, false);
      pmax = fmaxf(__uint_as_float(rr[0]), __uint_as_float(rr[1])); }
    constexpr float C2 = 1.4426950408889634f * MLA_SCALE;
    if (__builtin_expect(__all((pmax - m_reg) * MLA_SCALE <= ATT_THR), 1)) { mn = m_reg; alpha = 1.f; }
    else { mn = fmaxf(m_reg, pmax); alpha = __builtin_amdgcn_exp2f((m_reg - mn) * C2); m_reg = mn; }
    const float mnL = -mn * C2;
#pragma unroll
    for (int r = 0; r < 16; ++r) p0[r] = fmaf(p0[r], C2, mnL);
#pragma unroll
    for (int r = 0; r < 16; ++r) p1[r] = fmaf(p1[r], C2, mnL);
#pragma unroll
    for (int r = 0; r < 16; ++r) p0[r] = __builtin_amdgcn_exp2f(p0[r]);
}
__device__ __forceinline__ void finishSM(f32x16& p0, f32x16& p1, float alpha, float& l_reg, bf16x8& pa0, bf16x8& pa1, bf16x8& pa2, bf16x8& pa3) {
#pragma unroll
    for (int r = 0; r < 16; ++r) p1[r] = __builtin_amdgcn_exp2f(p1[r]);
    float ps = 0;
#pragma unroll
    for (int r = 0; r < 16; ++r) ps += p0[r];
#pragma unroll
    for (int r = 0; r < 16; ++r) ps += p1[r];
    { auto rr = __builtin_amdgcn_permlane32_swap(__float_as_uint(ps), __float_as_uint(ps), false, false);
      ps = __uint_as_float(rr[0]) + __uint_as_float(rr[1]); }
    l_reg = l_reg * alpha + ps;
#define PK4(P, B_, OUT) do { unsigned a0 = cvtpk(P[B_+0], P[B_+1]), a1 = cvtpk(P[B_+2], P[B_+3]);                          \
        unsigned b0 = cvtpk(P[B_+4], P[B_+5]), b1 = cvtpk(P[B_+6], P[B_+7]);                                             \
        auto r0 = __builtin_amdgcn_permlane32_swap(a0, b0, false, false); auto r1 = __builtin_amdgcn_permlane32_swap(a1, b1, false, false); \
        v4u w = {r0[0], r1[0], r0[1], r1[1]}; OUT = *reinterpret_cast<bf16x8*>(&w); } while (0)
    PK4(p0, 0, pa0); PK4(p0, 8, pa1); PK4(p1, 0, pa2); PK4(p1, 8, pa3);
#undef PK4
}
__device__ __forceinline__ void qkt192(f32x16& p0, f32x16& p1, const LAS char* Kb, int r32, int hi, const bf16x8* qr, const LAS char* qpe) {
    p0 = f32x16{}; p1 = f32x16{};
    const LAS char* kb[4];
#pragma unroll
    for (int dd = 0; dd < 4; ++dd) kb[dd] = Kb + KSWZ(r32, (dd * 16 + hi * 8) * 2);
#pragma unroll
    for (int d0 = 0; d0 < 12; ++d0) { const LAS char* a = kb[d0 & 3] + (d0 >> 2) * 128;
        const bf16x8 b0 = *(const LAS bf16x8*)a, b1 = *(const LAS bf16x8*)(a + 32 * 384);
        const bf16x8 qf = d0 < 8 ? qr[d0 & 7] : *(const LAS bf16x8*)(qpe + (d0 & 3) * 1024);
        p0 = __builtin_amdgcn_mfma_f32_32x32x16_bf16(b0, qf, p0, 0, 0, 0);
        p1 = __builtin_amdgcn_mfma_f32_32x32x16_bf16(b1, qf, p1, 0, 0, 0);
        if ((d0 & 3) == 3) __builtin_amdgcn_sched_barrier(0); }
}
__device__ __forceinline__ void pv_tile(f32x16* o, int vb0, bf16x8 pa0, bf16x8 pa1, bf16x8 pa2, bf16x8 pa3) {
#define TRRD(dst, off) asm volatile("ds_read_b64_tr_b16 %0, %1 offset:%2" : "=&v"(dst) : "v"(vb0), "i"(off) : "memory")
#define PV_D0(d0) do { s16x4 l0, l1, l2, l3, h0, h1, h2, h3; constexpr int b_ = v_rd_off(d0, 0, 0); \
        TRRD(l0, b_); TRRD(h0, b_ + 2048); TRRD(l1, b_ + 4096); TRRD(h1, b_ + 6144); TRRD(l2, b_ + 8192); TRRD(h2, b_ + 10240); TRRD(l3, b_ + 12288); TRRD(h3, b_ + 14336); \
        asm volatile("s_waitcnt lgkmcnt(0)" ::: "memory"); __builtin_amdgcn_sched_barrier(0); \
        o[d0] = __builtin_amdgcn_mfma_f32_32x32x16_bf16(pa0, (bf16x8){l0[0], l0[1], l0[2], l0[3], h0[0], h0[1], h0[2], h0[3]}, o[d0], 0, 0, 0);   \
        o[d0] = __builtin_amdgcn_mfma_f32_32x32x16_bf16(pa1, (bf16x8){l1[0], l1[1], l1[2], l1[3], h1[0], h1[1], h1[2], h1[3]}, o[d0], 0, 0, 0);   \
        o[d0] = __builtin_amdgcn_mfma_f32_32x32x16_bf16(pa2, (bf16x8){l2[0], l2[1], l2[2], l2[3], h2[0], h2[1], h2[2], h2[3]}, o[d0], 0, 0, 0);   \
        o[d0] = __builtin_amdgcn_mfma_f32_32x32x16_bf16(pa3, (bf16x8){l3[0], l3[1], l3[2], l3[3], h3[0], h3[1], h3[2], h3[3]}, o[d0], 0, 0, 0); } while (0)
    PV_D0(0); PV_D0(1); PV_D0(2); PV_D0(3);
#undef PV_D0
#undef TRRD
}
__device__ __forceinline__ void attn_qblock(Frame& F, int b, int h, int qb) {
    const int tid = F.tid, wid = F.wave, lane = F.lane, r32 = lane & 31, hi = lane >> 5;
    const bf16* Q = (const bf16*)(F.ws + WS_Q); const bf16* KNV = (const bf16*)(F.ws + WS_KNV); const bf16* KRB = (const bf16*)(F.ws + WS_KRB); bf16* AO = (bf16*)(F.ws + WS_AO);
    LAS char* V_lds = (LAS char*)F.lds + ATT_V; LAS char* K_lds = (LAS char*)F.lds + ATT_K;
    LAS float* wsf = (LAS float*)(F.lds + ATT_WS) + wid * 64; LAS float* li_l = wsf; LAS float* al_l = wsf + 32;
    bf16x8 qr[8]; LAS char* qpe = (LAS char*)F.lds + ATT_QPE + wid * 4096 + lane * 16;
    { const bf16* qp = Q + (size_t)(b * SEQ + qb * 256 + wid * 32 + r32) * 1536 + h * HD + hi * 8;
#pragma unroll
      for (int d0 = 0; d0 < 8; ++d0) qr[d0] = *(const bf16x8*)(qp + d0 * 16);
#pragma unroll
      for (int d0 = 0; d0 < 4; ++d0) *(LAS bf16x8*)(qpe + d0 * 1024) = *(const bf16x8*)(qp + (8 + d0) * 16); }
    const int NT = 1 + 4 * (qb + 1);
    const int sr = tid >> 4, sc = (tid & 15) * 8, rr = tid >> 3, rc = (tid & 7) * 8;
    const int kws = KSWZ(sr, sc * 2), krs = KSWZ(rr, 256 + rc * 2), vst0 = v_st(sr, sc), vst1 = v_st(32 + sr, sc);
    const int vb0 = (int)(unsigned)(uintptr_t)V_lds + v_rd_base(lane);
    const int qlo = qb * 256 + wid * 32, qm = qlo + r32 - 4 * hi;
    bf16x8 st_k0, st_k1, st_v0, st_v1, st_r; const unsigned koff = (unsigned)(h * 128 + sc);
#define KROW(t, kk) ((t) == 0 ? (unsigned)(XM + ((kk) < 16 ? (kk) : 15)) : (unsigned)(b * SEQ + ((t) - 1) * 64 + (kk)))
#define SLOAD(t) do { const unsigned ra = KROW(t, sr) * 2048u + koff, rb = KROW(t, 32 + sr) * 2048u + koff, rq = KROW(t, rr) * (unsigned)ROPE + (unsigned)rc; \
        st_k0 = *(const bf16x8*)(KNV + ra); st_k1 = *(const bf16x8*)(KNV + rb); \
        st_v0 = *(const bf16x8*)(KNV + ra + 1024u); st_v1 = *(const bf16x8*)(KNV + rb + 1024u); \
        st_r = *(const bf16x8*)(KRB + rq); } while (0)
#define SWRITE(bf) do { *(LAS bf16x8*)(K_lds + (bf) * SHM_K + kws) = st_k0; *(LAS bf16x8*)(K_lds + (bf) * SHM_K + kws + 32 * 384) = st_k1; *(LAS bf16x8*)(K_lds + (bf) * SHM_K + krs) = st_r; \
        *(LAS bf16x8*)(V_lds + (bf) * SHM_V + vst0) = st_v0; *(LAS bf16x8*)(V_lds + (bf) * SHM_V + vst1) = st_v1; } while (0)
    SLOAD(0); SWRITE(0); __syncthreads();
    float m_reg = -1e30f, l_reg = 0.f; f32x16 o[4] = {};
    const float NEG = -__builtin_inff();
#pragma unroll 1
    for (int t = 0; t < NT; ++t) {
        const int cur = t & 1;
        if (t + 1 < NT) SLOAD(t + 1);
        f32x16 p0, p1; float mn, al; bf16x8 pa0, pa1, pa2, pa3;
        qkt192(p0, p1, K_lds + cur * SHM_K, r32, hi, qr, qpe);
        if (t == 0) {
#pragma unroll
            for (int r = 0; r < 16; ++r) { const int c = (r & 3) + 8 * (r >> 2) + 4 * hi; if (c >= NMETA) p0[r] = NEG; p1[r] = NEG; }
        } else { const int kb_ = (t - 1) * 64;
            if (kb_ + 63 > qlo) { const int dq = qm - kb_;
#pragma unroll
                for (int r = 0; r < 16; ++r) { const int c = (r & 3) + 8 * (r >> 2); if (dq - c < 0) p0[r] = NEG; if (dq - c - 32 < 0) p1[r] = NEG; } } }
        partialSM(p0, p1, m_reg, mn, al);
        if (__any(al < 1.f)) { if (hi == 0) al_l[r32] = al; LDS_WAIT();
#pragma unroll
            for (int d = 0; d < 4; ++d)
#pragma unroll
                for (int r = 0; r < 16; ++r) o[d][r] *= al_l[crow(r, hi)]; }
        finishSM(p0, p1, al, l_reg, pa0, pa1, pa2, pa3);
        __builtin_amdgcn_sched_barrier(0);
        pv_tile(o, vb0 + cur * SHM_V, pa0, pa1, pa2, pa3);
        if (t + 1 < NT) SWRITE(cur ^ 1);
        __syncthreads();
    }
    if (hi == 0) li_l[r32] = l_reg; LDS_WAIT();
    bf16* Ow = AO + (size_t)(b * SEQ + qb * 256 + wid * 32) * DM + h * 128;
#pragma unroll
    for (int r = 0; r < 16; ++r) { const int orow = crow(r, hi); const float rl = __builtin_amdgcn_rcpf(li_l[orow]);
#pragma unroll
        for (int d0 = 0; d0 < 4; ++d0) { const float v = o[d0][r] * rl; const float vn = __shfl_xor(v, 1);
            if ((r32 & 1) == 0) *(unsigned*)(Ow + (size_t)orow * DM + d0 * 32 + r32) = cvtpk(v, vn); } }
    __syncthreads();
#undef KROW
#undef SLOAD
#undef SWRITE
}
__device__ __forceinline__ void attn_meta(Frame& F) {
    const bf16* Q = (const bf16*)(F.ws + WS_Q); const bf16* KNV = (const bf16*)(F.ws + WS_KNV); const bf16* KRB = (const bf16*)(F.ws + WS_KRB); bf16* AO = (bf16*)(F.ws + WS_AO);
    for (int it = F.wave; it < NMETA * MH; it += 8) {
        const int m = it >> 3, h = it & 7;
        const bf16* q = Q + (size_t)(XM + m) * 1536 + h * HD;
        const float q0 = bf2f(q[F.lane]), q1 = bf2f(q[64 + F.lane]), q2 = bf2f(q[128 + F.lane]);
        float sc[NMETA]; float mx = -1e30f;
#pragma unroll
        for (int k = 0; k < NMETA; ++k) { const bf16* kn = KNV + (size_t)(XM + k) * 2048 + h * 128; const float d = wave_sum(q0 * bf2f(kn[F.lane]) + q1 * bf2f(kn[64 + F.lane]) + q2 * bf2f(KRB[(size_t)(XM + k) * ROPE + F.lane]));
            sc[k] = k <= m ? d * MLA_SCALE : -1e30f; mx = fmaxf(mx, sc[k]); }
        float l = 0.f, o0 = 0.f, o1 = 0.f;
#pragma unroll
        for (int k = 0; k < NMETA; ++k) { const float p = k <= m ? __expf(sc[k] - mx) : 0.f; l += p; const bf16* v = KNV + (size_t)(XM + k) * 2048 + 1024 + h * 128; o0 += p * bf2f(v[F.lane]); o1 += p * bf2f(v[64 + F.lane]); }
        AO[(size_t)(XM + m) * DM + h * 128 + F.lane] = (bf16)f2bf(o0 / l); AO[(size_t)(XM + m) * DM + h * 128 + 64 + F.lane] = (bf16)f2bf(o1 / l);
    }
}
constexpr int PART_STRIDE = 16 + 8 * 256;
constexpr int QL_STRIDE = 8 * 256 + 8 * 64;
__device__ __forceinline__ void attn_sample_item(Frame& F, int s, int half) {
    const int tid = F.tid, lane = F.lane, wid = F.wave;
    const bf16* Q = (const bf16*)(F.ws + WS_Q) + (size_t)(XS + s) * 1536;
    LAS float* qn = (LAS float*)F.lds;
    LAS float* qlat = qn + 8 * 192;
    LAS float* qpe = qlat + 8 * 256;
    LAS float* xm = qpe + 8 * 64;
    LAS float* xl = xm + 64;
    LAS float* xo = xl + 64;
    for (int i = tid; i < 8 * 192; i += 512) qn[i] = bf2f(Q[i]);
    __syncthreads();
    { const float* wuk = F.in[I_WUK];
      for (int e = tid; e < 8 * 256; e += 512) { const int h = e >> 8, r = e & 255; const f32x4* w = (const f32x4*)(wuk + (size_t)r * 1024 + h * 128); const LAS float* qq = qn + h * 192; float acc = 0.f;
#pragma unroll 8
          for (int n4 = 0; n4 < 32; ++n4) { const f32x4 wv = w[n4]; acc += qq[4 * n4] * wv.x + qq[4 * n4 + 1] * wv.y + qq[4 * n4 + 2] * wv.z + qq[4 * n4 + 3] * wv.w; }
          qlat[e] = acc; }
      { const int h = tid >> 6, i = tid & 63; qpe[tid] = qn[h * 192 + 128 + i]; } }
    __syncthreads();
    if (half == 0) { float* ql = (float*)(F.ws + WS_QLAT) + (size_t)s * QL_STRIDE; for (int i = tid; i < QL_STRIDE; i += 512) ql[i] = qlat[i]; }
    float ql4[8][4], qp[8];
#pragma unroll
    for (int h = 0; h < 8; ++h) { const f32x4 t = *(const LAS f32x4*)(qlat + h * 256 + 4 * lane); ql4[h][0] = t.x; ql4[h][1] = t.y; ql4[h][2] = t.z; ql4[h][3] = t.w; qp[h] = qpe[h * 64 + lane]; }
    float o[8][4]; float m_run = -1e30f, l_run = 0.f;
#pragma unroll
    for (int h = 0; h < 8; ++h) { o[h][0] = 0.f; o[h][1] = 0.f; o[h][2] = 0.f; o[h][3] = 0.f; }
    const int* pt = (const int*)F.in[I_PT] + s * NPAGE + half * 32 + wid * 4;
    const float* ckv = F.in[I_CKV]; const float* ckr = F.in[I_CKR];
#pragma unroll 1
    for (int pg = 0; pg < 4; ++pg) {
        const int page = __builtin_amdgcn_readfirstlane(pt[pg]);
        const f32x4* cp = (const f32x4*)(ckv + (size_t)page * PAGE * KVL) + lane; const float* rp = ckr + (size_t)page * PAGE * ROPE + lane;
#pragma unroll 1
        for (int k0 = 0; k0 < PAGE; k0 += 8) {
            f32x4 c[8]; float kr[8];
#pragma unroll
            for (int k = 0; k < 8; ++k) { c[k] = cp[(size_t)(k0 + k) * 64]; kr[k] = rp[(size_t)(k0 + k) * ROPE]; }
            float a[64];
#pragma unroll
            for (int k = 0; k < 8; ++k)
#pragma unroll
                for (int h = 0; h < 8; ++h) a[k * 8 + h] = (ql4[h][0] * c[k].x + ql4[h][1] * c[k].y) + (ql4[h][2] * c[k].z + ql4[h][3] * c[k].w) + qp[h] * kr[k];
#pragma unroll
            for (int st = 0; st < 6; ++st) { const int M = 32 >> st, n = 32 >> st; const bool bit = (lane & M) != 0;
#pragma unroll
                for (int i = 0; i < n; ++i) { const float keep = bit ? a[i + n] : a[i], send = bit ? a[i] : a[i + n]; a[i] = keep + __shfl_xor(send, M); } }
            const float sc = a[0] * MLA_SCALE;
            float mx = sc; mx = fmaxf(mx, __shfl_xor(mx, 8)); mx = fmaxf(mx, __shfl_xor(mx, 16)); mx = fmaxf(mx, __shfl_xor(mx, 32));
            const float mnew = fmaxf(m_run, mx), p = __expf(sc - mnew), alpha = __expf(m_run - mnew);
            float ps = p; ps += __shfl_xor(ps, 8); ps += __shfl_xor(ps, 16); ps += __shfl_xor(ps, 32);
            l_run = l_run * alpha + ps; m_run = mnew;
#pragma unroll
            for (int h = 0; h < 8; ++h) { const float ah = __builtin_bit_cast(float, __builtin_amdgcn_readlane(__builtin_bit_cast(int, alpha), h));
                o[h][0] *= ah; o[h][1] *= ah; o[h][2] *= ah; o[h][3] *= ah;
#pragma unroll
                for (int k = 0; k < 8; ++k) { const float pk = __builtin_bit_cast(float, __builtin_amdgcn_readlane(__builtin_bit_cast(int, p), k * 8 + h));
                    o[h][0] += pk * c[k].x; o[h][1] += pk * c[k].y; o[h][2] += pk * c[k].z; o[h][3] += pk * c[k].w; } }
        }
    }
    if (lane < 8) { xm[wid * 8 + lane] = m_run; xl[wid * 8 + lane] = l_run; }
#pragma unroll
    for (int h = 0; h < 8; ++h) *(LAS f32x4*)(xo + (size_t)(wid * 8 + h) * 256 + 4 * lane) = (f32x4){o[h][0], o[h][1], o[h][2], o[h][3]};
    __syncthreads();
    float* part = (float*)(F.ws + WS_PART) + (size_t)(s * 2 + half) * PART_STRIDE;
    for (int e = tid; e < 8 * 256; e += 512) { const int h = e >> 8, r = e & 255; float M = -1e30f;
#pragma unroll
        for (int w = 0; w < 8; ++w) M = fmaxf(M, xm[w * 8 + h]);
        float acc = 0.f, L = 0.f;
#pragma unroll
        for (int w = 0; w < 8; ++w) { const float e_ = __expf(xm[w * 8 + h] - M); acc += xo[(size_t)(w * 8 + h) * 256 + r] * e_; L += xl[w * 8 + h] * e_; }
        part[16 + e] = acc; if (r == 0) { part[h] = M; part[8 + h] = L; } }
    __syncthreads();
}
__device__ __forceinline__ void attn_sample_combine(Frame& F, int s) {
    const int tid = F.tid, lane = F.lane, wid = F.wave;
    LAS float* ssf = (LAS float*)F.lds;
    LAS float* olat = ssf + 64;
    const float* ql = (const float*)(F.ws + WS_QLAT) + (size_t)s * QL_STRIDE; const float* cs = F.out + O_SKV + (size_t)s * KVL; const float* krs = F.out + O_SKR + (size_t)s * ROPE;
    { const int h = wid; const f32x4 qv = ((const f32x4*)(ql + h * 256))[lane], cv = ((const f32x4*)cs)[lane];
      const float d = wave_sum((qv.x * cv.x + qv.y * cv.y) + (qv.z * cv.z + qv.w * cv.w) + ql[8 * 256 + h * 64 + lane] * krs[lane]); if (lane == 0) ssf[h] = d * MLA_SCALE; }
    __syncthreads();
    const float* p0 = (const float*)(F.ws + WS_PART) + (size_t)(s * 2) * PART_STRIDE; const float* p1 = p0 + PART_STRIDE;
    for (int e = tid; e < 8 * 256; e += 512) { const int h = e >> 8, r = e & 255; const float m0 = p0[h], m1 = p1[h], ms = ssf[h], M = fmaxf(fmaxf(m0, m1), ms);
        const float e0 = __expf(m0 - M), e1 = __expf(m1 - M), es = __expf(ms - M), L = p0[8 + h] * e0 + p1[8 + h] * e1 + es;
        olat[e] = (p0[16 + e] * e0 + p1[16 + e] * e1 + es * cs[r]) / L; }
    __syncthreads();
    const float* wuv = F.in[I_WUV]; bf16* AO = (bf16*)(F.ws + WS_AO) + (size_t)(XS + s) * DM;
    for (int e = tid; e < 8 * 128; e += 512) { const int h = e >> 7; const LAS float* ol = olat + h * 256; float acc = 0.f;
#pragma unroll 8
        for (int r = 0; r < 256; ++r) acc += ol[r] * wuv[(size_t)r * 1024 + e];
        AO[e] = (bf16)f2bf(acc); }
    __syncthreads();
}

constexpr int NPHASE = 22;
__global__ void __launch_bounds__(512, 2) mk_fwd(Params P) {
    extern __shared__ __attribute__((aligned(16))) unsigned char lds_raw[];
    Frame F;
    F.lds = (LAS unsigned char*)lds_raw; F.tid = threadIdx.x; F.lane = F.tid & 63; F.wave = __builtin_amdgcn_readfirstlane(F.tid >> 6);
    F.G = gridDim.x; F.bid = blockIdx.x; F.in = P.in; F.out = P.out; F.ws = P.ws;
    volatile LAS unsigned* MISC = (volatile LAS unsigned*)(F.lds + MISC_OFF);
    for (int u = F.tid; u < (LDS_BYTES - RING_BYTES) / 4; u += 512) ((LAS unsigned*)(F.lds + RING_BYTES))[u] = 0u;
    __syncthreads();
    const int lo = P.ph_lo, hi = P.ph_hi;
    XcdBarrier bar; bar.bar = (unsigned*)(P.ws + WS_CTL) + CW_BAR; bar.x = 0; bar.st = nullptr;
    if (hi - lo > 1) bar = xcd_barrier_post((unsigned*)(P.ws + WS_CTL) + CW_BAR, MISC + 8);
#define IN(k) (lo <= (k) && (k) < hi)
#define SEAM(k) do { if (IN(k) && IN((k) + 1)) xcd_barrier(bar); } while (0)
    unsigned char* ws = P.ws;
    bf16* XH = (bf16*)(ws + WS_XH); float* TMP = (float*)(ws + WS_TMP);

    if (IN(0)) { p0_prologue(F, P); } SEAM(0);
    if (IN(1)) { pg8::Gemm g{XH, (const bf16*)(ws + WS_WIN), TM, 4096, DM}; pg8::StaticOrder S; S.init(TM, 4096, F.G, F.bid); pg8::EpiBf16 E{(bf16*)(ws + WS_QKVZ), 4096};
        pg8::gemm_phase<pg8::EpiBf16, pg8::StaticOrder, true, true>(F.lds, g, S, E); } SEAM(1);
    if (IN(2)) { for (int it = F.bid; it < NB * GH + NS * GH; it += F.G) gdn_item(F, it); } SEAM(2);
    if (IN(3)) { p3_gate(F); } SEAM(3);
    if (IN(4)) { pg8::Gemm g{(const bf16*)(ws + WS_GO), (const bf16*)(ws + WS_WGOUT), TM, DM, DM}; pg8::StaticOrder S; S.init(TM, DM, F.G, F.bid); pg8::EpiF32 E{TMP, DM};
        pg8::gemm_phase<pg8::EpiF32, pg8::StaticOrder, true, true>(F.lds, g, S, E); } SEAM(4);
    if (IN(5)) { p_postnorm<false>(F, F.in[I_ANPOST]); } SEAM(5);
    if (IN(6)) { pg8::Gemm g{XH, (const bf16*)(ws + WS_WUP0), TM, FF2, DM}; pg8::StaticOrder S; S.init(TM, FF2, F.G, F.bid); pg8::EpiBf16 E{(bf16*)(ws + WS_UP), FF2};
        pg8::gemm_phase<pg8::EpiBf16, pg8::StaticOrder, true, true>(F.lds, g, S, E); } SEAM(6);
    if (IN(7)) { p_ffn_act(F, 0); } SEAM(7);
    if (IN(8)) { pg8::Gemm g{(const bf16*)(ws + WS_ACT), (const bf16*)(ws + WS_WDN0), TM, DM, FF}; pg8::StaticOrder S; S.init(TM, DM, F.G, F.bid); pg8::EpiF32 E{TMP, DM};
        pg8::gemm_phase<pg8::EpiF32, pg8::StaticOrder, true, true>(F.lds, g, S, E); } SEAM(8);
    if (IN(9)) { p_postnorm<false>(F, F.in[I_FNPOST]); } SEAM(9);
    if (IN(10)) { pg8::Gemm g{XH, (const bf16*)(ws + WS_WKVQA), TM, 768, DM}; pg8::StaticOrder S; S.init(TM, 768, F.G, F.bid); pg8::EpiF32 E{(float*)(ws + WS_CKVQ), 768};
        pg8::gemm_phase<pg8::EpiF32, pg8::StaticOrder, true, true>(F.lds, g, S, E); } SEAM(10);
    if (IN(11)) { p_kvq(F); } SEAM(11);
    if (IN(12)) {
        { pg8::Gemm g{(const bf16*)(ws + WS_QAN), (const bf16*)(ws + WS_WQB), TM, 1536, QL}; pg8::StaticOrder S; S.init(TM, 1536, F.G, F.bid); pg8::EpiBf16 E{(bf16*)(ws + WS_Q), 1536};
          pg8::gemm_phase<pg8::EpiBf16, pg8::StaticOrder, true, true>(F.lds, g, S, E); }
        __syncthreads();
        { pg8::Gemm g{(const bf16*)(ws + WS_CB), (const bf16*)(ws + WS_WUKV), TM, 2048, KVL}; pg8::StaticOrder S; S.init(TM, 2048, F.G, F.bid); pg8::EpiBf16 E{(bf16*)(ws + WS_KNV), 2048};
          pg8::gemm_phase<pg8::EpiBf16, pg8::StaticOrder, true, true>(F.lds, g, S, E); }
    } SEAM(12);
    if (IN(13)) { p_qrope(F); } SEAM(13);
    if (IN(14)) {
        if (F.bid == F.G - 1) attn_meta(F);
        for (int L = F.bid; L < NB * MH * 4; L += F.G) { const int bh = L >> 2, x = L & 3;
#pragma unroll 1
            for (int pass = 0; pass < 2; ++pass) attn_qblock(F, bh >> 3, bh & 7, pass ? 7 - x : x); }
        for (int it = F.bid; it < NS * 2; it += F.G) attn_sample_item(F, it >> 1, it & 1);
    } SEAM(14);
    if (IN(15)) { for (int s = F.bid; s < NS; s += F.G) attn_sample_combine(F, s); } SEAM(15);
    if (IN(16)) { pg8::Gemm g{(const bf16*)(ws + WS_AO), (const bf16*)(ws + WS_WMOUT), TM, DM, DM}; pg8::StaticOrder S; S.init(TM, DM, F.G, F.bid); pg8::EpiF32 E{TMP, DM};
        pg8::gemm_phase<pg8::EpiF32, pg8::StaticOrder, true, true>(F.lds, g, S, E); } SEAM(16);
    if (IN(17)) { p_postnorm<false>(F, F.in[I_BNPOST]); } SEAM(17);
    if (IN(18)) { pg8::Gemm g{XH, (const bf16*)(ws + WS_WUP1), TM, FF2, DM}; pg8::StaticOrder S; S.init(TM, FF2, F.G, F.bid); pg8::EpiBf16 E{(bf16*)(ws + WS_UP), FF2};
        pg8::gemm_phase<pg8::EpiBf16, pg8::StaticOrder, true, true>(F.lds, g, S, E); } SEAM(18);
    if (IN(19)) { p_ffn_act(F, 1); } SEAM(19);
    if (IN(20)) { pg8::Gemm g{(const bf16*)(ws + WS_ACT), (const bf16*)(ws + WS_WDN1), TM, DM, FF}; pg8::StaticOrder S; S.init(TM, DM, F.G, F.bid); pg8::EpiF32 E{TMP, DM};
        pg8::gemm_phase<pg8::EpiF32, pg8::StaticOrder, true, true>(F.lds, g, S, E); } SEAM(20);
    if (IN(21)) { p_postnorm<true>(F, F.in[I_FNPOST] + DM); }
#undef IN
#undef SEAM
}

#ifndef MK_PER_PHASE
#define MK_PER_PHASE 1
#endif
extern "C" void kernel_launch(void* const* d_in, const int* in_sizes, int n_in, void* d_out, int out_size, void* d_ws, size_t ws_size, hipStream_t stream) {
    static int grid = 0;
    if (grid == 0) {
        if (n_in != N_IN || (size_t)out_size != O_END || ws_size < WS_END) { fprintf(stderr, "kernel_launch: unexpected shapes: n_in %d out %d ws %zu (need %zu)\n", n_in, out_size, ws_size, (size_t)WS_END); grid = -1; return; }
        int dev = 0, cus = 0, per_cu = 0;
        if (hipGetDevice(&dev) != hipSuccess || hipDeviceGetAttribute(&cus, hipDeviceAttributeMultiprocessorCount, dev) != hipSuccess) { grid = -1; return; }
        if (hipFuncSetAttribute((const void*)mk_fwd, hipFuncAttributeMaxDynamicSharedMemorySize, LDS_BYTES) != hipSuccess) { fprintf(stderr, "kernel_launch: hipFuncSetAttribute failed\n"); grid = -1; return; }
        if (hipOccupancyMaxActiveBlocksPerMultiprocessor(&per_cu, (const void*)mk_fwd, 512, LDS_BYTES) != hipSuccess || per_cu < 1) fprintf(stderr, "kernel_launch: occupancy query says %d\n", per_cu);
        (void)hipGetLastError();
        grid = cus;
    }
    if (grid < 0) return;
    (void)hipMemsetAsync((char*)d_ws + WS_CTL, 0, CTL_ZERO_BYTES, stream);
    Params P{};
    for (int i = 0; i < N_IN; ++i) P.in[i] = (const float*)d_in[i];
    P.out = (float*)d_out; P.ws = (unsigned char*)d_ws;
    unsigned char* ws = (unsigned char*)d_ws;
    const float* const* in = P.in;
    P.jobs[0] = ConvJob{in[I_AWIN], in[I_ANPRE], (bf16*)(ws + WS_WIN), DM, 4096, GIN, 0};
    P.jobs[1] = ConvJob{in[I_AWOUT], nullptr, (bf16*)(ws + WS_WGOUT), DM, DM, DM, 0};
    P.jobs[2] = ConvJob{in[I_FWUP], in[I_FNPRE], (bf16*)(ws + WS_WUP0), DM, FF2, FF2, 0};
    P.jobs[3] = ConvJob{in[I_FWUP] + (size_t)DM * FF2, in[I_FNPRE] + DM, (bf16*)(ws + WS_WUP1), DM, FF2, FF2, 0};
    P.jobs[4] = ConvJob{in[I_FWDOWN], nullptr, (bf16*)(ws + WS_WDN0), FF, DM, DM, 0};
    P.jobs[5] = ConvJob{in[I_FWDOWN] + (size_t)FF * DM, nullptr, (bf16*)(ws + WS_WDN1), FF, DM, DM, 0};
    P.jobs[6] = ConvJob{in[I_KVWA], in[I_KVNORM], (bf16*)(ws + WS_WKVQA), DM, 320, 320, 0};
    P.jobs[7] = ConvJob{in[I_BWQA], in[I_BNPRE], (bf16*)(ws + WS_WKVQA), DM, QL, QL, 320};
    P.jobs[8] = ConvJob{in[I_BWQB], nullptr, (bf16*)(ws + WS_WQB), QL, 1536, 1536, 0};
    P.jobs[9] = ConvJob{in[I_WUK], nullptr, (bf16*)(ws + WS_WUKV), KVL, 1024, 1024, 0};
    P.jobs[10] = ConvJob{in[I_WUV], nullptr, (bf16*)(ws + WS_WUKV), KVL, 1024, 1024, 1024};
    P.jobs[11] = ConvJob{in[I_BWOUT], nullptr, (bf16*)(ws + WS_WMOUT), DM, DM, DM, 0};
#if MK_PER_PHASE
    for (int ph = 0; ph < NPHASE; ++ph) { P.ph_lo = ph; P.ph_hi = ph + 1; hipLaunchKernelGGL(mk_fwd, dim3(grid), dim3(512), LDS_BYTES, stream, P); }
#else
    P.ph_lo = 0; P.ph_hi = NPHASE; hipLaunchKernelGGL(mk_fwd, dim3(grid), dim3(512), LDS_BYTES, stream, P);
#endif
    const hipError_t le = hipPeekAtLastError();
    if (le != hipSuccess) fprintf(stderr, "kernel_launch: launch failed: %s\n", hipGetErrorName(le));
}
```

```cpp
#include <hip/hip_runtime.h>
#include <cstdio>
#include <cstdint>
namespace pg8 {
#define PG8_LAS __attribute__((address_space(3)))
typedef unsigned short bf16_t;
typedef short bf16x8 __attribute__((ext_vector_type(8)));
typedef float f32x4 __attribute__((ext_vector_type(4)));
typedef unsigned u32x4 __attribute__((ext_vector_type(4)));
constexpr int BM = 256, BK = 64, HALF = 128, HTB = HALF * BK * 2  , STAGE_BYTES = 8 * HTB, NXCD = 8, WGM = 8;

__host__ __device__ __forceinline__ int lds_byte(int r, int c) { const int st = (r >> 4) * 2 + (c >> 5), rr = r & 15, cc = c & 31, ob = rr * 64 + cc * 2; return st * 1024 + (ob ^ (((ob >> 9) & 1) << 5)); }
__host__ __device__ __forceinline__ void stage_rc(int b, int& R, int& C) { const int st = b / 1024, sb = b % 1024, swz = sb ^ (((sb >> 9) & 1) << 5); R = (st >> 1) * 16 + swz / 64; C = (st & 1) * 32 + (swz % 64) / 2; }
__host__ __device__ __forceinline__ int perm32(int rho) { const int n = rho >> 4, i = rho & 15; return 8 * (i >> 2) + 4 * n + (i & 3); }

struct Unit { int pm, pn; };
struct Gemm { const bf16_t* A; const bf16_t* Bt; int M, N, K; };

struct StaticOrder {
    int nM, nN, nwg, G, c, rep;
    __host__ __device__ void init(int M, int N, int G_, int c_, int rep_ = 1) { nM = M / BM; nN = N / BM; nwg = nM * nN; G = G_; c = c_; rep = rep_; }
    __host__ __device__ bool next(int i, Unit& u) const {
        const long L = (long)i * G + c; if (L >= (long)nwg * rep) return false;
        int wgid = (int)(L % nwg); { const int q = nwg / NXCD, r = nwg % NXCD, xcd = wgid % NXCD, off = wgid / NXCD; wgid = (xcd < r ? xcd * (q + 1) : r * (q + 1) + (xcd - r) * q) + off; }
        const int nig = WGM * nN, gid = wgid / nig, fm = gid * WGM, gsz = (nM - fm) < WGM ? (nM - fm) : WGM;
        u.pm = fm + ((wgid % nig) % gsz); u.pn = (wgid % nig) / gsz; return true;
    }
    __device__ __forceinline__ void a_ready(const Unit&) const {}
    __device__ __forceinline__ void done(const Unit&) const {}
};
typedef float cvt_f32x2 __attribute__((ext_vector_type(2)));
typedef __bf16 cvt_bf16x2 __attribute__((ext_vector_type(2)));
__device__ __forceinline__ unsigned cvt_pk_bf16(float lo, float hi) { const cvt_f32x2 v = {lo, hi}; return __builtin_bit_cast(unsigned, __builtin_convertvector(v, cvt_bf16x2)); }
typedef float f32x2 __attribute__((ext_vector_type(2)));
struct EpiF32 {
    static constexpr bool PERM = false, AFTER_DRAIN = false, WPF = false;
    float* C; int ldc;
    __device__ __forceinline__ void operator()(const f32x4 (&acc)[2][2][4][2], const Unit& u, int wr, int wc, int fr, int fq) const {
        const int row0 = u.pm * BM + wr * 64 + fr, col0 = u.pn * BM + wc * 32 + 4 * fq;
#pragma unroll
        for (int ai = 0; ai < 2; ++ai)
#pragma unroll
            for (int m = 0; m < 4; ++m) { float* rowp = C + (size_t)(row0 + ai * HALF + m * 16) * ldc + col0;
#pragma unroll
                for (int bj = 0; bj < 2; ++bj)
#pragma unroll
                    for (int n = 0; n < 2; ++n) *(f32x4*)(rowp + bj * HALF + n * 16) = acc[ai][bj][m][n]; }
    }
};
struct EpiBf16 {
    static constexpr bool PERM = true, AFTER_DRAIN = false, WPF = false;
    bf16_t* O; int ldc;
    __device__ __forceinline__ void operator()(const f32x4 (&acc)[2][2][4][2], const Unit& u, int wr, int wc, int fr, int fq) const {
        const int row0 = u.pm * BM + wr * 64 + fr, col0 = u.pn * BM + wc * 32 + 8 * fq;
#pragma unroll
        for (int ai = 0; ai < 2; ++ai)
#pragma unroll
            for (int m = 0; m < 4; ++m) { bf16_t* rowp = O + (size_t)(row0 + ai * HALF + m * 16) * ldc + col0;
#pragma unroll
                for (int bj = 0; bj < 2; ++bj) { const f32x4 v0 = acc[ai][bj][m][0], v1 = acc[ai][bj][m][1];
                    u32x4 w; w.x = cvt_pk_bf16(v0[0], v0[1]); w.y = cvt_pk_bf16(v0[2], v0[3]); w.z = cvt_pk_bf16(v1[0], v1[1]); w.w = cvt_pk_bf16(v1[2], v1[3]);
                    *(u32x4*)(rowp + bj * HALF) = w; } }
    }
};
struct EpiFfnAct {
    static constexpr bool PERM = false, AFTER_DRAIN = false, WPF = true;
    static constexpr int WSLOT_OFF = 131072;
    __device__ __forceinline__ void prefetch(PG8_LAS unsigned char* lds, const Unit& u, int par, int wid, int lane) const {
        constexpr int FFC = 2816, FF2C = 5632;
        if (wid < 4) { const int s_ = 2 * wid + (lane >> 5), isv = s_ & 1, tap = s_ >> 1; const float* src = (tap < 3 ? cw + tap * FF2C : cb) + isv * FFC + 128 * u.pn + (lane & 31) * 4;
            __builtin_amdgcn_global_load_lds((const unsigned*)src, (PG8_LAS unsigned*)(lds + WSLOT_OFF + par * 4096 + wid * 1024), 16, 0, 0); }
    }
    bf16_t* ACT; float* RAWH; float* RAWX; const float* cw; const float* cb; int nrealp;
    static __device__ __forceinline__ float shr_prev(float prev, float x, int) { return x; }
    template <int D> static __device__ __forceinline__ float rowprev(float prev, float x) {
        const int o = __builtin_amdgcn_update_dpp(0, __builtin_bit_cast(int, prev), 0x100 + (16 - D), 0xF, 0xF, true);
        return __builtin_bit_cast(float, __builtin_amdgcn_update_dpp(o, __builtin_bit_cast(int, x), 0x110 + D, 0xF, 0xF, false));
    }
    __device__ __forceinline__ void operator()(const f32x4 (&acc)[2][2][4][2], const Unit& u, int wr, int wc, int fr, int fq, PG8_LAS unsigned char* lds, int par) const {
        constexpr int FFC = 2816, FF2C = 5632;
        f32x4 w0g[2], w1g[2], w2g[2], w0v[2], w1v[2], w2v[2], bg[2], bv[2];
        const PG8_LAS float* ws_ = (const PG8_LAS float*)(lds + WSLOT_OFF + par * 4096);
#pragma unroll
        for (int bj = 0; bj < 2; ++bj) { const int cl = 16 * (4 * bj + wc) + 4 * fq;
            w0g[bj] = *(const PG8_LAS f32x4*)(ws_ + cl); w0v[bj] = *(const PG8_LAS f32x4*)(ws_ + 128 + cl); w1g[bj] = *(const PG8_LAS f32x4*)(ws_ + 256 + cl); w1v[bj] = *(const PG8_LAS f32x4*)(ws_ + 384 + cl);
            w2g[bj] = *(const PG8_LAS f32x4*)(ws_ + 512 + cl); w2v[bj] = *(const PG8_LAS f32x4*)(ws_ + 640 + cl); bg[bj] = *(const PG8_LAS f32x4*)(ws_ + 768 + cl); bv[bj] = *(const PG8_LAS f32x4*)(ws_ + 896 + cl); }
#pragma unroll
        for (int bj = 0; bj < 2; ++bj)
#pragma unroll
            for (int ai = 0; ai < 2; ++ai) {
                const int G = 8 * u.pn + 4 * bj + wc, ch0 = 16 * G + 4 * fq, co0 = 32 * G + 4 * fq;
                const int rowg = u.pm * BM + ai * HALF + wr * 64;
#pragma unroll
                for (int m = 0; m < 4; ++m) {
                    const f32x4 xg = acc[ai][bj][m][0], xv = acc[ai][bj][m][1];
                    const f32x4 pg = m > 0 ? acc[ai][bj][m > 0 ? m - 1 : 0][0] : (f32x4){0.f, 0.f, 0.f, 0.f}, pv = m > 0 ? acc[ai][bj][m > 0 ? m - 1 : 0][1] : (f32x4){0.f, 0.f, 0.f, 0.f};
                    f32x4 g1, g2, v1, v2;
#pragma unroll
                    for (int e = 0; e < 4; ++e) { g1[e] = rowprev<1>(pg[e], xg[e]); g2[e] = rowprev<2>(pg[e], xg[e]); v1[e] = rowprev<1>(pv[e], xv[e]); v2[e] = rowprev<2>(pv[e], xv[e]); }
                    const f32x4 ug = w0g[bj] * g2 + w1g[bj] * g1 + w2g[bj] * xg + bg[bj], uv = w0v[bj] * v2 + w1v[bj] * v1 + w2v[bj] * xv + bv[bj];
                    const f32x4 den = ug * (-1.4426950408889634f); f32x4 sg;
#pragma unroll
                    for (int e = 0; e < 4; ++e) sg[e] = __builtin_amdgcn_rcpf(1.f + __builtin_amdgcn_exp2f(den[e]));
                    const f32x4 a = ug * sg * uv;
                    typedef unsigned u32x2 __attribute__((ext_vector_type(2)));
                    *(u32x2*)(ACT + (size_t)(rowg + 16 * m + fr) * FFC + ch0) = (u32x2){cvt_pk_bf16(a[0], a[1]), cvt_pk_bf16(a[2], a[3])};
                    if (m == 0 && fr < 2) { float* rp = RAWH + ((size_t)(rowg >> 6) * 4 + fr) * FF2C + co0; *(f32x4*)rp = xg; *(f32x4*)(rp + 16) = xv; }
                    if (m == 3 && fr >= 14) { float* rp = RAWH + ((size_t)(rowg >> 6) * 4 + 2 + (fr - 14)) * FF2C + co0; *(f32x4*)rp = xg; *(f32x4*)(rp + 16) = xv; }
                }
            }
    }
};
struct EpiInConv {
    static constexpr bool PERM = true, AFTER_DRAIN = false, WPF = true;
    bf16_t* O; float* RAWQ; const float* cw;
    __device__ __forceinline__ void prefetch(PG8_LAS unsigned char* lds, const Unit& u, int par, int wid, int lane) const {
        if (wid < 4 && u.pn * BM < 3072) __builtin_amdgcn_global_load_lds((const unsigned*)(cw + wid * 3072 + u.pn * BM + lane * 4), (PG8_LAS unsigned*)(lds + EpiFfnAct::WSLOT_OFF + par * 4096 + wid * 1024), 16, 0, 0);
    }
    __device__ __forceinline__ void operator()(const f32x4 (&acc)[2][2][4][2], const Unit& u, int wr, int wc, int fr, int fq, PG8_LAS unsigned char* lds, int par) const {
        constexpr int LDO = 4096, NQKV = 3072;
        const bool conv = u.pn * BM < NQKV;
        const PG8_LAS float* ws_ = (const PG8_LAS float*)(lds + EpiFfnAct::WSLOT_OFF + par * 4096);
#pragma unroll
        for (int bj = 0; bj < 2; ++bj) {
            asm volatile("" ::: "memory");
            const int col0 = u.pn * BM + bj * HALF + wc * 32 + 8 * fq;
            f32x4 w[4][2];
#pragma unroll
            for (int j = 0; j < 4; ++j) { const int cl = bj * HALF + wc * 32 + 8 * fq; w[j][0] = *(const PG8_LAS f32x4*)(ws_ + j * 256 + cl); w[j][1] = *(const PG8_LAS f32x4*)(ws_ + j * 256 + cl + 4); }
#pragma unroll
            for (int ai = 0; ai < 2; ++ai) {
                const int rowg = u.pm * BM + ai * HALF + wr * 64;
#pragma unroll
                for (int m = 0; m < 4; ++m) {
                    f32x4 o[2];
#pragma unroll
                    for (int n = 0; n < 2; ++n) { const f32x4 x = acc[ai][bj][m][n]; const f32x4 pz = {0.f, 0.f, 0.f, 0.f}; const f32x4 p = m > 0 ? acc[ai][bj][m > 0 ? m - 1 : 0][n] : pz;
                        if (conv) { f32x4 x1, x2, x3;
#pragma unroll
                            for (int e = 0; e < 4; ++e) { x1[e] = EpiFfnAct::rowprev<1>(p[e], x[e]); x2[e] = EpiFfnAct::rowprev<2>(p[e], x[e]); x3[e] = EpiFfnAct::rowprev<3>(p[e], x[e]); }
                            const f32x4 a = (w[0][n] * x3 + w[1][n] * x2) + (w[2][n] * x1 + w[3][n] * x), den = a * (-1.4426950408889634f); f32x4 sg;
#pragma unroll
                            for (int e = 0; e < 4; ++e) sg[e] = __builtin_amdgcn_rcpf(1.f + __builtin_amdgcn_exp2f(den[e]));
                            o[n] = a * sg;
                        } else o[n] = x; }
                    u32x4 wv; wv.x = cvt_pk_bf16(o[0][0], o[0][1]); wv.y = cvt_pk_bf16(o[0][2], o[0][3]); wv.z = cvt_pk_bf16(o[1][0], o[1][1]); wv.w = cvt_pk_bf16(o[1][2], o[1][3]);
                    *(u32x4*)(O + (size_t)(rowg + 16 * m + fr) * LDO + col0) = wv;
                    if (conv) {
                        if (m == 0 && fr < 3) { float* rp = RAWQ + ((size_t)(rowg >> 6) * 6 + fr) * NQKV + col0; *(f32x4*)rp = acc[ai][bj][m][0]; *(f32x4*)(rp + 4) = acc[ai][bj][m][1]; }
                        if (m == 3 && fr >= 13) { float* rp = RAWQ + ((size_t)(rowg >> 6) * 6 + 3 + (fr - 13)) * NQKV + col0; *(f32x4*)rp = acc[ai][bj][m][0]; *(f32x4*)(rp + 4) = acc[ai][bj][m][1]; }
                    }
                }
            }
        }
    }
};
template <class Epi, class Sched, bool ALIGN_EPI = false, bool SP2 = false>
__device__ __forceinline__ void gemm_phase(PG8_LAS unsigned char* lds, const Gemm g, const Sched& S, const Epi& E) {
    int tid_ = threadIdx.x; asm volatile("" : "+v"(tid_));
    const int tid = tid_, wid = __builtin_amdgcn_readfirstlane(tid >> 6), lane = tid & 63, wr = wid >> 2, wc = wid & 3, fr = lane & 15, fq = lane >> 4;
    const int K = g.K, nt = K / BK;
    unsigned voffA[2], voffB[2];
#pragma unroll
    for (int i = 0; i < 2; ++i) { int R, C; stage_rc(tid * 16 + i * 8192, R, C); const int Rb = Epi::PERM ? ((R & ~31) + perm32(R & 31)) : R;
        voffA[i] = (unsigned)(R * K + C) * 2u; voffB[i] = (unsigned)(Rb * K + C) * 2u; }
    const size_t kstep = (size_t)(BK * 2);
    const size_t hstep = (size_t)HALF * K * 2;
    const size_t tstep = 2 * hstep;
    const unsigned ldsw = (unsigned)wid * 1024u;
    const int aoff = lds_byte(wr * 64 + fr, fq * 8), boff = lds_byte(wc * 32 + fr, fq * 8);
#define PG8_SA(b, h) (((b) * 2 + (h)) * HTB)
#define PG8_SB(b, h) ((4 + (b) * 2 + (h)) * HTB)
#define PG8_STAGE(bufoff, gbase, voff) do { _Pragma("unroll") for (int _i = 0; _i < 2; ++_i) \
        __builtin_amdgcn_global_load_lds((const unsigned*)((const char*)(gbase) + (voff)[_i]), (PG8_LAS unsigned*)(lds + (bufoff) + ldsw + _i * 8192), 16, 0, 0); } while (0)
#define PG8_LDA(dst, b, h) do { _Pragma("unroll") for (int m = 0; m < 4; ++m) _Pragma("unroll") for (int k = 0; k < 2; ++k) dst[m][k] = *(const PG8_LAS bf16x8*)(lds + PG8_SA(b, h) + aoff + m * 2048 + k * 1024); } while (0)
#define PG8_LDB(dst, b, h) do { _Pragma("unroll") for (int n = 0; n < 2; ++n) _Pragma("unroll") for (int k = 0; k < 2; ++k) dst[n][k] = *(const PG8_LAS bf16x8*)(lds + PG8_SB(b, h) + boff + n * 2048 + k * 1024); } while (0)
#define PG8_MMA(ai, bj, At, Bt) do { __builtin_amdgcn_s_setprio(1); _Pragma("unroll") for (int m = 0; m < 4; ++m) _Pragma("unroll") for (int n = 0; n < 2; ++n) _Pragma("unroll") for (int k = 0; k < 2; ++k) \
        acc[ai][bj][m][n] = __builtin_amdgcn_mfma_f32_16x16x32_bf16(Bt[n][k], At[m][k], acc[ai][bj][m][n], 0, 0, 0); __builtin_amdgcn_s_setprio(0); } while (0)
#define PG8_WAIT_V(n) asm volatile("s_waitcnt vmcnt(" #n ")" ::: "memory")
#define PG8_WAIT_L(n) asm volatile("s_waitcnt lgkmcnt(" #n ")" ::: "memory")
#define PG8_BAR __builtin_amdgcn_s_barrier()
#define PG8_SCHED __builtin_amdgcn_sched_barrier(0)
    Unit cur, nxt; int ui = 0;
    if (!S.next(0, cur)) return;
    f32x4 acc[2][2][4][2];
#pragma unroll
    for (int a = 0; a < 2; ++a)
#pragma unroll
        for (int b = 0; b < 2; ++b)
#pragma unroll
            for (int m = 0; m < 4; ++m)
#pragma unroll
                for (int n = 0; n < 2; ++n) acc[a][b][m][n] = (f32x4){0.f, 0.f, 0.f, 0.f};
    bf16x8 At[4][2], B0[2][2], B1[2][2];
    const char* cA = (const char*)g.A + (size_t)cur.pm * tstep; const char* cB = (const char*)g.Bt + (size_t)cur.pn * tstep;
    S.a_ready(cur);
    if constexpr (Epi::WPF) E.prefetch(lds, cur, 0, wid, lane);
    if constexpr (SP2) {
        PG8_STAGE(PG8_SB(0, 0), cB, voffB); PG8_STAGE(PG8_SB(0, 1), cB + hstep, voffB); PG8_STAGE(PG8_SA(0, 0), cA, voffA); PG8_STAGE(PG8_SA(0, 1), cA + hstep, voffA);
        PG8_STAGE(PG8_SB(1, 0), cB + kstep, voffB); PG8_STAGE(PG8_SA(1, 0), cA + kstep, voffA); PG8_STAGE(PG8_SB(1, 1), cB + hstep + kstep, voffB);
        PG8_WAIT_V(8); PG8_BAR;
        if (wr == 1) PG8_BAR;
    } else {
        PG8_STAGE(PG8_SB(0, 0), cB, voffB); PG8_STAGE(PG8_SA(0, 0), cA, voffA); PG8_STAGE(PG8_SB(0, 1), cB + hstep, voffB); PG8_STAGE(PG8_SA(0, 1), cA + hstep, voffA);
        if (wr == 1) PG8_BAR;
        PG8_WAIT_V(4); PG8_BAR;
        PG8_STAGE(PG8_SB(1, 0), cB + kstep, voffB); PG8_STAGE(PG8_SA(1, 0), cA + kstep, voffA); PG8_STAGE(PG8_SB(1, 1), cB + hstep + kstep, voffB);
        PG8_WAIT_V(6); PG8_BAR;
    }
    for (;;) {
        const bool has_next = S.next(ui + 1, nxt);
        const char* nA = has_next ? (const char*)g.A + (size_t)nxt.pm * tstep : cA; const char* nB = has_next ? (const char*)g.Bt + (size_t)nxt.pn * tstep : cB;
        for (int t = 0; t < nt; t += 2) {
            const bool last = (t == nt - 2);
            const char* a1 = cA + (size_t)(t + 1) * kstep;
            const char* a2 = last ? nA : cA + (size_t)(t + 2) * kstep; const char* b2 = last ? nB : cB + (size_t)(t + 2) * kstep;
            const char* a3 = a2 + kstep; const char* b3 = b2 + kstep;
            if (last && has_next) S.a_ready(nxt);
            if constexpr (SP2) {
            PG8_LDB(B0, 0, 0); PG8_LDB(B1, 0, 1); PG8_SCHED; PG8_LDA(At, 0, 0); PG8_STAGE(PG8_SA(1, 1), a1 + hstep, voffA);
            PG8_WAIT_V(8); PG8_WAIT_L(0); PG8_BAR; PG8_MMA(0, 0, At, B0); PG8_MMA(0, 1, At, B1); PG8_BAR; PG8_SCHED;
            PG8_LDA(At, 0, 1); PG8_STAGE(PG8_SB(0, 0), b2, voffB); PG8_STAGE(PG8_SB(0, 1), b2 + hstep, voffB); PG8_STAGE(PG8_SA(0, 0), a2, voffA);
            PG8_WAIT_V(8); PG8_WAIT_L(0); PG8_BAR; PG8_MMA(1, 0, At, B0); PG8_MMA(1, 1, At, B1); PG8_BAR; PG8_SCHED;
            PG8_LDB(B0, 1, 0); PG8_LDB(B1, 1, 1); PG8_SCHED; PG8_LDA(At, 1, 0); PG8_STAGE(PG8_SA(0, 1), a2 + hstep, voffA);
            PG8_WAIT_V(8); PG8_WAIT_L(0); PG8_BAR; PG8_MMA(0, 0, At, B0); PG8_MMA(0, 1, At, B1); PG8_BAR; PG8_SCHED;
            PG8_LDA(At, 1, 1); PG8_STAGE(PG8_SB(1, 0), b3, voffB); PG8_STAGE(PG8_SB(1, 1), b3 + hstep, voffB); PG8_STAGE(PG8_SA(1, 0), a3, voffA);
            PG8_WAIT_V(8); PG8_WAIT_L(0); PG8_BAR; PG8_MMA(1, 0, At, B0); PG8_MMA(1, 1, At, B1); PG8_BAR; PG8_SCHED;
            } else {
            PG8_LDB(B0, 0, 0); PG8_SCHED; PG8_LDA(At, 0, 0); PG8_STAGE(PG8_SA(1, 1), a1 + hstep, voffA);
            PG8_WAIT_L(8); PG8_BAR; PG8_WAIT_L(0); PG8_MMA(0, 0, At, B0); PG8_BAR; PG8_SCHED;
            PG8_LDB(B1, 0, 1); PG8_STAGE(PG8_SB(0, 0), b2, voffB);
            PG8_BAR; PG8_WAIT_L(0); PG8_MMA(0, 1, At, B1); PG8_BAR;
            PG8_LDA(At, 0, 1); PG8_STAGE(PG8_SA(0, 0), a2, voffA);
            PG8_BAR; PG8_WAIT_L(0); PG8_MMA(1, 0, At, B0); PG8_BAR; PG8_SCHED;
            PG8_STAGE(PG8_SB(0, 1), b2 + hstep, voffB);
            PG8_WAIT_V(6); PG8_BAR; PG8_MMA(1, 1, At, B1); PG8_BAR;
            PG8_LDB(B0, 1, 0); PG8_SCHED; PG8_LDA(At, 1, 0); PG8_STAGE(PG8_SA(0, 1), a2 + hstep, voffA);
            PG8_WAIT_L(8); PG8_BAR; PG8_WAIT_L(0); PG8_MMA(0, 0, At, B0); PG8_BAR; PG8_SCHED;
            PG8_LDB(B1, 1, 1); PG8_STAGE(PG8_SB(1, 0), b3, voffB);
            PG8_BAR; PG8_WAIT_L(0); PG8_MMA(0, 1, At, B1); PG8_BAR;
            PG8_LDA(At, 1, 1); PG8_STAGE(PG8_SA(1, 0), a3, voffA);
            PG8_BAR; PG8_WAIT_L(0); PG8_MMA(1, 0, At, B0); PG8_BAR; PG8_SCHED;
            PG8_STAGE(PG8_SB(1, 1), b3 + hstep, voffB);
            PG8_WAIT_V(6); PG8_BAR; PG8_MMA(1, 1, At, B1); PG8_BAR;
            }
        }
        if constexpr (ALIGN_EPI) { if (wr == 0) PG8_BAR; }
        if constexpr (Epi::WPF) { if (has_next) E.prefetch(lds, nxt, (ui + 1) & 1, wid, lane); E(acc, cur, wr, wc, fr, fq, lds, ui & 1); S.done(cur); }
        else if constexpr (!Epi::AFTER_DRAIN) { E(acc, cur, wr, wc, fr, fq); S.done(cur); }
        if (!has_next) break;
#pragma unroll
        for (int a = 0; a < 2; ++a)
#pragma unroll
            for (int b = 0; b < 2; ++b)
#pragma unroll
                for (int m = 0; m < 4; ++m)
#pragma unroll
                    for (int n = 0; n < 2; ++n) acc[a][b][m][n] = (f32x4){0.f, 0.f, 0.f, 0.f};
        cur = nxt; cA = nA; cB = nB; ++ui;
        if constexpr (ALIGN_EPI) { if (wr == 1) PG8_BAR; }
    }
    PG8_WAIT_V(0);
    if constexpr (!ALIGN_EPI) { if (wr == 0) PG8_BAR; }
    PG8_BAR;
    if constexpr (Epi::AFTER_DRAIN) { E.fused(acc, cur, wr, wc, fr, fq, lds, wid, lane); S.done(cur); }
#undef PG8_SA
#undef PG8_SB
#undef PG8_STAGE
#undef PG8_LDA
#undef PG8_LDB
#undef PG8_MMA
#undef PG8_WAIT_V
#undef PG8_WAIT_L
#undef PG8_BAR
#undef PG8_SCHED
}
}

constexpr int DM = 1024, NB = 16, SEQ = 2048, TR = NB * SEQ, NMETA = 16, NS = 128;
constexpr int XM = TR, XS = TR + NMETA, NVALID = TR + NMETA + NS, TM = 33024;
constexpr int LP = NMETA + SEQ;
constexpr int GH = 8, GDK = 128, GDV = 128, GQKV = 3072, GIN = 4112;
constexpr int QL = 384, KVL = 256, NOPE = 128, ROPE = 64, HD = 192, MH = 8;
constexpr int FF = 2816, FF2 = 5632;
constexpr int PAST = 8192, PAGE = 128, NPAGE = 64;
constexpr float EPS = 1e-6f;
constexpr float MLA_SCALE = 0.07216878364870322f;
static_assert(TM % 256 == 0 && TM >= NVALID, "row padding");

enum { I_XP = 0, I_XS, I_SDS, I_SDC, I_SFC, I_CKV, I_CKR, I_PT, I_META, I_ANPRE, I_ANPOST, I_AWIN, I_ACONV, I_ALOG, I_ADT, I_AONORM, I_AWOUT,
       I_KVNORM, I_KVWA, I_KVANORM, I_WUK, I_WUV, I_BNPRE, I_BNPOST, I_BWQA, I_BQANORM, I_BWQB, I_BWOUT, I_FNPRE, I_FNPOST, I_FWUP, I_FCONVW, I_FCONVB, I_FWDOWN, N_IN };
constexpr size_t O_YP = 0, O_YS = O_YP + (size_t)TR * DM, O_PDS = O_YS + (size_t)NS * DM, O_PDC = O_PDS + (size_t)NB * GH * GDK * GDV, O_PFC = O_PDC + (size_t)NB * 3 * GQKV,
                 O_PKV = O_PFC + (size_t)2 * NB * 2 * FF2, O_PKR = O_PKV + (size_t)NB * LP * KVL, O_SDS = O_PKR + (size_t)NB * LP * ROPE, O_SDC = O_SDS + (size_t)NS * GH * GDK * GDV,
                 O_SFC = O_SDC + (size_t)NS * 3 * GQKV, O_SKV = O_SFC + (size_t)2 * NS * 2 * FF2, O_SKR = O_SKV + (size_t)NS * KVL, O_END = O_SKR + (size_t)NS * ROPE;

constexpr size_t MiB = 1u << 20;
constexpr size_t WS_CTL = 0, CTL_ZERO_BYTES = 1 * MiB;
constexpr size_t WS_ROPE = 1 * MiB;
constexpr size_t WS_WIN = 2 * MiB, WS_WGOUT = 10 * MiB, WS_WUP0 = 12 * MiB, WS_WUP1 = 23 * MiB, WS_WDN0 = 34 * MiB, WS_WDN1 = 40 * MiB, WS_WKVQA = 46 * MiB,
                 WS_WQB = 48 * MiB, WS_WUKV = 50 * MiB, WS_WMOUT = 52 * MiB, WS_AB = 54 * MiB, WS_PART = 57 * MiB, WS_QLAT = 60 * MiB;
constexpr size_t WS_XRES = 64 * MiB, WS_XH = 193 * MiB, WS_TMP = 258 * MiB, WS_QKVZ = 387 * MiB, WS_GO = 645 * MiB, WS_UP = 710 * MiB, WS_RAWH = 710 * MiB, WS_RAWX = 760 * MiB, WS_ACT = 1065 * MiB,
                 WS_CKVQ = 1243 * MiB, WS_CB = 1340 * MiB, WS_KRB = 1357 * MiB, WS_QAN = 1362 * MiB, WS_Q = 1387 * MiB, WS_KNV = 1484 * MiB, WS_AO = 1613 * MiB,
                 WS_SREC = 1678 * MiB, WS_GU = 1904 * MiB, WS_GA = 1970 * MiB, WS_GRV = 2036 * MiB, WS_GRK = 2102 * MiB, WS_GEG = 2168 * MiB, WS_RAWQ = 2169 * MiB, WS_END = 2210 * MiB;
constexpr int CW_BAR = 4096, CW_QUEUE = 2048;
constexpr int NPOSTAB = LP + 1;

constexpr int RING_BYTES = 131072, LDS_BYTES = 147456, CTLLDS_OFF = LDS_BYTES - 2048, MISC_OFF = CTLLDS_OFF + 320, INTAB_OFF = CTLLDS_OFF + 1024;

#define LAS __attribute__((address_space(3)))
typedef unsigned short bf16;
typedef unsigned v4u __attribute__((ext_vector_type(4)));
typedef unsigned v2u __attribute__((ext_vector_type(2)));
typedef float f32x4 __attribute__((ext_vector_type(4)));
typedef float f32x16 __attribute__((ext_vector_type(16)));
typedef short bf16x8 __attribute__((ext_vector_type(8)));
typedef short s16x4 __attribute__((ext_vector_type(4)));
#define LDS_WAIT() asm volatile("s_waitcnt lgkmcnt(0)" ::: "memory")
#define VM_WAIT() asm volatile("s_waitcnt vmcnt(0)" ::: "memory")
#define LDS_BARRIER() do { asm volatile("s_waitcnt lgkmcnt(0)" ::: "memory"); __builtin_amdgcn_s_barrier(); asm volatile("" ::: "memory"); } while (0)
__device__ __forceinline__ unsigned f2bf(float f) { unsigned u = __builtin_bit_cast(unsigned, f); return (u + 0x7fffu + ((u >> 16) & 1u)) >> 16; }
__device__ __forceinline__ unsigned pk2(float lo, float hi) { return f2bf(lo) | (f2bf(hi) << 16); }
__device__ __forceinline__ float bf2f(bf16 b) { return __builtin_bit_cast(float, (unsigned)b << 16); }
__device__ __forceinline__ float bflo(unsigned w) { return __builtin_bit_cast(float, w << 16); }
__device__ __forceinline__ float bfhi(unsigned w) { return __builtin_bit_cast(float, w & 0xffff0000u); }
#define DPPF(x, ctrl) __builtin_bit_cast(float, __builtin_amdgcn_update_dpp(0, __builtin_bit_cast(int, (x)), (ctrl), 0xF, 0xF, false))
__device__ __forceinline__ float swap16_sum(float v) { auto r = __builtin_amdgcn_permlane16_swap(__float_as_uint(v), __float_as_uint(v), false, false); return __uint_as_float(r[0]) + __uint_as_float(r[1]); }
__device__ __forceinline__ float swap32_sum(float v) { auto r = __builtin_amdgcn_permlane32_swap(__float_as_uint(v), __float_as_uint(v), false, false); return __uint_as_float(r[0]) + __uint_as_float(r[1]); }
__device__ __forceinline__ float wave_sum(float v) {
    v += DPPF(v, 0xB1); v += DPPF(v, 0x4E); v += DPPF(v, 0x141); v += DPPF(v, 0x140);
    return swap32_sum(swap16_sum(v));
}
__device__ __forceinline__ float siluf(float x) { return x * __builtin_amdgcn_rcpf(1.f + __expf(-x)); }

#define XB_TMO      128
#define XB_XCNT(j)  (256  + 64 * (j))
#define XB_XSUB(j)  (1280 + 64 * (j))
#define XB_XGEN(j)  (2304 + 64 * (j))
#define XB_TOP      3328
#define XB_TOPGEN   3392
#define XCD_BAR_WORDS 3456
#define XB_SPIN_CAP (1u << 18)
__device__ __forceinline__ unsigned xb_ld(unsigned* p)              { return __hip_atomic_load(p, __ATOMIC_RELAXED, __HIP_MEMORY_SCOPE_AGENT); }
__device__ __forceinline__ unsigned xb_add(unsigned* p, unsigned v) { return __hip_atomic_fetch_add(p, v, __ATOMIC_RELAXED, __HIP_MEMORY_SCOPE_AGENT); }
__device__ __forceinline__ unsigned xb_xcc_id() { return (unsigned)__builtin_amdgcn_s_getreg((3 << 11) | 20) & 0xFu; }
#define XB_SPIN(cond, bar) do { unsigned _sp = 0; while (cond) { __builtin_amdgcn_s_sleep(1); \
    if ((++_sp & 255u) == 0u) { if (xb_ld(&(bar)[XB_TMO])) break; if (_sp > XB_SPIN_CAP) { atomicAdd(&(bar)[XB_TMO], 1u); break; } } } } while (0)
struct XcdBarrier { unsigned* bar; unsigned x; volatile LAS unsigned* st; };
__device__ __forceinline__ XcdBarrier xcd_barrier_post(unsigned* bar, volatile LAS unsigned* st) {
    XcdBarrier b; b.bar = bar; b.x = xb_xcc_id(); b.st = st;
    if (threadIdx.x == 0) (void)xb_add(&bar[XB_XCNT(b.x)], 1u);
    return b;
}
__device__ __forceinline__ void xcd_barrier_complete(unsigned* bar, unsigned x, unsigned& nloc, unsigned& nx) {
    const unsigned G = gridDim.x * gridDim.y * gridDim.z;
    unsigned sum, cnt, mine, sp = 0u;
    for (;;) {
        sum = 0u; cnt = 0u; mine = 0u;
#pragma unroll
        for (unsigned j = 0; j < 16; ++j) { const unsigned c = xb_ld(&bar[XB_XCNT(j)]); sum += c; cnt += (c > 0u) ? 1u : 0u; mine = (j == x) ? c : mine; }
        if (sum == G) break;
        __builtin_amdgcn_s_sleep(1);
        if ((++sp & 255u) == 0u) { if (xb_ld(&bar[XB_TMO])) break; if (sp > XB_SPIN_CAP) { atomicAdd(&bar[XB_TMO], 1u); break; } }
    }
    nloc = mine > 0u ? mine : 1u; nx = cnt > 0u ? cnt : 1u;
}
__device__ __forceinline__ void xcd_barrier(const XcdBarrier& b) {
    asm volatile("s_waitcnt vmcnt(0)" ::: "memory");
    __syncthreads();
    if (threadIdx.x == 0) {
        unsigned* bar = b.bar;
        __builtin_amdgcn_s_waitcnt(0);
        unsigned nloc = b.st[0], nx = b.st[1];
        if (nloc == 0u) { xcd_barrier_complete(bar, b.x, nloc, nx); b.st[0] = nloc; b.st[1] = nx; }
        const unsigned old = xb_add(&bar[XB_XSUB(b.x)], 1u);
        const unsigned gen = old / nloc;
        if (old + 1u == (gen + 1u) * nloc) {
            __builtin_amdgcn_fence(__ATOMIC_RELEASE, "agent");
            asm volatile("s_waitcnt vmcnt(0)" ::: "memory");
            const unsigned og = xb_add(&bar[XB_TOP], 1u);
            const unsigned tg = og / nx;
            if (og + 1u == (tg + 1u) * nx) xb_add(&bar[XB_TOPGEN], 1u);
            else XB_SPIN(xb_ld(&bar[XB_TOPGEN]) == tg, bar);
            __builtin_amdgcn_fence(__ATOMIC_ACQUIRE, "agent");
            xb_add(&bar[XB_XGEN(b.x)], 1u);
            asm volatile("s_waitcnt vmcnt(0)" ::: "memory");
        } else {
            XB_SPIN(xb_ld(&bar[XB_XGEN(b.x)]) == gen, bar);
            __builtin_amdgcn_fence(__ATOMIC_ACQUIRE, "agent");
            asm volatile("s_waitcnt vmcnt(0)" ::: "memory");
        }
    }
    __syncthreads();
}

struct ConvJob { const float* src; const float* gain; bf16* dst; int K, N, ld, row_off, mode, pad; };
constexpr int NJOBS = 12;
struct Params {
    const float* in[N_IN];
    float* out; unsigned char* ws;
    ConvJob jobs[NJOBS];
    int ph_lo, ph_hi;
};
#define GAS __attribute__((address_space(1)))
struct InTab { const LAS unsigned* t;
    __device__ __forceinline__ const float* operator[](int i) const { const unsigned lo = __builtin_amdgcn_readfirstlane(t[2 * i]), hi = __builtin_amdgcn_readfirstlane(t[2 * i + 1]); return (const float*)(GAS const float*)(((unsigned long long)hi << 32) | lo); } };
struct Frame {
    LAS unsigned char* lds;
    int tid, lane, wave, G, bid;
    InTab in; GAS float* out; GAS unsigned char* ws;
};
__device__ __forceinline__ int prow(int b, int pos) { return pos < NMETA ? XM + pos : b * SEQ + (pos - NMETA); }

template <bool GAIN> __device__ __forceinline__ void p0_transpose_item(const ConvJob& J, LAS float* scr, int item, int lane) {
    const int nblk = J.N / 32, kb = item / nblk, nb = item % nblk, k0 = 64 * kb, n0 = 32 * nb;
    const int kr = lane >> 3, c4 = (lane & 7) * 4;
    f32x4 v[8]; float gn[8];
#pragma unroll
    for (int i = 0; i < 8; ++i) { const int kk = 8 * i + kr; v[i] = *(const f32x4*)(J.src + (size_t)(k0 + kk) * J.ld + n0 + c4); gn[i] = GAIN ? J.gain[k0 + kk] : 1.f; }
#pragma unroll
    for (int i = 0; i < 8; ++i) { const int kk = 8 * i + kr; LAS float* d = scr + kk * 33 + c4; d[0] = v[i].x * gn[i]; d[1] = v[i].y * gn[i]; d[2] = v[i].z * gn[i]; d[3] = v[i].w * gn[i]; }
    LDS_WAIT(); asm volatile("" ::: "memory");
    const int c = lane & 7;
#pragma unroll
    for (int j = 0; j < 4; ++j) { const int n = (lane >> 3) + 8 * j; const LAS float* s = scr + (8 * c) * 33 + n;
        v4u o; o.x = pk2(s[0 * 33], s[1 * 33]); o.y = pk2(s[2 * 33], s[3 * 33]); o.z = pk2(s[4 * 33], s[5 * 33]); o.w = pk2(s[6 * 33], s[7 * 33]);
        const int sc_ = n0 + n; int drow = J.row_off + sc_; if (J.mode == 1) { const int isv = sc_ >= FF ? 1 : 0, ch = sc_ - isv * FF; drow = 32 * (ch >> 4) + 16 * isv + (ch & 15); }
        *(v4u*)(J.dst + (size_t)drow * J.K + k0 + 8 * c) = o; }
    LDS_WAIT(); asm volatile("" ::: "memory");
}
__device__ __forceinline__ void p0_prologue(Frame& F, const Params& P) {
    const int gw = F.bid * 8 + F.wave, NGW = F.G * 8;
    {
        LAS float* scr = (LAS float*)(F.lds + F.wave * 16384);
        int base = 0;
#ifndef P0A
#define P0A 1
#define P0C 1
#endif
#pragma unroll 1
        for (int j_ = 0; j_ < NJOBS * P0A; ++j_) { const int j = j_ % NJOBS; if (j == 0) base = 0;
            const ConvJob J = P.jobs[j]; const int nit = (J.K / 64) * (J.N / 32);
            int first = (gw - base % NGW + NGW) % NGW;
            if (J.gain) { _Pragma("unroll 1") for (int it = first; it < nit; it += NGW) p0_transpose_item<true>(J, scr, it, F.lane); }
            else { _Pragma("unroll 1") for (int it = first; it < nit; it += NGW) p0_transpose_item<false>(J, scr, it, F.lane); }
            base += nit;
        }
        bf16* wz = (bf16*)(F.ws + WS_WKVQA) + (size_t)704 * DM;
        for (int i = F.bid * 512 + F.tid; i < 64 * DM / 8; i += F.G * 512) ((v4u*)wz)[i] = (v4u){0u, 0u, 0u, 0u};
    }
    {
        float* ctab = (float*)(F.ws + WS_ROPE); float* stab = ctab + NPOSTAB * 32;
        for (int idx = F.bid * 512 + F.tid; idx < NPOSTAB * 32; idx += F.G * 512) {
            const int pi = idx >> 5, i = idx & 31; const int pos = pi < LP ? pi : PAST;
            double inv = 1.0; for (int k = 0; k < i; ++k) inv *= 0.74989420933245582730;
            double c1 = 1.0, s1 = inv, tc = 1.0, ts = inv; const double x2 = inv * inv;
            for (int k = 1; k < 14; ++k) { tc *= -x2 / (double)((2 * k - 1) * (2 * k)); ts *= -x2 / (double)((2 * k) * (2 * k + 1)); c1 += tc; s1 += ts; }
            double rc = 1.0, rs = 0.0, bc = c1, bs = s1; int e = pos;
            for (int k = 0; k < 14; ++k) { if (e & 1) { const double t = rc * bc - rs * bs; rs = rc * bs + rs * bc; rc = t; } const double t2 = bc * bc - bs * bs; bs = 2.0 * bc * bs; bc = t2; e >>= 1; }
            ctab[idx] = (float)rc; stab[idx] = (float)rs;
        }
    }
    __syncthreads();
    asm volatile("" : "+s"(F.ws));
    LAS float* wab = (LAS float*)F.lds;
    { const float* win = F.in[I_AWIN]; const float* g = F.in[I_ANPRE];
      for (int idx = F.tid; idx < DM * 16; idx += 512) { const int k = idx >> 4, q = idx & 15, j = k >> 8, ln = (k >> 2) & 63, i = k & 3; wab[(((j * 4 + i) * 4 + (q >> 2)) * 64 + ln) * 4 + (q & 3)] = win[(size_t)k * GIN + 4096 + q] * g[k]; } }
    __syncthreads();
    float* XRES = (float*)(F.ws + WS_XRES); bf16* XH = (bf16*)(F.ws + WS_XH); float* AB = (float*)(F.ws + WS_AB);
#pragma unroll 1
    for (int rb_ = gw * 2; rb_ < TM * P0C; rb_ += NGW * 2) { const int rb = rb_ % TM;
        f32x4 v[2][4]; float msk[2];
#pragma unroll
        for (int u = 0; u < 2; ++u) { const int row = rb + u; const float* src = F.in[I_XP];
            if (row < TR) src = F.in[I_XP] + (size_t)row * DM; else if (row < XS) src = F.in[I_META] + (size_t)(row - XM) * DM; else if (row < NVALID) src = F.in[I_XS] + (size_t)(row - XS) * DM;
            msk[u] = row < NVALID ? 1.f : 0.f;
#pragma unroll
            for (int j = 0; j < 4; ++j) v[u][j] = ((const f32x4*)src)[64 * j + F.lane]; }
#pragma unroll
        for (int u = 0; u < 2; ++u) { const int row = rb + u; float ss = 0.f;
#pragma unroll
            for (int j = 0; j < 4; ++j) { v[u][j] = v[u][j] * msk[u]; ss += (v[u][j].x * v[u][j].x + v[u][j].y * v[u][j].y) + (v[u][j].z * v[u][j].z + v[u][j].w * v[u][j].w); }
            ss = wave_sum(ss); const float rstd = rsqrtf(ss * (1.f / DM) + EPS);
            unsigned long long* xh = (unsigned long long*)(XH + (size_t)row * DM);
#pragma unroll
            for (int j = 0; j < 4; ++j) { v[u][j] = v[u][j] * rstd; xh[64 * j + F.lane] = (unsigned long long)pk2(v[u][j].x, v[u][j].y) | ((unsigned long long)pk2(v[u][j].z, v[u][j].w) << 32); }
            if (row >= NVALID) continue;
            float a[16];
#pragma unroll
            for (int q = 0; q < 16; ++q) a[q] = 0.f;
#pragma unroll
            for (int j = 0; j < 4; ++j)
#pragma unroll
                for (int i = 0; i < 4; ++i) { const float xv = v[u][j][i]; const LAS f32x4* wr = (const LAS f32x4*)wab + (j * 4 + i) * 256 + F.lane;
#pragma unroll
                    for (int q4 = 0; q4 < 4; ++q4) { const f32x4 w = wr[q4 * 64]; a[4 * q4 + 0] += xv * w.x; a[4 * q4 + 1] += xv * w.y; a[4 * q4 + 2] += xv * w.z; a[4 * q4 + 3] += xv * w.w; } }
#pragma unroll
            for (int i = 0; i < 8; ++i) { auto r_ = __builtin_amdgcn_permlane32_swap(__float_as_uint(a[i]), __float_as_uint(a[i + 8]), false, false); a[i] = __uint_as_float(r_[0]) + __uint_as_float(r_[1]); }
#pragma unroll
            for (int i = 0; i < 4; ++i) { auto r_ = __builtin_amdgcn_permlane16_swap(__float_as_uint(a[i]), __float_as_uint(a[i + 4]), false, false); a[i] = __uint_as_float(r_[0]) + __uint_as_float(r_[1]); }
            { const bool b3 = (F.lane & 8) != 0, b2 = (F.lane & 4) != 0;
#pragma unroll
              for (int i = 0; i < 2; ++i) { const float keep = b3 ? a[i + 2] : a[i], send = b3 ? a[i] : a[i + 2]; a[i] = keep + DPPF(send, 0x140); }
              { const float keep = b2 ? a[1] : a[0], send = b2 ? a[0] : a[1]; a[0] = keep + DPPF(send, 0x141); } }
            a[0] += DPPF(a[0], 0x4E); a[0] += DPPF(a[0], 0xB1);
            if ((F.lane & 3) == 0) { const int idx = ((F.lane >> 5) & 1) * 8 + ((F.lane >> 4) & 1) * 4 + ((F.lane >> 3) & 1) * 2 + ((F.lane >> 2) & 1); AB[(size_t)row * 16 + idx] = a[0]; }
        }
    }
}

__device__ __forceinline__ void gdn_item(Frame& F, int item) {
    const bool is_p = item < NB * GH;
    const int b = is_p ? item >> 3 : 0, h = item & 7, s = is_p ? 0 : (item - NB * GH) >> 3;
    const int dv = F.tid & 127, qd = __builtin_amdgcn_readfirstlane(F.tid >> 7);
    LAS float* qs = (LAS float*)F.lds; LAS float* ks = qs + 16 * 128; LAS float* vs = ks + 16 * 128; LAS float* red = vs + 16 * 128; LAS float* red2 = red + 512; LAS float* egs = red2 + 512; LAS float* bes = egs + 16;
    const bf16* QKVZ = (const bf16*)(F.ws + WS_QKVZ); const float* AB = (const float*)(F.ws + WS_AB); bf16* OB = (bf16*)(F.ws + WS_TMP);
    const float* cw = F.in[I_ACONV]; const float* sdc = F.in[I_SDC];
    float S[32];
    if (is_p) {
#pragma unroll
        for (int i = 0; i < 32; ++i) S[i] = 0.f;
    } else { const float* s0 = F.in[I_SDS] + ((size_t)(s * GH + h) * GDK + 32 * qd) * GDV + dv;
#pragma unroll
        for (int i = 0; i < 32; ++i) S[i] = s0[(size_t)i * GDV]; }
    const float Ah = __expf(F.in[I_ALOG][h]), dtb = F.in[I_ADT][h];
    const int nchunk = is_p ? LP / 16 : 1, ntok = is_p ? 16 : 1;
#pragma unroll 1
    for (int ch = 0; ch < nchunk; ++ch) {
        for (int idx = F.tid; idx < ntok * 384; idx += 512) {
            const int ti = idx / 384, c = idx - ti * 384, part = c >> 7, cc = c & 127, col = part * 1024 + h * 128 + cc;
            float acc = 0.f;
#pragma unroll
            for (int j = 0; j < 4; ++j) {
                float xv;
                if (is_p) { const int pos = ch * 16 + ti - 3 + j; xv = pos < 0 ? 0.f : bf2f(QKVZ[(size_t)prow(b, pos) * 4096 + col]); }
                else xv = j < 3 ? sdc[(size_t)(s * 3 + j) * GQKV + col] : bf2f(QKVZ[(size_t)(XS + s) * 4096 + col]);
                acc += cw[j * GQKV + col] * xv;
            }
            acc = siluf(acc);
            (part == 0 ? qs : part == 1 ? ks : vs)[ti * 128 + cc] = acc;
        }
        if (F.tid < ntok) { const int row = is_p ? prow(b, ch * 16 + F.tid) : XS + s; const float a = AB[(size_t)row * 16 + h], bb = AB[(size_t)row * 16 + 8 + h];
            const float x = a + dtb, sp = x > 20.f ? x : log1pf(__expf(x)); egs[F.tid] = __expf(-Ah * sp); bes[F.tid] = 1.f / (1.f + __expf(-bb)); }
        __syncthreads();
        for (int vv = F.wave; vv < 2 * ntok; vv += 8) { const int ti = vv >> 1, isk = vv & 1; LAS float* p = (isk ? ks : qs) + ti * 128; const float x0 = p[F.lane], x1 = p[F.lane + 64];
            const float ss = wave_sum(x0 * x0 + x1 * x1); const float r = rsqrtf(ss + EPS) * (isk ? 1.f : 0.08838834764831845f); p[F.lane] = x0 * r; p[F.lane + 64] = x1 * r; }
        __syncthreads();
#pragma unroll 1
        for (int ti = 0; ti < ntok; ++ti) {
            float kk[32]; float p = 0.f;
#pragma unroll
            for (int i = 0; i < 32; ++i) { kk[i] = ks[ti * 128 + 32 * qd + i]; p += kk[i] * S[i]; }
            red[qd * 128 + dv] = p; __syncthreads();
            const float kS = (red[dv] + red[128 + dv]) + (red[256 + dv] + red[384 + dv]);
            const float eg = egs[ti], be = bes[ti], u = be * (vs[ti * 128 + dv] - eg * kS);
            float op = 0.f;
#pragma unroll
            for (int i = 0; i < 32; ++i) { S[i] = eg * S[i] + kk[i] * u; op += qs[ti * 128 + 32 * qd + i] * S[i]; }
            red2[qd * 128 + dv] = op; __syncthreads();
            if (qd == 0) { const float o = (red2[dv] + red2[128 + dv]) + (red2[256 + dv] + red2[384 + dv]);
                const int row = is_p ? prow(b, ch * 16 + ti) : XS + s;
                if (!is_p || ch > 0 || b == 0) OB[(size_t)row * DM + h * 128 + dv] = (bf16)f2bf(o); }
        }
        __syncthreads();
    }
    GAS float* so = is_p ? F.out + O_PDS + ((size_t)(b * GH + h) * GDK + 32 * qd) * GDV + dv : F.out + O_SDS + ((size_t)(s * GH + h) * GDK + 32 * qd) * GDV + dv;
#pragma unroll
    for (int i = 0; i < 32; ++i) so[(size_t)i * GDV] = S[i];
}

__device__ __forceinline__ void p3_gate(Frame& F) {
    const int gw = F.bid * 8 + F.wave, NGW = F.G * 8;
    const bf16* OB = (const bf16*)(F.ws + WS_TMP); const bf16* QKVZ = (const bf16*)(F.ws + WS_QKVZ); bf16* GO = (bf16*)(F.ws + WS_GO);
    const float* on = F.in[I_AONORM];
    f32x4 g4[4];
#pragma unroll
    for (int j = 0; j < 4; ++j) g4[j] = ((const f32x4*)on)[((16 * F.lane) & 127) / 4 + j];
    for (int row = gw; row < NVALID; row += NGW) {
        const v4u* op = (const v4u*)(OB + (size_t)row * DM + 16 * F.lane); const v4u* zp = (const v4u*)(QKVZ + (size_t)row * 4096 + 3072 + 16 * F.lane);
        f32x4 o[4]; float ss = 0.f; const v4u o0 = op[0], o1 = op[1]; const unsigned ow[8] = {o0.x, o0.y, o0.z, o0.w, o1.x, o1.y, o1.z, o1.w};
#pragma unroll
        for (int j = 0; j < 4; ++j) { o[j] = (f32x4){bflo(ow[2 * j]), bfhi(ow[2 * j]), bflo(ow[2 * j + 1]), bfhi(ow[2 * j + 1])}; ss += (o[j].x * o[j].x + o[j].y * o[j].y) + (o[j].z * o[j].z + o[j].w * o[j].w); }
        ss += DPPF(ss, 0xB1); ss += DPPF(ss, 0x4E); ss += DPPF(ss, 0x141);
        const float rstd = rsqrtf(ss * (1.f / 128.f) + EPS);
        const v4u z0 = zp[0], z1 = zp[1]; const unsigned zw[8] = {z0.x, z0.y, z0.z, z0.w, z1.x, z1.y, z1.z, z1.w};
        unsigned w[8];
#pragma unroll
        for (int j = 0; j < 4; ++j) { const f32x4 y = o[j] * rstd * g4[j];
            w[2 * j] = pk2(y.x * siluf(bflo(zw[2 * j])), y.y * siluf(bfhi(zw[2 * j]))); w[2 * j + 1] = pk2(y.z * siluf(bflo(zw[2 * j + 1])), y.w * siluf(bfhi(zw[2 * j + 1]))); }
        v4u* gp = (v4u*)(GO + (size_t)row * DM + 16 * F.lane); gp[0] = (v4u){w[0], w[1], w[2], w[3]}; gp[1] = (v4u){w[4], w[5], w[6], w[7]};
    }
    const int gt = F.bid * 512 + F.tid, NGT = F.G * 512;
    { const float* RAWQ = (const float*)(F.ws + WS_RAWQ);
      for (int i = gt; i < NB * 3 * GQKV; i += NGT) { const int c = i % GQKV, j = (i / GQKV) % 3, b = i / (3 * GQKV); F.out[O_PDC + i] = RAWQ[((size_t)(b * 32 + 31) * 6 + 3 + j) * GQKV + c]; } }
    for (int i = gt; i < NS * 3 * GQKV; i += NGT) { const int c = i % GQKV, j = (i / GQKV) % 3, s = i / (3 * GQKV);
        F.out[O_SDC + i] = j < 2 ? F.in[I_SDC][(size_t)(s * 3 + j + 1) * GQKV + c] : bf2f(QKVZ[(size_t)(XS + s) * 4096 + c]); }
}

template <bool LAST, bool FIRST = false> __device__ __forceinline__ void p_postnorm(Frame& F, const float* gpost) {
    const int gw = F.bid * 8 + F.wave, NGW = F.G * 8;
    const bf16* TMPB = (const bf16*)(F.ws + WS_TMP); bf16* XRES = (bf16*)(F.ws + WS_XRES); bf16* XH = (bf16*)(F.ws + WS_XH);
    f32x4 g[4];
#pragma unroll
    for (int j = 0; j < 4; ++j) g[j] = ((const f32x4*)gpost)[64 * j + F.lane];
    static_assert(NVALID % 2 == 0, "two rows per wave iteration");
    const float* xin_p = F.in[I_XP]; const float* xin_m = F.in[I_META]; const float* xin_s = F.in[I_XS];
#pragma unroll 1
    for (int rb = gw * 2; rb < NVALID; rb += NGW * 2) {
        f32x4 t[2][4], x[2][4];
#pragma unroll
        for (int u = 0; u < 2; ++u) { const v2u* tp = (const v2u*)(TMPB + (size_t)(rb + u) * DM); const v2u* xb = (const v2u*)(XRES + (size_t)(rb + u) * DM);
            const int row = rb + u; const f32x4* xp = (const f32x4*)(row < TR ? xin_p + (size_t)row * DM : (row < XS ? xin_m + (size_t)(row - XM) * DM : xin_s + (size_t)(row - XS) * DM));
#pragma unroll
            for (int j = 0; j < 4; ++j) { const v2u w = tp[64 * j + F.lane]; t[u][j] = (f32x4){bflo(w.x), bfhi(w.x), bflo(w.y), bfhi(w.y)};
                if (FIRST) x[u][j] = xp[64 * j + F.lane]; else { const v2u q = xb[64 * j + F.lane]; x[u][j] = (f32x4){bflo(q.x), bfhi(q.x), bflo(q.y), bfhi(q.y)}; } } }
#pragma unroll
        for (int u = 0; u < 2; ++u) { const int row = rb + u; float ss = 0.f;
#pragma unroll
            for (int j = 0; j < 4; ++j) ss += (t[u][j].x * t[u][j].x + t[u][j].y * t[u][j].y) + (t[u][j].z * t[u][j].z + t[u][j].w * t[u][j].w);
            ss = wave_sum(ss); const float rstd = rsqrtf(ss * (1.f / DM) + EPS); float s2 = 0.f;
#pragma unroll
            for (int j = 0; j < 4; ++j) { x[u][j] = x[u][j] + t[u][j] * rstd * g[j]; s2 += (x[u][j].x * x[u][j].x + x[u][j].y * x[u][j].y) + (x[u][j].z * x[u][j].z + x[u][j].w * x[u][j].w); }
            if (LAST) {
                GAS float* yo = row < TR ? F.out + O_YP + (size_t)row * DM : (row >= XS ? F.out + O_YS + (size_t)(row - XS) * DM : nullptr);
                if (yo) {
#pragma unroll
                    for (int j = 0; j < 4; ++j) ((f32x4*)yo)[64 * j + F.lane] = x[u][j]; }
            } else {
                s2 = wave_sum(s2); const float r2 = rsqrtf(s2 * (1.f / DM) + EPS);
                unsigned long long* xo = (unsigned long long*)(XRES + (size_t)row * DM); unsigned long long* xh = (unsigned long long*)(XH + (size_t)row * DM);
#pragma unroll
                for (int j = 0; j < 4; ++j) { xo[64 * j + F.lane] = (unsigned long long)pk2(x[u][j].x, x[u][j].y) | ((unsigned long long)pk2(x[u][j].z, x[u][j].w) << 32); const f32x4 y = x[u][j] * r2; xh[64 * j + F.lane] = (unsigned long long)pk2(y.x, y.y) | ((unsigned long long)pk2(y.z, y.w) << 32); }
            }
        }
    }
}

__device__ __forceinline__ void ld8(const bf16* p, float (&o)[8]) { const v4u w = *(const v4u*)p; o[0] = bflo(w.x); o[1] = bfhi(w.x); o[2] = bflo(w.y); o[3] = bfhi(w.y); o[4] = bflo(w.z); o[5] = bfhi(w.z); o[6] = bflo(w.w); o[7] = bfhi(w.w); }
__device__ __forceinline__ void ld8f(const float* p, float (&o)[8]) { const f32x4 a = ((const f32x4*)p)[0], b = ((const f32x4*)p)[1]; o[0] = a.x; o[1] = a.y; o[2] = a.z; o[3] = a.w; o[4] = b.x; o[5] = b.y; o[6] = b.z; o[7] = b.w; }
__device__ __forceinline__ int ffperm(int ch, int isv) { return 32 * (ch >> 4) + 16 * isv + (ch & 15); }
__device__ __forceinline__ void p_ffn_fix(Frame& F, int layer) {
    bf16* ACT = (bf16*)(F.ws + WS_ACT); const float* RAWH = (const float*)(F.ws + WS_RAWH); const float* RAWX = (const float*)(F.ws + WS_RAWX);
    const float* cw = F.in[I_FCONVW] + (size_t)layer * 3 * FF2; const float* cb = F.in[I_FCONVB] + (size_t)layer * FF2; const float* sfc = F.in[I_SFC] + (size_t)layer * NS * 2 * FF2;
    const int gt = F.bid * 512 + F.tid, NGT = F.G * 512; constexpr int CG = FF / 8, NG = TR / 64;
#pragma unroll 1
    for (int i = gt; i < (NG * 2 + NMETA + NS) * CG; i += NGT) {
        const int task = i / CG, ch0 = (i - task * CG) * 8, cog = ffperm(ch0, 0), cov = cog + 16;
        const float* p2; const float* p1; const float* p0; float k1 = 1.f, k0 = 1.f; int row; bool smp = false; int sidx = 0;
        if (task < NG * 2) { const int g = task >> 1, j = task & 1; row = 64 * g + j; const bool bstart = ((64 * g) & (SEQ - 1)) == 0;
            const float* prev3 = bstart ? RAWX + (size_t)15 * FF2 : RAWH + ((size_t)(g - 1) * 4 + 3) * FF2; const float* prev2 = bstart ? RAWX + (size_t)14 * FF2 : RAWH + ((size_t)(g - 1) * 4 + 2) * FF2;
            const float* c0 = RAWH + ((size_t)g * 4) * FF2; const float* c1 = c0 + FF2;
            if (j == 0) { p2 = c0; p1 = prev3; p0 = prev2; } else { p2 = c1; p1 = c0; p0 = prev3; } }
        else { const int rr = task - NG * 2; row = XM + rr; smp = rr >= NMETA; sidx = smp ? rr - NMETA : 0; p2 = RAWX + (size_t)rr * FF2;
            p1 = (!smp && rr >= 1) ? p2 - FF2 : RAWX; p0 = (!smp && rr >= 2) ? p2 - 2 * FF2 : RAWX; k1 = (!smp && rr >= 1) ? 1.f : 0.f; k0 = (!smp && rr >= 2) ? 1.f : 0.f; }
        float x2g[8], x2v[8], x1g[8], x1v[8], x0g[8], x0v[8], s1g[8], s1v[8], s0g[8], s0v[8];
        ld8f(p2 + cog, x2g); ld8f(p2 + cov, x2v); ld8f(p1 + cog, x1g); ld8f(p1 + cov, x1v); ld8f(p0 + cog, x0g); ld8f(p0 + cov, x0v);
        const float ks = smp ? 1.f : 0.f;
        ld8f(sfc + (size_t)(sidx * 2 + 1) * FF2 + ch0, s1g); ld8f(sfc + (size_t)(sidx * 2 + 1) * FF2 + FF + ch0, s1v); ld8f(sfc + (size_t)(sidx * 2) * FF2 + ch0, s0g); ld8f(sfc + (size_t)(sidx * 2) * FF2 + FF + ch0, s0v);
        float w0g[8], w1g[8], w2g[8], w0v[8], w1v[8], w2v[8], bg[8], bv[8];
        ld8f(cw + ch0, w0g); ld8f(cw + FF2 + ch0, w1g); ld8f(cw + 2 * FF2 + ch0, w2g); ld8f(cw + FF + ch0, w0v); ld8f(cw + FF2 + FF + ch0, w1v); ld8f(cw + 2 * FF2 + FF + ch0, w2v); ld8f(cb + ch0, bg); ld8f(cb + FF + ch0, bv);
        float a[8];
#pragma unroll
        for (int k = 0; k < 8; ++k) { const float q0g = k0 * x0g[k] + ks * s0g[k], q0v = k0 * x0v[k] + ks * s0v[k], q1g = k1 * x1g[k] + ks * s1g[k], q1v = k1 * x1v[k] + ks * s1v[k];
            const float ug = w0g[k] * q0g + w1g[k] * q1g + w2g[k] * x2g[k] + bg[k], uv = w0v[k] * q0v + w1v[k] * q1v + w2v[k] * x2v[k] + bv[k]; a[k] = siluf(ug) * uv; }
        *(v4u*)(ACT + (size_t)row * FF + ch0) = (v4u){pk2(a[0], a[1]), pk2(a[2], a[3]), pk2(a[4], a[5]), pk2(a[6], a[7])};
    }
    GAS float* pfc = F.out + O_PFC + (size_t)layer * NB * 2 * FF2; GAS float* sfo = F.out + O_SFC + (size_t)layer * NS * 2 * FF2;
    for (int i = gt; i < NB * 2 * FF2; i += NGT) { const int c = i % FF2, j = (i / FF2) & 1, b = i / (2 * FF2); const int isv = c >= FF ? 1 : 0; pfc[i] = RAWH[((size_t)(b * 32 + 31) * 4 + 2 + j) * FF2 + ffperm(c - isv * FF, isv)]; }
    for (int i = gt; i < NS * 2 * FF2; i += NGT) { const int c = i % FF2, j = (i / FF2) & 1, s_ = i / (2 * FF2); const int isv = c >= FF ? 1 : 0;
        sfo[i] = j == 0 ? sfc[(size_t)(s_ * 2 + 1) * FF2 + c] : RAWX[(size_t)(NMETA + s_) * FF2 + ffperm(c - isv * FF, isv)]; }
}

__device__ __forceinline__ void p_kvq(Frame& F) {
    const int gw = F.bid * 8 + F.wave, NGW = F.G * 8;
    const bf16* CK = (const bf16*)(F.ws + WS_CKVQ); bf16* CB = (bf16*)(F.ws + WS_CB); bf16* KRB = (bf16*)(F.ws + WS_KRB); bf16* QAN = (bf16*)(F.ws + WS_QAN);
    const float* ctab = (const float*)(F.ws + WS_ROPE); const float* stab = ctab + NPOSTAB * 32;
    const f32x4 gk = ((const f32x4*)F.in[I_KVANORM])[F.lane];
    float gq[6];
#pragma unroll
    for (int j = 0; j < 6; ++j) gq[j] = F.in[I_BQANORM][F.lane + 64 * j];
    for (int row = gw; row < NVALID; row += NGW) {
        const bf16* cr = CK + (size_t)row * 768;
        const v2u lw = ((const v2u*)cr)[F.lane]; f32x4 lat = {bflo(lw.x), bfhi(lw.x), bflo(lw.y), bfhi(lw.y)}; float ss = wave_sum((lat.x * lat.x + lat.y * lat.y) + (lat.z * lat.z + lat.w * lat.w));
        lat = lat * rsqrtf(ss * (1.f / KVL) + EPS) * gk;
        const int posidx = row < TR ? NMETA + (row & (SEQ - 1)) : (row < XS ? row - XM : LP);
        const int i = F.lane & 31; const float x1 = bf2f(cr[256 + i]), x2 = bf2f(cr[288 + i]), cs = ctab[posidx * 32 + i], sn = stab[posidx * 32 + i];
        const float kr = F.lane < 32 ? x1 * cs - x2 * sn : x2 * cs + x1 * sn;
        ((v2u*)(CB + (size_t)row * KVL))[F.lane] = (v2u){pk2(lat.x, lat.y), pk2(lat.z, lat.w)};
        KRB[(size_t)row * ROPE + F.lane] = (bf16)f2bf(kr);
        if (row < TR) { const int b = row >> 11, t = row & (SEQ - 1); ((f32x4*)(F.out + O_PKV + ((size_t)b * LP + NMETA + t) * KVL))[F.lane] = lat; F.out[O_PKR + ((size_t)b * LP + NMETA + t) * ROPE + F.lane] = kr; }
        else if (row < XS) { const int m = row - XM;
            for (int b = 0; b < NB; ++b) { ((f32x4*)(F.out + O_PKV + ((size_t)b * LP + m) * KVL))[F.lane] = lat; F.out[O_PKR + ((size_t)b * LP + m) * ROPE + F.lane] = kr; } }
        else { const int s = row - XS; ((f32x4*)(F.out + O_SKV + (size_t)s * KVL))[F.lane] = lat; F.out[O_SKR + (size_t)s * ROPE + F.lane] = kr; }
        float qa[6]; float sq = 0.f;
#pragma unroll
        for (int j = 0; j < 6; ++j) { qa[j] = bf2f(cr[320 + F.lane + 64 * j]); sq += qa[j] * qa[j]; }
        sq = wave_sum(sq); const float rq = rsqrtf(sq * (1.f / QL) + EPS);
#pragma unroll
        for (int j = 0; j < 6; ++j) QAN[(size_t)row * QL + F.lane + 64 * j] = (bf16)f2bf(qa[j] * rq * gq[j]);
    }
}
__device__ __forceinline__ void p_qrope(Frame& F) {
    const int gw = F.bid * 8 + F.wave, NGW = F.G * 8;
    bf16* Q = (bf16*)(F.ws + WS_Q); const float* ctab = (const float*)(F.ws + WS_ROPE); const float* stab = ctab + NPOSTAB * 32;
    for (int row = gw; row < NVALID; row += NGW) {
        const int posidx = row < TR ? NMETA + (row & (SEQ - 1)) : (row < XS ? row - XM : LP);
#pragma unroll
        for (int j = 0; j < 4; ++j) { const int idx = F.lane + 64 * j, h = idx >> 5, i = idx & 31; bf16* q = Q + (size_t)row * 1536 + h * HD + NOPE + i;
            const float x1 = bf2f(q[0]), x2 = bf2f(q[32]), cs = ctab[posidx * 32 + i], sn = stab[posidx * 32 + i];
            q[0] = (bf16)f2bf(x1 * cs - x2 * sn); q[32] = (bf16)f2bf(x2 * cs + x1 * sn); }
    }
}

constexpr int SHM_K = 64 * HD * 2, SHM_V = 64 * 128 * 2;
constexpr int ATT_K = 0, ATT_V = 2 * SHM_K, ATT_WS = ATT_V + 3 * SHM_V, ATT_QPE = ATT_WS + 8 * 64 * 4;
static_assert(ATT_QPE + 8 * 4096 <= CTLLDS_OFF, "attention LDS");
#define KSWZ(row, colB) ((row) * 384 + ((colB) ^ ((((row) >> 1) & 7) << 4)))
__device__ __forceinline__ int v_st(int k, int c) { const int kk = (k & ~0xC) | ((k & 4) << 1) | ((k & 8) >> 1); return ((kk >> 3) * 4 + (c >> 5)) * 512 + ((kk & 7) * 32 + (c & 31)) * 2; }
__device__ __forceinline__ int v_rd_base(int lane) { return ((lane & 3) << 3) | (((lane >> 2) & 3) << 6) | (((lane >> 4) & 1) << 5) | (((lane >> 5) & 1) << 8); }
constexpr int v_rd_off(int d0, int ks, int half) { return d0 * 512 + ks * 4096 + half * 2048; }
__device__ __forceinline__ int crow(int r, int hi) { return (r & 3) + 8 * (r >> 2) + 4 * hi; }
__device__ __forceinline__ unsigned cvtpk(float lo, float hi) { return pg8::cvt_pk_bf16(lo, hi); }
__device__ __forceinline__ bf16x8 pack8f(const f32x4 a, const f32x4 b) { v4u w = {cvtpk(a.x, a.y), cvtpk(a.z, a.w), cvtpk(b.x, b.y), cvtpk(b.z, b.w)}; return *reinterpret_cast<bf16x8*>(&w); }
__device__ __forceinline__ f32x4 mfma16(bf16x8 a, bf16x8 b, f32x4 c) { return __builtin_amdgcn_mfma_f32_16x16x32_bf16(a, b, c, 0, 0, 0); }
constexpr float ATT_THR = 8.f;
__device__ __forceinline__ void partialSM(f32x16& p0, f32x16& p1, float& m_reg, float& mn, float& alpha) {
    float pmax = p0[0];
#pragma unroll
    for (int r = 1; r < 16; ++r) pmax = fmaxf(pmax, p0[r]);
#pragma unroll
    for (int r = 0; r < 16; ++r) pmax = fmaxf(pmax, p1[r]);
    { auto rr = __builtin_amdgcn_permlane32_swap(__float_as_uint(pmax), __float_as_uint(pmax), false, false);
      pmax = fmaxf(__uint_as_float(rr[0]), __uint_as_float(rr[1])); }
    constexpr float C2 = 1.4426950408889634f * MLA_SCALE;
    if (__builtin_expect(__all((pmax - m_reg) * MLA_SCALE <= ATT_THR), 1)) { mn = m_reg; alpha = 1.f; }
    else { mn = fmaxf(m_reg, pmax); alpha = __builtin_amdgcn_exp2f((m_reg - mn) * C2); m_reg = mn; }
    const float mnL = -mn * C2;
#pragma unroll
    for (int r = 0; r < 16; ++r) p0[r] = fmaf(p0[r], C2, mnL);
#pragma unroll
    for (int r = 0; r < 16; ++r) p1[r] = fmaf(p1[r], C2, mnL);
#pragma unroll
    for (int r = 0; r < 16; ++r) p0[r] = __builtin_amdgcn_exp2f(p0[r]);
}
__device__ __forceinline__ void finishSM(f32x16& p0, f32x16& p1, float alpha, float& l_reg, bf16x8& pa0, bf16x8& pa1, bf16x8& pa2, bf16x8& pa3) {
#pragma unroll
    for (int r = 0; r < 16; ++r) p1[r] = __builtin_amdgcn_exp2f(p1[r]);
    float ps = 0;
#pragma unroll
    for (int r = 0; r < 16; ++r) ps += p0[r];
#pragma unroll
    for (int r = 0; r < 16; ++r) ps += p1[r];
    { auto rr = __builtin_amdgcn_permlane32_swap(__float_as_uint(ps), __float_as_uint(ps), false, false);
      ps = __uint_as_float(rr[0]) + __uint_as_float(rr[1]); }
    l_reg = l_reg * alpha + ps;
#define PK4(P, B_, OUT) do { unsigned a0 = cvtpk(P[B_+0], P[B_+1]), a1 = cvtpk(P[B_+2], P[B_+3]);                          \
        unsigned b0 = cvtpk(P[B_+4], P[B_+5]), b1 = cvtpk(P[B_+6], P[B_+7]);                                             \
        auto r0 = __builtin_amdgcn_permlane32_swap(a0, b0, false, false); auto r1 = __builtin_amdgcn_permlane32_swap(a1, b1, false, false); \
        v4u w = {r0[0], r1[0], r0[1], r1[1]}; OUT = *reinterpret_cast<bf16x8*>(&w); } while (0)
    PK4(p0, 0, pa0); PK4(p0, 8, pa1); PK4(p1, 0, pa2); PK4(p1, 8, pa3);
#undef PK4
}
__device__ __forceinline__ void qkt192(f32x16& p0, f32x16& p1, const LAS char* Kb, int r32, int hi, const bf16x8* qr, const LAS char* qpe) {
    p0 = f32x16{}; p1 = f32x16{};
    const LAS char* kb[4];
#pragma unroll
    for (int dd = 0; dd < 4; ++dd) kb[dd] = Kb + KSWZ(r32, (dd * 16 + hi * 8) * 2);
#pragma unroll
    for (int d0 = 0; d0 < 12; ++d0) { const LAS char* a = kb[d0 & 3] + (d0 >> 2) * 128;
        const bf16x8 b0 = *(const LAS bf16x8*)a, b1 = *(const LAS bf16x8*)(a + 32 * 384);
        const bf16x8 qf = d0 < 8 ? qr[d0 & 7] : *(const LAS bf16x8*)(qpe + (d0 & 3) * 1024);
        p0 = __builtin_amdgcn_mfma_f32_32x32x16_bf16(b0, qf, p0, 0, 0, 0);
        p1 = __builtin_amdgcn_mfma_f32_32x32x16_bf16(b1, qf, p1, 0, 0, 0);
        if ((d0 & 3) == 3) __builtin_amdgcn_sched_barrier(0); }
}
__device__ __forceinline__ void pv_tile(f32x16* o, int vb0, bf16x8 pa0, bf16x8 pa1, bf16x8 pa2, bf16x8 pa3) {
#define TRRD(dst, off) asm volatile("ds_read_b64_tr_b16 %0, %1 offset:%2" : "=&v"(dst) : "v"(vb0), "i"(off) : "memory")
#define PV_D0(d0) do { s16x4 l0, l1, l2, l3, h0, h1, h2, h3; constexpr int b_ = v_rd_off(d0, 0, 0); \
        TRRD(l0, b_); TRRD(h0, b_ + 2048); TRRD(l1, b_ + 4096); TRRD(h1, b_ + 6144); TRRD(l2, b_ + 8192); TRRD(h2, b_ + 10240); TRRD(l3, b_ + 12288); TRRD(h3, b_ + 14336); \
        asm volatile("s_waitcnt lgkmcnt(0)" ::: "memory"); __builtin_amdgcn_sched_barrier(0); \
        o[d0] = __builtin_amdgcn_mfma_f32_32x32x16_bf16(pa0, (bf16x8){l0[0], l0[1], l0[2], l0[3], h0[0], h0[1], h0[2], h0[3]}, o[d0], 0, 0, 0);   \
        o[d0] = __builtin_amdgcn_mfma_f32_32x32x16_bf16(pa1, (bf16x8){l1[0], l1[1], l1[2], l1[3], h1[0], h1[1], h1[2], h1[3]}, o[d0], 0, 0, 0);   \
        o[d0] = __builtin_amdgcn_mfma_f32_32x32x16_bf16(pa2, (bf16x8){l2[0], l2[1], l2[2], l2[3], h2[0], h2[1], h2[2], h2[3]}, o[d0], 0, 0, 0);   \
        o[d0] = __builtin_amdgcn_mfma_f32_32x32x16_bf16(pa3, (bf16x8){l3[0], l3[1], l3[2], l3[3], h3[0], h3[1], h3[2], h3[3]}, o[d0], 0, 0, 0); } while (0)
    PV_D0(0); PV_D0(1); PV_D0(2); PV_D0(3);
#undef PV_D0
#undef TRRD
}
__device__ __forceinline__ void attn_qblock(Frame& F, int b, int h, int qb) {
    const int wid = F.wave, lane = F.lane, r32 = lane & 31, hi = lane >> 5;
    const bf16* Q = (const bf16*)(F.ws + WS_Q); const bf16* KNV = (const bf16*)(F.ws + WS_KNV); const bf16* KRB = (const bf16*)(F.ws + WS_KRB); bf16* AO = (bf16*)(F.ws + WS_AO);
    LAS char* K_lds = (LAS char*)F.lds + ATT_K; LAS char* V_lds = (LAS char*)F.lds + ATT_V;
    LAS float* wsf = (LAS float*)(F.lds + ATT_WS) + wid * 64; LAS float* li_l = wsf; LAS float* al_l = wsf + 32;
    bf16x8 qr[8]; LAS char* qpe = (LAS char*)F.lds + ATT_QPE + wid * 4096 + lane * 16;
    { const bf16* qp = Q + (size_t)(b * SEQ + qb * 256 + wid * 32 + r32) * 1536 + h * HD + hi * 8;
#pragma unroll
      for (int d0 = 0; d0 < 8; ++d0) qr[d0] = *(const bf16x8*)(qp + d0 * 16);
      const float* ctab = (const float*)(F.ws + WS_ROPE); const float* stab = ctab + NPOSTAB * 32; const int pidx = (NMETA + qb * 256 + wid * 32 + r32) * 32 + hi * 8;
#pragma unroll
      for (int pr = 0; pr < 2; ++pr) { const v4u wa = *(const v4u*)(qp + (8 + pr) * 16), wb = *(const v4u*)(qp + (10 + pr) * 16);
          const f32x4 c0 = *(const f32x4*)(ctab + pidx + 16 * pr), c1 = *(const f32x4*)(ctab + pidx + 16 * pr + 4), s0 = *(const f32x4*)(stab + pidx + 16 * pr), s1 = *(const f32x4*)(stab + pidx + 16 * pr + 4);
          const float xa[8] = {bflo(wa.x), bfhi(wa.x), bflo(wa.y), bfhi(wa.y), bflo(wa.z), bfhi(wa.z), bflo(wa.w), bfhi(wa.w)}, xb[8] = {bflo(wb.x), bfhi(wb.x), bflo(wb.y), bfhi(wb.y), bflo(wb.z), bfhi(wb.z), bflo(wb.w), bfhi(wb.w)};
          const float cs[8] = {c0.x, c0.y, c0.z, c0.w, c1.x, c1.y, c1.z, c1.w}, sn[8] = {s0.x, s0.y, s0.z, s0.w, s1.x, s1.y, s1.z, s1.w};
          float oa[8], ob[8];
#pragma unroll
          for (int e = 0; e < 8; ++e) { oa[e] = xa[e] * cs[e] - xb[e] * sn[e]; ob[e] = xb[e] * cs[e] + xa[e] * sn[e]; }
          const v4u va = {cvtpk(oa[0], oa[1]), cvtpk(oa[2], oa[3]), cvtpk(oa[4], oa[5]), cvtpk(oa[6], oa[7])}, vb = {cvtpk(ob[0], ob[1]), cvtpk(ob[2], ob[3]), cvtpk(ob[4], ob[5]), cvtpk(ob[6], ob[7])};
          *(LAS v4u*)(qpe + pr * 1024) = va; *(LAS v4u*)(qpe + (2 + pr) * 1024) = vb; } }
    const int NT = 1 + 4 * (qb + 1);
    unsigned k0o[3], k1o[3], v0o[2], v1o[2];
#pragma unroll
    for (int j = 0; j < 3; ++j) { const int off = 1024 * (wid * 3 + j) + 16 * lane, row = off / 384, cb = off - row * 384, colB = cb ^ (((row >> 1) & 7) << 4), col = colB >> 1; const bool isr = col >= 128;
        const unsigned rb = isr ? (unsigned)(ROPE * 2) : 4096u, cpart = isr ? (unsigned)(WS_KRB + (size_t)(col - 128) * 2) : (unsigned)(WS_KNV + (size_t)(h * 128 + col) * 2);
        k0o[j] = (unsigned)(XM + (row < 16 ? row : 15)) * rb + cpart; k1o[j] = ((unsigned)(b * SEQ + row) * rb + cpart) | (isr ? 1u : 0u); }
#pragma unroll
    for (int j = 0; j < 2; ++j) { const int off = 1024 * (wid * 2 + j) + 16 * lane, sub = off >> 9, within = off & 511, kk = (sub >> 2) * 8 + (within >> 6), k = (kk & ~0xC) | ((kk & 4) << 1) | ((kk & 8) >> 1);
        const unsigned cpart = (unsigned)(WS_KNV + (size_t)(1024 + h * 128 + (sub & 3) * 32 + ((within & 63) >> 1)) * 2);
        v0o[j] = (unsigned)(XM + (k < 16 ? k : 15)) * 4096u + cpart; v1o[j] = (unsigned)(b * SEQ + k) * 4096u + cpart; }
    const GAS unsigned char* wsb = F.ws;
#define KDMA0(bi) do { _Pragma("unroll") for (int j_ = 0; j_ < 3; ++j_) __builtin_amdgcn_global_load_lds((const unsigned*)(wsb + k0o[j_]), (LAS unsigned*)(K_lds + (bi) * SHM_K + (wid * 3 + j_) * 1024), 16, 0, 0); } while (0)
#define VDMA0(bi) do { _Pragma("unroll") for (int j_ = 0; j_ < 2; ++j_) __builtin_amdgcn_global_load_lds((const unsigned*)(wsb + v0o[j_]), (LAS unsigned*)(V_lds + (bi) * SHM_V + (wid * 2 + j_) * 1024), 16, 0, 0); } while (0)
#define KDMA(t, bi) do { _Pragma("unroll") for (int j_ = 0; j_ < 3; ++j_) { const unsigned o_ = (k1o[j_] & ~1u) + (unsigned)((t) - 1) * ((k1o[j_] & 1u) ? 64u * (unsigned)(ROPE * 2) : 64u * 4096u); \
            __builtin_amdgcn_global_load_lds((const unsigned*)(wsb + o_), (LAS unsigned*)(K_lds + (bi) * SHM_K + (wid * 3 + j_) * 1024), 16, 0, 0); } } while (0)
#define VDMA(t, bi) do { _Pragma("unroll") for (int j_ = 0; j_ < 2; ++j_) { const unsigned o_ = v1o[j_] + (unsigned)((t) - 1) * (64u * 4096u); \
            __builtin_amdgcn_global_load_lds((const unsigned*)(wsb + o_), (LAS unsigned*)(V_lds + (bi) * SHM_V + (wid * 2 + j_) * 1024), 16, 0, 0); } } while (0)
    const int vb0 = (int)(unsigned)(uintptr_t)V_lds + v_rd_base(lane);
    const int qlo = qb * 256 + wid * 32, qm = qlo + r32 - 4 * hi;
    KDMA0(0); VDMA0(0); KDMA(1, 1); VDMA(1, 1);
    float m_reg = -1e30f, l_reg = 0.f; f32x16 o[4] = {};
    const float NEG = -__builtin_inff();
    f32x16 pA0, pA1, pB0, pB1; float mnA, mnB, alA, alB; bf16x8 pa0, pa1, pa2, pa3;
#define RESC(a) do { if (__any((a) < 1.f)) { if (hi == 0) al_l[r32] = (a); LDS_WAIT(); \
        _Pragma("unroll") for (int d_ = 0; d_ < 4; ++d_) _Pragma("unroll") for (int r = 0; r < 16; ++r) o[d_][r] *= al_l[crow(r, hi)]; } } while (0)
#define MASKT(P0_, P1_, t_) do { const int kb_ = ((t_) - 1) * 64; if (kb_ + 63 > qlo) { const int dq = qm - kb_; \
        _Pragma("unroll") for (int r = 0; r < 16; ++r) { const int c = (r & 3) + 8 * (r >> 2); if (dq - c < 0) P0_[r] = NEG; if (dq - c - 32 < 0) P1_[r] = NEG; } } } while (0)
    asm volatile("s_waitcnt vmcnt(5)" ::: "memory"); asm volatile("s_waitcnt lgkmcnt(0)" ::: "memory"); __builtin_amdgcn_s_barrier(); asm volatile("" ::: "memory");
    qkt192(pA0, pA1, K_lds, r32, hi, qr, qpe);
#pragma unroll
    for (int r = 0; r < 16; ++r) { const int c = (r & 3) + 8 * (r >> 2) + 4 * hi; if (c >= NMETA) pA0[r] = NEG; pA1[r] = NEG; }
    partialSM(pA0, pA1, m_reg, mnA, alA);
    int vprev = 0, vcur = 1;
#define HALF_STEP(PX0, PX1, mnX, alX, PY0, PY1, alY, t_) do { \
        asm volatile("s_waitcnt vmcnt(2)" ::: "memory"); asm volatile("s_waitcnt lgkmcnt(0)" ::: "memory"); __builtin_amdgcn_s_barrier(); asm volatile("" ::: "memory");     \
        const int vnext_ = vcur == 2 ? 0 : vcur + 1; \
        if ((t_) + 1 < NT) { KDMA((t_) + 1, ((t_) + 1) & 1); VDMA((t_) + 1, vnext_); } \
        qkt192(PX0, PX1, K_lds + ((t_) & 1) * SHM_K, r32, hi, qr, qpe); \
        finishSM(PY0, PY1, alY, l_reg, pa0, pa1, pa2, pa3); __builtin_amdgcn_sched_barrier(0); \
        pv_tile(o, vb0 + vprev * SHM_V, pa0, pa1, pa2, pa3); \
        MASKT(PX0, PX1, t_); partialSM(PX0, PX1, m_reg, mnX, alX); \
        RESC(alX); \
        vprev = vcur; vcur = vnext_; } while (0)
#pragma unroll 1
    for (int t = 1; t + 1 < NT; t += 2) {
        HALF_STEP(pB0, pB1, mnB, alB, pA0, pA1, alA, t);
        HALF_STEP(pA0, pA1, mnA, alA, pB0, pB1, alB, t + 1);
    }
    asm volatile("s_waitcnt vmcnt(0)" ::: "memory"); asm volatile("s_waitcnt lgkmcnt(0)" ::: "memory"); __builtin_amdgcn_s_barrier(); asm volatile("" ::: "memory");
    finishSM(pA0, pA1, alA, l_reg, pa0, pa1, pa2, pa3); __builtin_amdgcn_sched_barrier(0);
    pv_tile(o, vb0 + vprev * SHM_V, pa0, pa1, pa2, pa3);
#undef HALF_STEP
#undef MASKT
#undef RESC
    { int ln = F.lane; asm volatile("" : "+v"(ln));
      const int r32e = ln & 31, hie = ln >> 5; LAS float* li_e = (LAS float*)(F.lds + ATT_WS) + wid * 64;
      if (hie == 0) li_e[r32e] = l_reg; LDS_WAIT();
      bf16* Ow = (bf16*)(F.ws + WS_AO) + (size_t)(b * SEQ + qb * 256 + wid * 32) * DM + h * 128;
#pragma unroll
      for (int r = 0; r < 16; ++r) { const int orow = crow(r, hie); const float rl = __builtin_amdgcn_rcpf(li_e[orow]);
#pragma unroll
          for (int d0 = 0; d0 < 4; ++d0) { const float v = o[d0][r] * rl; const float vn = DPPF(v, 0xB1);
              if ((r32e & 1) == 0) *(unsigned*)(Ow + (size_t)orow * DM + d0 * 32 + r32e) = cvtpk(v, vn); } } }
    __syncthreads();
#undef KDMA
#undef VDMA
#undef KDMA0
#undef VDMA0
}
__device__ __forceinline__ void attn_meta(Frame& F) {
    const bf16* Q = (const bf16*)(F.ws + WS_Q); const bf16* KNV = (const bf16*)(F.ws + WS_KNV); const bf16* KRB = (const bf16*)(F.ws + WS_KRB); bf16* AO = (bf16*)(F.ws + WS_AO);
    for (int it = F.wave; it < NMETA * MH; it += 8) {
        const int m = it >> 3, h = it & 7;
        const bf16* q = Q + (size_t)(XM + m) * 1536 + h * HD;
        const float q0 = bf2f(q[F.lane]), q1 = bf2f(q[64 + F.lane]); float q2;
        { const float* ctab = (const float*)(F.ws + WS_ROPE); const float* stab = ctab + NPOSTAB * 32; const int i = F.lane & 31; const float x = bf2f(q[128 + F.lane]), y = [&]{ auto r_ = __builtin_amdgcn_permlane32_swap(__float_as_uint(x), __float_as_uint(x), false, false); return F.lane < 32 ? __uint_as_float(r_[1]) : __uint_as_float(r_[0]); }(), cs = ctab[m * 32 + i], sn = stab[m * 32 + i];
          q2 = F.lane < 32 ? x * cs - y * sn : x * cs + y * sn; }
        float sc[NMETA]; float mx = -1e30f;
#pragma unroll
        for (int k = 0; k < NMETA; ++k) { const bf16* kn = KNV + (size_t)(XM + k) * 2048 + h * 128; const float d = wave_sum(q0 * bf2f(kn[F.lane]) + q1 * bf2f(kn[64 + F.lane]) + q2 * bf2f(KRB[(size_t)(XM + k) * ROPE + F.lane]));
            sc[k] = k <= m ? d * MLA_SCALE : -1e30f; mx = fmaxf(mx, sc[k]); }
        float l = 0.f, o0 = 0.f, o1 = 0.f;
#pragma unroll
        for (int k = 0; k < NMETA; ++k) { const float p = k <= m ? __expf(sc[k] - mx) : 0.f; l += p; const bf16* v = KNV + (size_t)(XM + k) * 2048 + 1024 + h * 128; o0 += p * bf2f(v[F.lane]); o1 += p * bf2f(v[64 + F.lane]); }
        AO[(size_t)(XM + m) * DM + h * 128 + F.lane] = (bf16)f2bf(o0 / l); AO[(size_t)(XM + m) * DM + h * 128 + 64 + F.lane] = (bf16)f2bf(o1 / l);
    }
}
__device__ __forceinline__ void attn_sample_item(Frame& F, int s) {
    const int tid = F.tid, lane = F.lane, wid = F.wave;
    const bf16* Q = (const bf16*)(F.ws + WS_Q) + (size_t)(XS + s) * 1536;
    LAS float* qn = (LAS float*)F.lds;
    LAS float* qlat = qn + 8 * 192;
    LAS float* qpe = qlat + 8 * 256;
    LAS float* xm = qpe + 8 * 64;
    LAS float* xl = xm + 64;
    LAS float* ssf = xl + 64;
    LAS int* ptl = (LAS int*)(ssf + 64);
    LAS float* xo = (LAS float*)(ptl + 64);
    LAS float* olat = xo + 8 * 8 * 256;
    for (int i = tid; i < 8 * 192; i += 512) qn[i] = bf2f(Q[i]);
    if (tid < NPAGE) ptl[tid] = ((const int*)F.in[I_PT])[s * NPAGE + tid];
    __syncthreads();
    { const float* wuk = F.in[I_WUK] + wid * 128 + lane; const float q0 = qn[wid * 192 + lane], q1 = qn[wid * 192 + 64 + lane];
#pragma unroll 1
      for (int rb = 0; rb < 256; rb += 64) {
          float a[64];
#pragma unroll
          for (int r = 0; r < 64; ++r) { const float* w = wuk + (size_t)(rb + r) * 1024; a[r] = q0 * w[0] + q1 * w[64]; }
#pragma unroll
          for (int i = 0; i < 32; ++i) { auto r_ = __builtin_amdgcn_permlane32_swap(__float_as_uint(a[i]), __float_as_uint(a[i + 32]), false, false); a[i] = __uint_as_float(r_[0]) + __uint_as_float(r_[1]); }
#pragma unroll
          for (int i = 0; i < 16; ++i) { auto r_ = __builtin_amdgcn_permlane16_swap(__float_as_uint(a[i]), __float_as_uint(a[i + 16]), false, false); a[i] = __uint_as_float(r_[0]) + __uint_as_float(r_[1]); }
#define SA_DPP(x, ctrl) __builtin_bit_cast(float, __builtin_amdgcn_update_dpp(0, __builtin_bit_cast(int, (x)), (ctrl), 0xF, 0xF, false))
          { const bool b3 = (lane & 8) != 0, b2 = (lane & 4) != 0, b1 = (lane & 2) != 0, b0 = (lane & 1) != 0;
#pragma unroll
            for (int i = 0; i < 8; ++i) { const float keep = b3 ? a[i + 8] : a[i], send = b3 ? a[i] : a[i + 8]; a[i] = keep + SA_DPP(send, 0x140); }
#pragma unroll
            for (int i = 0; i < 4; ++i) { const float keep = b2 ? a[i + 4] : a[i], send = b2 ? a[i] : a[i + 4]; a[i] = keep + SA_DPP(send, 0x141); }
#pragma unroll
            for (int i = 0; i < 2; ++i) { const float keep = b1 ? a[i + 2] : a[i], send = b1 ? a[i] : a[i + 2]; a[i] = keep + SA_DPP(send, 0x1B); }
            { const float keep = b0 ? a[1] : a[0], send = b0 ? a[0] : a[1]; a[0] = keep + SA_DPP(send, 0xB1); } }
          qlat[wid * 256 + rb + lane] = a[0];
      }
      { const float* ctab = (const float*)(F.ws + WS_ROPE); const float* stab = ctab + NPOSTAB * 32; const int i = lane & 31; const float x1 = qn[wid * 192 + 128 + i], x2 = qn[wid * 192 + 160 + i], cs = ctab[LP * 32 + i], sn = stab[LP * 32 + i];
        qpe[tid] = lane < 32 ? x1 * cs - x2 * sn : x2 * cs + x1 * sn; } }
    __syncthreads();
    const GAS float* cs = F.out + O_SKV + (size_t)s * KVL; const GAS float* krs = F.out + O_SKR + (size_t)s * ROPE;
    { const f32x4 qv = *(const LAS f32x4*)(qlat + wid * 256 + 4 * lane), cv = ((const f32x4*)cs)[lane];
      const float d = wave_sum((qv.x * cv.x + qv.y * cv.y) + (qv.z * cv.z + qv.w * cv.w) + qpe[wid * 64 + lane] * krs[lane]); if (lane == 0) ssf[wid] = d * MLA_SCALE; }
    const int c16 = lane & 15, g = lane >> 4;
    LAS bf16x8* qfl = (LAS bf16x8*)(olat + 8 * 256);
#pragma unroll
    for (int ks = 0; ks < 10; ++ks) { f32x4 a = {0.f, 0.f, 0.f, 0.f}, b = a;
        if (c16 < 8) { const LAS float* qq = ks < 8 ? qlat + c16 * 256 + 32 * ks + 8 * g : qpe + c16 * 64 + 32 * (ks - 8) + 8 * g; a = *(const LAS f32x4*)qq; b = *(const LAS f32x4*)(qq + 4); }
        if (wid == 0) qfl[ks * 64 + lane] = pack8f(a, b); }
    __syncthreads();
    float o[8][4]; float m_run = -1e30f, l_run = 0.f;
#pragma unroll
    for (int h = 0; h < 8; ++h) { o[h][0] = 0.f; o[h][1] = 0.f; o[h][2] = 0.f; o[h][3] = 0.f; }
    const float* ckv = F.in[I_CKV]; const float* ckr = F.in[I_CKR];
    LAS char* vt = (LAS char*)xo + wid * (16 * 528);
    const unsigned lo_t = (unsigned)(c16 * KVL + 8 * g) * 4u, lo_r = (unsigned)(c16 * ROPE + 8 * g) * 4u;
    const char* ckvb = (const char*)ckv; const char* ckrb = (const char*)ckr;
#define SA_LOADT(gi_) do { const unsigned page_ = (unsigned)__builtin_amdgcn_readfirstlane(ptl[wid * 8 + ((gi_) >> 3)]); const unsigned row_ = page_ * (unsigned)PAGE + (unsigned)(((gi_) & 7) * 16); \
        const unsigned ka_ = row_ * (unsigned)(KVL * 4) + lo_t, ra_ = row_ * (unsigned)(ROPE * 4) + lo_r; \
        _Pragma("unroll") for (int ks = 0; ks < 8; ++ks) { t[2 * ks] = *(const f32x4*)(ckvb + (ka_ + 128u * ks)); t[2 * ks + 1] = *(const f32x4*)(ckvb + (ka_ + 128u * ks + 16u)); } \
        t[16] = *(const f32x4*)(ckrb + ra_); t[17] = *(const f32x4*)(ckrb + (ra_ + 16u)); t[18] = *(const f32x4*)(ckrb + (ra_ + 128u)); t[19] = *(const f32x4*)(ckrb + (ra_ + 144u)); } while (0)
    f32x4 t[20];
    SA_LOADT(0);
#pragma unroll 1
    for (int gi = 0; gi < 64; ++gi) {
        bf16x8 kf[10];
#pragma unroll
        for (int ks = 0; ks < 10; ++ks) kf[ks] = pack8f(t[2 * ks], t[2 * ks + 1]);
        __builtin_amdgcn_sched_barrier(0);
        if (gi < 63) SA_LOADT(gi + 1);
        __builtin_amdgcn_sched_barrier(0);
        f32x4 acc = {0.f, 0.f, 0.f, 0.f};
#pragma unroll
        for (int ks = 0; ks < 10; ++ks) acc = mfma16(kf[ks], qfl[ks * 64 + lane], acc);
#pragma unroll
        for (int ks = 0; ks < 8; ++ks) *(LAS bf16x8*)(vt + c16 * 528 + (32 * ks + 8 * g) * 2) = kf[ks];
        float sc[4], mx;
#pragma unroll
        for (int r = 0; r < 4; ++r) sc[r] = acc[r] * MLA_SCALE;
        mx = fmaxf(fmaxf(sc[0], sc[1]), fmaxf(sc[2], sc[3]));
        { auto r_ = __builtin_amdgcn_permlane16_swap(__float_as_uint(mx), __float_as_uint(mx), false, false); mx = fmaxf(__uint_as_float(r_[0]), __uint_as_float(r_[1])); }
        { auto r_ = __builtin_amdgcn_permlane32_swap(__float_as_uint(mx), __float_as_uint(mx), false, false); mx = fmaxf(__uint_as_float(r_[0]), __uint_as_float(r_[1])); }
        const float mnew = fmaxf(m_run, mx), alpha = __expf(m_run - mnew); float pr[4], ps;
#pragma unroll
        for (int r = 0; r < 4; ++r) pr[r] = __expf(sc[r] - mnew);
        ps = (pr[0] + pr[1]) + (pr[2] + pr[3]);
        { auto r_ = __builtin_amdgcn_permlane16_swap(__float_as_uint(ps), __float_as_uint(ps), false, false); ps = __uint_as_float(r_[0]) + __uint_as_float(r_[1]); }
        { auto r_ = __builtin_amdgcn_permlane32_swap(__float_as_uint(ps), __float_as_uint(ps), false, false); ps = __uint_as_float(r_[0]) + __uint_as_float(r_[1]); }
        l_run = l_run * alpha + ps; m_run = mnew;
        LDS_WAIT();
        v2u cw_[16];
#pragma unroll
        for (int k = 0; k < 16; ++k) cw_[k] = *(const LAS v2u*)(vt + k * 528 + lane * 8);
#pragma unroll
        for (int h = 0; h < 8; ++h) { const float ah = __builtin_bit_cast(float, __builtin_amdgcn_readlane(__builtin_bit_cast(int, alpha), h));
            o[h][0] *= ah; o[h][1] *= ah; o[h][2] *= ah; o[h][3] *= ah;
#pragma unroll
            for (int k = 0; k < 16; ++k) { const float pk = __builtin_bit_cast(float, __builtin_amdgcn_readlane(__builtin_bit_cast(int, pr[k & 3]), (k >> 2) * 16 + h));
                o[h][0] += pk * bflo(cw_[k].x); o[h][1] += pk * bfhi(cw_[k].x); o[h][2] += pk * bflo(cw_[k].y); o[h][3] += pk * bfhi(cw_[k].y); } }
    }
#undef SA_LOADT
#undef SA_DPP
    __syncthreads();
    if (lane < 8) { xm[wid * 8 + lane] = m_run; xl[wid * 8 + lane] = l_run; }
#pragma unroll
    for (int h = 0; h < 8; ++h) *(LAS f32x4*)(xo + (size_t)(wid * 8 + h) * 256 + 4 * lane) = (f32x4){o[h][0], o[h][1], o[h][2], o[h][3]};
    __syncthreads();
    for (int e = tid; e < 8 * 256; e += 512) { const int h = e >> 8, r = e & 255; const float ms = ssf[h]; float M = ms;
#pragma unroll
        for (int w = 0; w < 8; ++w) M = fmaxf(M, xm[w * 8 + h]);
        const float es = __expf(ms - M); float acc = es * cs[r], L = es;
#pragma unroll
        for (int w = 0; w < 8; ++w) { const float e_ = __expf(xm[w * 8 + h] - M); acc += xo[(size_t)(w * 8 + h) * 256 + r] * e_; L += xl[w * 8 + h] * e_; }
        olat[e] = acc / L; }
    __syncthreads();
    const float* wuv = F.in[I_WUV]; bf16* AO = (bf16*)(F.ws + WS_AO) + (size_t)(XS + s) * DM;
    for (int e = tid; e < 8 * 128; e += 512) { const int h = e >> 7; const LAS float* ol = olat + h * 256; float acc = 0.f;
#pragma unroll 8
        for (int r = 0; r < 256; ++r) acc += ol[r] * wuv[(size_t)r * 1024 + e];
        AO[e] = (bf16)f2bf(acc); }
    __syncthreads();
}

constexpr int NCHR = NB * 32 * GH, NCH = NCHR + GH;
constexpr int TS = 132;
constexpr int SREC = 57344;
constexpr int SR_W = 0, SR_Q = 16384, SR_AT = 32768, SR_KT = 40960;

struct PrepRaw { v4u x[6]; f32x4 fx[4][2]; float ab_a, ab_b; };
struct PrepW { f32x4 w[4][2]; };
__device__ __forceinline__ void gdn_prep_load(Frame& F, int ch, PrepRaw& R) {
    if (ch >= NCHR) return;
    const int tid = F.tid, h = ch & 7, bc = ch >> 3, b = bc >> 5, c = bc & 31, row0 = b * SEQ + c * 64;
    const bf16* QKVZ = (const bf16*)(F.ws + WS_QKVZ);
#pragma unroll
    for (int k = 0; k < 6; ++k) { const int uu = tid + 512 * k, tok = uu / 48, cg = uu - tok * 48, col0 = cg * 8, gcol = (col0 >> 7) * 1024 + h * 128 + (col0 & 127);
        R.x[k] = *(const v4u*)(QKVZ + (size_t)(row0 + tok) * 4096 + gcol); }
    if (tid < 144) { const int tok = tid / 48, cg = tid - tok * 48, col0 = cg * 8, gcol = (col0 >> 7) * 1024 + h * 128 + (col0 & 127), grp = b * 32 + c; const float* RAWQ = (const float*)(F.ws + WS_RAWQ);
#pragma unroll
        for (int j = 0; j < 4; ++j) { const int r = tok - 3 + j;
            if (r >= 0 || c > 0) { const float* p = RAWQ + ((size_t)(r >= 0 ? grp : grp - 1) * 6 + (r >= 0 ? r : 6 + r)) * GQKV + gcol; R.fx[j][0] = *(const f32x4*)p; R.fx[j][1] = *(const f32x4*)(p + 4); }
            else { const v4u q = *(const v4u*)(QKVZ + (size_t)(XM + NMETA + r) * 4096 + gcol); R.fx[j][0] = (f32x4){bflo(q.x), bfhi(q.x), bflo(q.y), bfhi(q.y)}; R.fx[j][1] = (f32x4){bflo(q.z), bfhi(q.z), bflo(q.w), bfhi(q.w)}; } } }
    if (F.wave == 7) { const float* AB = (const float*)(F.ws + WS_AB); R.ab_a = AB[(size_t)(row0 + F.lane) * 16 + h]; R.ab_b = AB[(size_t)(row0 + F.lane) * 16 + 8 + h]; }
}
__device__ __forceinline__ void gdn_prep_item(Frame& F, int ch, PrepRaw& R, int next_ch, const float* cwbase, float Ah, float dtb, const PrepW& W) {
    asm volatile("" : "+v"(F.tid), "+v"(F.lane));
    const int tid = F.tid, lane = F.lane, wave = F.wave;
    const bool meta = ch >= NCHR; const int h = ch & 7, bc = ch >> 3, b = bc >> 5, c = bc & 31;
    const int row0 = meta ? XM : b * SEQ + c * 64;
    LAS float* qf = (LAS float*)F.lds; LAS float* kf = qf + 64 * TS; LAS float* vf = kf + 64 * TS; LAS float* gcs = vf + 64 * TS; LAS float* bes = gcs + 64;
    GAS unsigned char* srec = F.ws + WS_SREC + (size_t)ch * SREC;
    const bf16* QKVZ = (const bf16*)(F.ws + WS_QKVZ);
    if (!meta) {
#pragma unroll
        for (int k = 0; k < 6; ++k) { const int uu = tid + 512 * k, tok = uu / 48, cg = uu - tok * 48, col0 = cg * 8, part = col0 >> 7, cc = col0 & 127;
            if (k == 0 && tid < 144) continue;
            const v4u q = R.x[k]; LAS float* tile = (part == 0 ? qf : (part == 1 ? kf : vf)) + tok * TS + cc;
            *(LAS f32x4*)tile = (f32x4){bflo(q.x), bfhi(q.x), bflo(q.y), bfhi(q.y)}; *(LAS f32x4*)(tile + 4) = (f32x4){bflo(q.z), bfhi(q.z), bflo(q.w), bfhi(q.w)}; }
        if (tid < 144) { const int tok = tid / 48, cg = tid - tok * 48, col0 = cg * 8, part = col0 >> 7, cc = col0 & 127;
            float acc8[8];
#pragma unroll
            for (int e = 0; e < 8; ++e) acc8[e] = 0.f;
#pragma unroll
            for (int j = 0; j < 4; ++j) { const float wj[8] = {W.w[j][0].x, W.w[j][0].y, W.w[j][0].z, W.w[j][0].w, W.w[j][1].x, W.w[j][1].y, W.w[j][1].z, W.w[j][1].w};
                const float xr[8] = {R.fx[j][0].x, R.fx[j][0].y, R.fx[j][0].z, R.fx[j][0].w, R.fx[j][1].x, R.fx[j][1].y, R.fx[j][1].z, R.fx[j][1].w};
#pragma unroll
                for (int e = 0; e < 8; ++e) acc8[e] += wj[e] * xr[e]; }
            LAS float* tile = (part == 0 ? qf : (part == 1 ? kf : vf)) + tok * TS + cc;
            *(LAS f32x4*)tile = (f32x4){siluf(acc8[0]), siluf(acc8[1]), siluf(acc8[2]), siluf(acc8[3])}; *(LAS f32x4*)(tile + 4) = (f32x4){siluf(acc8[4]), siluf(acc8[5]), siluf(acc8[6]), siluf(acc8[7])}; }
    } else if (tid < 384) {
        const int cg = tid % 48, tg = tid / 48, col0 = cg * 8, part = col0 >> 7, cc = col0 & 127, gcol = part * 1024 + h * 128 + cc;
        const float* cw = cwbase + gcol;
        float w[4][8];
#pragma unroll
        for (int j = 0; j < 4; ++j) ld8f(cw + j * GQKV, w[j]);
        float x[11][8];
#pragma unroll
        for (int r = 0; r < 11; ++r) { const int tt = 8 * tg - 3 + r; const bool ok = tt >= 0 && tt < NMETA; const float m_ = ok ? 1.f : 0.f;
            ld8(QKVZ + (size_t)(ok ? XM + tt : XM) * 4096 + gcol, x[r]);
#pragma unroll
            for (int e = 0; e < 8; ++e) x[r][e] *= m_; }
        LAS float* tile = part == 0 ? qf : (part == 1 ? kf : vf);
#pragma unroll
        for (int t = 0; t < 8; ++t) { const int tok = 8 * tg + t; float o[8];
#pragma unroll
            for (int e = 0; e < 8; ++e) { const float a = (w[0][e] * x[t][e] + w[1][e] * x[t + 1][e]) + (w[2][e] * x[t + 2][e] + w[3][e] * x[t + 3][e]); o[e] = tok >= NMETA ? 0.f : siluf(a); }
            *(LAS f32x4*)(tile + tok * TS + cc) = (f32x4){o[0], o[1], o[2], o[3]}; *(LAS f32x4*)(tile + tok * TS + cc + 4) = (f32x4){o[4], o[5], o[6], o[7]}; }
    }
    const float ab_a = R.ab_a, ab_b = R.ab_b;
    asm volatile("" ::: "memory"); gdn_prep_load(F, next_ch, R);
    if (wave == 7) {
        const bool nul = meta && lane >= NMETA; float a = ab_a, bb = ab_b;
        if (meta) { const float* AB = (const float*)(F.ws + WS_AB); const int row = nul ? XM : row0 + lane; a = AB[(size_t)row * 16 + h]; bb = AB[(size_t)row * 16 + 8 + h]; }
        const float x = a + dtb, sp = x > 20.f ? x : log1pf(__expf(x)); float g = nul ? 0.f : -Ah * sp;
#pragma unroll
        for (int o = 1; o < 64; o <<= 1) { const float t = __shfl_up(g, o); if (lane >= o) g += t; }
        gcs[lane] = g; bes[lane] = nul ? 0.f : 1.f / (1.f + __expf(-bb));
    }
    LDS_BARRIER();
#ifndef PR2
#define PR2 1
#define PR3 1
#define PR4 1
#endif
    _Pragma("unroll 1") for (int pr2 = 0; pr2 < PR2; ++pr2)
#pragma unroll 8
    for (int v = wave * 16; v < wave * 16 + 16; ++v) { const int tok = v >> 1, isk = v & 1; LAS float* p = (isk ? kf : qf) + tok * TS; const float x0 = p[lane], x1 = p[lane + 64];
        const float ss = wave_sum(x0 * x0 + x1 * x1); const float r = rsqrtf(ss + EPS) * (isk ? 1.f : 0.08838834764831845f); p[lane] = x0 * r; p[lane + 64] = x1 * r; }
    LDS_BARRIER();
    const int r16 = lane & 15, g = lane >> 4;
#pragma unroll 2
    for (int jj = wave; jj < 32 * PR3; jj += 8) {
        const bool isA = (jj & 31) < 16; const int ta = (jj >> 2) & 3, tb = jj & 3;
        const bool live = isA ? (tb <= ta) : (tb >= ta);
        f32x4 acc = {0.f, 0.f, 0.f, 0.f};
        if (live) {
            const LAS float* pa = kf + (16 * ta + r16) * TS + 8 * g; const LAS float* pb = (isA ? kf : qf) + (16 * tb + r16) * TS + 8 * g;
#pragma unroll
            for (int ks = 0; ks < 4; ++ks) { const bf16x8 fa = pack8f(*(const LAS f32x4*)(pa + 32 * ks), *(const LAS f32x4*)(pa + 32 * ks + 4)), fb = pack8f(*(const LAS f32x4*)(pb + 32 * ks), *(const LAS f32x4*)(pb + 32 * ks + 4));
                acc = mfma16(fa, fb, acc); }
        }
        if (isA) { if (live) { float* GA = (float*)(F.ws + WS_GA) + (size_t)ch * 4096; const int j = 16 * tb + r16; const float gj = gcs[j];
#pragma unroll
                for (int r = 0; r < 4; ++r) { const int i = 16 * ta + 4 * g + r; GA[i * 64 + j] = i > j ? bes[i] * __expf(gcs[i] - gj) * acc[r] : 0.f; } } }
        else { const int i = 16 * tb + r16; const float gi = gcs[i]; float v[4];
#pragma unroll
            for (int r = 0; r < 4; ++r) { const int j = 16 * ta + 4 * g + r; v[r] = (live && i >= j) ? __expf(gi - gcs[j]) * acc[r] : 0.f; }
            *(v2u*)(srec + SR_AT + ((tb * 2 + (ta >> 1)) * 64 + lane) * 16 + 8 * (ta & 1)) = (v2u){cvtpk(v[0], v[1]), cvtpk(v[2], v[3])}; }
    }
    const float glast = gcs[63];
#pragma unroll 4
    for (int q_ = 0; q_ < 8 * PR4; ++q_) { const int q = q_ & 7;
        const int which = q >> 1, f = (q & 1) * 8 + wave; float v[8];
        if (which == 0) { const int t = f >> 2, ks = f & 3, tok = 16 * t + r16; const float sc = __expf(gcs[tok]); const LAS float* p = qf + tok * TS + 32 * ks + 4 * g;
            const f32x4 a = *(const LAS f32x4*)p, bq = *(const LAS f32x4*)(p + 16);
            *(bf16x8*)(srec + SR_Q + (f * 64 + lane) * 16) = pack8f(a * sc, bq * sc); }
        else if (which == 1) { const int mt = f >> 1, ks = f & 1, dk = 16 * mt + r16;
#pragma unroll
            for (int e = 0; e < 8; ++e) { const int tok = 32 * ks + 16 * (e >> 2) + 4 * g + (e & 3); v[e] = kf[tok * TS + dk] * __expf(glast - gcs[tok]); }
            *(bf16x8*)(srec + SR_KT + (f * 64 + lane) * 16) = pack8f((f32x4){v[0], v[1], v[2], v[3]}, (f32x4){v[4], v[5], v[6], v[7]}); }
        else { const int nt = f >> 1, ks = f & 1, col = 16 * nt + r16; const LAS float* tile = which == 2 ? vf : kf;
#pragma unroll
            for (int e = 0; e < 8; ++e) { const int tok = 32 * ks + 8 * g + e; v[e] = tile[tok * TS + col] * bes[tok] * (which == 2 ? 1.f : __expf(gcs[tok])); }
            *(bf16x8*)(F.ws + (which == 2 ? WS_GRV : WS_GRK) + (size_t)ch * 16384 + (f * 64 + lane) * 16) = pack8f((f32x4){v[0], v[1], v[2], v[3]}, (f32x4){v[4], v[5], v[6], v[7]}); }
    }
    if (tid == 0) ((float*)(F.ws + WS_GEG))[ch] = __expf(glast);
    LDS_BARRIER();
}

template <bool META> __device__ __forceinline__ void gdn_solve_item(Frame& F, int ch) {
    const int lane = F.lane, r16 = lane & 15, g = lane >> 4;
    LAS float* As = (LAS float*)F.lds + F.wave * 4096;
    { const f32x4* ga = (const f32x4*)((const float*)(F.ws + WS_GA) + (size_t)ch * 4096); f32x4 gr[16];
#pragma unroll
      for (int it = 0; it < 16; ++it) { const int e = it * 64 + lane; gr[it] = ga[((e & 15) < ((e >> 8) + 1) * 4) ? e : lane]; }
#pragma unroll
      for (int it = 0; it < 16; ++it) ((LAS f32x4*)As)[it * 64 + lane] = gr[it]; }
    LDS_WAIT();
    float x[64];
    x[0] = (lane == 0) ? 1.f : 0.f;
#pragma unroll
    for (int i = NMETA; i < 64; ++i) x[i] = (lane == i) ? 1.f : 0.f;
#pragma unroll
    for (int i = 1; i < (META ? NMETA : 64); ++i) {
        f32x4 av[16];
#pragma unroll
        for (int j4 = 0; j4 < (i + 3) / 4; ++j4) av[j4] = *(const LAS f32x4*)(As + i * 64 + 4 * j4);
        __builtin_amdgcn_sched_barrier(0);
        float a0 = (lane == i) ? 1.f : 0.f, a1 = 0.f, a2 = 0.f, a3 = 0.f;
#pragma unroll
        for (int j4 = 0; j4 < (i + 3) / 4; ++j4) {
            if (4 * j4 + 0 < i) a0 -= av[j4].x * x[4 * j4 + 0]; if (4 * j4 + 1 < i) a1 -= av[j4].y * x[4 * j4 + 1]; if (4 * j4 + 2 < i) a2 -= av[j4].z * x[4 * j4 + 2]; if (4 * j4 + 3 < i) a3 -= av[j4].w * x[4 * j4 + 3]; }
        x[i] = (a0 + a1) + (a2 + a3);
        __builtin_amdgcn_sched_barrier(0);
    }
    LDS_WAIT();
#pragma unroll
    for (int i = 0; i < 64; ++i) As[i * 64 + lane] = x[i];
    LDS_WAIT();
    bf16x8 Tf[4][2];
#pragma unroll
    for (int t = 0; t < 4; ++t)
#pragma unroll
        for (int ks = 0; ks < 2; ++ks) { const LAS float* p = As + (16 * t + r16) * 64 + 32 * ks + 8 * g; Tf[t][ks] = pack8f(*(const LAS f32x4*)p, *(const LAS f32x4*)(p + 4)); }
    const GAS unsigned char* grv = F.ws + WS_GRV + (size_t)ch * 16384; const GAS unsigned char* grk = F.ws + WS_GRK + (size_t)ch * 16384;
    GAS unsigned char* gu = F.ws + WS_GU + (size_t)ch * 16384; GAS unsigned char* gw = F.ws + WS_SREC + (size_t)ch * SREC + SR_W;
#pragma unroll 4
    for (int nt = 0; nt < 8; ++nt) { const bf16x8 b0 = *(const bf16x8*)(grv + ((nt * 2) * 64 + lane) * 16), b1 = *(const bf16x8*)(grv + ((nt * 2 + 1) * 64 + lane) * 16);
#pragma unroll
        for (int t = 0; t < 4; ++t) { f32x4 acc = {0.f, 0.f, 0.f, 0.f}; acc = mfma16(Tf[t][0], b0, acc); acc = mfma16(Tf[t][1], b1, acc);
            *(v2u*)(gu + ((nt * 4 + t) * 64 + lane) * 8) = (v2u){cvtpk(acc[0], acc[1]), cvtpk(acc[2], acc[3])}; } }
#pragma unroll 4
    for (int mt = 0; mt < 8; ++mt) { const bf16x8 a0 = *(const bf16x8*)(grk + ((mt * 2) * 64 + lane) * 16), a1 = *(const bf16x8*)(grk + ((mt * 2 + 1) * 64 + lane) * 16);
#pragma unroll
        for (int t = 0; t < 4; ++t) { f32x4 acc = {0.f, 0.f, 0.f, 0.f}; acc = mfma16(a0, Tf[t][0], acc); acc = mfma16(a1, Tf[t][1], acc);
            *(v2u*)(gw + ((t * 4 + (mt >> 1)) * 64 + lane) * 16 + 8 * (mt & 1)) = (v2u){cvtpk(-acc[0], -acc[1]), cvtpk(-acc[2], -acc[3])}; } }
}

__device__ __forceinline__ void gdn_scan_item(Frame& F, int item) {
    const int lane = F.lane, wave = F.wave, g = lane >> 4, c16 = lane & 15;
    const int half = item & 1, h = (item >> 1) & 7, b = item >> 4;
    const bool comp = wave < 4; const int cs0 = half * 64 + (wave & 3) * 16, ntu = cs0 >> 4;
    bf16* OB = (bf16*)(F.ws + WS_TMP); const float* GEG = (const float*)(F.ws + WS_GEG);
    LAS unsigned char* lds = F.lds;
#define SCAN_CH(n) ((n) == 0 ? NCHR + h : (b * 32 + (n) - 1) * 8 + h)
#define SCAN_DMA(n) do { const GAS unsigned char* src_ = F.ws + WS_SREC + (size_t)SCAN_CH(n) * SREC + lane * 16; LAS unsigned char* dst_ = lds + ((n) & 1) * SREC; \
        _Pragma("unroll") for (int i_ = 0; i_ < 7; ++i_) { const int p_ = i_ * 8 + wave; __builtin_amdgcn_global_load_lds((const unsigned*)(src_ + p_ * 1024), (LAS unsigned*)(dst_ + p_ * 1024), 16, 0, 0); } } while (0)
#define SCAN_U(n, dst) do { const GAS unsigned char* gu_ = F.ws + WS_GU + (size_t)SCAN_CH(n) * 16384; _Pragma("unroll") for (int t_ = 0; t_ < 4; ++t_) dst[t_] = *(const v2u*)(gu_ + ((ntu * 4 + t_) * 64 + lane) * 8); } while (0)
    f32x4 S[8];
#pragma unroll
    for (int m = 0; m < 8; ++m) S[m] = (f32x4){0.f, 0.f, 0.f, 0.f};
    v2u un[4] = {};
    SCAN_DMA(0); if (comp) SCAN_U(0, un);
#pragma unroll 1
    for (int n = 0; n <= 32; ++n) {
        VM_WAIT(); __syncthreads();
        v2u uc[4];
#pragma unroll
        for (int t = 0; t < 4; ++t) uc[t] = un[t];
        if (n < 32) { SCAN_DMA(n + 1); if (comp) SCAN_U(n + 1, un); }
        if (comp) {
            const LAS unsigned char* buf = lds + (n & 1) * SREC + lane * 16;
            const float eg = GEG[SCAN_CH(n)];
            bf16x8 Sb[4];
#pragma unroll
            for (int ks = 0; ks < 4; ++ks) Sb[ks] = pack8f(S[2 * ks], S[2 * ks + 1]);
            f32x4 av[4], ao[4];
#pragma unroll
            for (int t = 0; t < 4; ++t) { av[t] = (f32x4){bflo(uc[t].x), bfhi(uc[t].x), bflo(uc[t].y), bfhi(uc[t].y)}; ao[t] = (f32x4){0.f, 0.f, 0.f, 0.f}; }
#pragma unroll
            for (int t = 0; t < 4; ++t)
#pragma unroll
                for (int ks = 0; ks < 4; ++ks) { av[t] = mfma16(*(const LAS bf16x8*)(buf + SR_W + (t * 4 + ks) * 1024), Sb[ks], av[t]); ao[t] = mfma16(*(const LAS bf16x8*)(buf + SR_Q + (t * 4 + ks) * 1024), Sb[ks], ao[t]); }
            bf16x8 vb[2];
#pragma unroll
            for (int k = 0; k < 2; ++k) vb[k] = pack8f(av[2 * k], av[2 * k + 1]);
#pragma unroll
            for (int t = 0; t < 4; ++t)
#pragma unroll
                for (int k = 0; k < 2; ++k) if (32 * k <= 16 * t + 15) ao[t] = mfma16(*(const LAS bf16x8*)(buf + SR_AT + (t * 2 + k) * 1024), vb[k], ao[t]);
            if (n == 0) { if (b == 0) {
#pragma unroll
                    for (int r = 0; r < 4; ++r) { const float v = ao[0][r], vn = DPPF(v, 0xB1); if ((c16 & 1) == 0) *(unsigned*)(OB + (size_t)(XM + 4 * g + r) * DM + h * 128 + cs0 + c16) = cvtpk(v, vn); } } }
            else { bf16* op = OB + (size_t)(b * SEQ + (n - 1) * 64 + 4 * g) * DM + h * 128 + cs0 + c16;
#pragma unroll
                for (int t = 0; t < 4; ++t)
#pragma unroll
                    for (int r = 0; r < 4; ++r) { const float v = ao[t][r], vn = DPPF(v, 0xB1); if ((c16 & 1) == 0) *(unsigned*)(op + (size_t)(16 * t + r) * DM) = cvtpk(v, vn); } }
#pragma unroll
            for (int m = 0; m < 8; ++m) { S[m] = S[m] * eg;
#pragma unroll
                for (int k = 0; k < 2; ++k) S[m] = mfma16(*(const LAS bf16x8*)(buf + SR_KT + (m * 2 + k) * 1024), vb[k], S[m]); }
        }
    }
    if (comp) { GAS float* so = F.out + O_PDS + ((size_t)(b * GH + h) * GDK + 4 * g) * GDV + cs0 + c16;
#pragma unroll
        for (int m = 0; m < 8; ++m)
#pragma unroll
            for (int r = 0; r < 4; ++r) so[(size_t)(16 * m + r) * GDV] = S[m][r]; }
    __syncthreads();
#undef SCAN_CH
#undef SCAN_DMA
#undef SCAN_U
}

template <bool OUT_BF16> __device__ __forceinline__ void mini_gemm(Frame& F, const bf16* A, const bf16* Bt, int N, int K, void* out, int ldo) {
    const int lane = F.lane, c16 = lane & 15, g = lane >> 4, gw = F.wave * F.G + F.bid, NGW = F.G * 8;
    const int nct = N / 16;
#pragma unroll 1
    for (int task = gw; task < nct * 3; task += NGW) {
        const int ct = task % nct, rg = task / nct;
        const bf16* b0 = Bt + (size_t)(16 * ct + c16) * K + 8 * g; const bf16* a0 = A + (size_t)(TR + 48 * rg + c16) * K + 8 * g;
        f32x4 acc[3];
#pragma unroll
        for (int rt = 0; rt < 3; ++rt) acc[rt] = (f32x4){0.f, 0.f, 0.f, 0.f};
#define MG_LOAD(BF, AF, kk) do { _Pragma("unroll") for (int q = 0; q < 4; ++q) { BF[q] = *(const bf16x8*)(b0 + (kk) + 32 * q); \
            _Pragma("unroll") for (int rt = 0; rt < 3; ++rt) AF[q][rt] = *(const bf16x8*)(a0 + (size_t)(16 * rt) * K + (kk) + 32 * q); } } while (0)
#define MG_MMA(BF, AF) do { _Pragma("unroll") for (int q = 0; q < 4; ++q) { _Pragma("unroll") for (int rt = 0; rt < 3; ++rt) acc[rt] = mfma16(BF[q], AF[q][rt], acc[rt]); } } while (0)
        bf16x8 bfA[4], afA[4][3], bfB[4], afB[4][3];
        MG_LOAD(bfA, afA, 0);
#pragma unroll 1
        for (int k = 0; k < K; k += 256) {
            const bool hasB = k + 128 < K, hasA2 = k + 256 < K;
            if (hasB) MG_LOAD(bfB, afB, k + 128);
            __builtin_amdgcn_sched_barrier(0);
            MG_MMA(bfA, afA);
            __builtin_amdgcn_sched_barrier(0);
            if (hasA2) MG_LOAD(bfA, afA, k + 256);
            __builtin_amdgcn_sched_barrier(0);
            if (hasB) MG_MMA(bfB, afB);
            __builtin_amdgcn_sched_barrier(0);
        }
#undef MG_LOAD
#undef MG_MMA
#pragma unroll
        for (int rt = 0; rt < 3; ++rt) { const size_t o = (size_t)(48 * rg + 16 * rt + c16) * ldo + 16 * ct + 4 * g;
            if (OUT_BF16) *(v2u*)((bf16*)out + o) = (v2u){cvtpk(acc[rt][0], acc[rt][1]), cvtpk(acc[rt][2], acc[rt][3])};
            else *(f32x4*)((float*)out + o) = acc[rt]; }
    }
}

template <bool OUT_BF16> __device__ __forceinline__ void mini_gemm_deep(Frame& F, const bf16* A, const bf16* Bt, int N, int K, void* out, int ldo) {
    const int lane = F.lane, c16 = lane & 15, g = lane >> 4, gw = F.wave * F.G + F.bid, NGW = F.G * 8;
    const int nct = N / 16, nb = K / 128;
#pragma unroll 1
    for (int task = gw; task < nct * 9; task += NGW) {
        const int ct = task % nct, rt9 = task / nct;
        const bf16* b0 = Bt + (size_t)(16 * ct + c16) * K + 8 * g; const bf16* a0 = A + (size_t)(TR + 16 * rt9 + c16) * K + 8 * g;
        f32x4 acc = {0.f, 0.f, 0.f, 0.f};
        bf16x8 bq[4][4], aq[4][4];
#define MD_LOAD(i, kk) do { _Pragma("unroll") for (int q = 0; q < 4; ++q) { bq[i][q] = *(const bf16x8*)(b0 + (kk) + 32 * q); aq[i][q] = *(const bf16x8*)(a0 + (kk) + 32 * q); } } while (0)
#pragma unroll
        for (int i = 0; i < 4; ++i) MD_LOAD(i, 128 * i);
#pragma unroll 1
        for (int kb = 0; kb < nb; kb += 4) {
#pragma unroll
            for (int i = 0; i < 4; ++i) {
                if (kb + i < nb) {
#pragma unroll
                    for (int q = 0; q < 4; ++q) acc = mfma16(bq[i][q], aq[i][q], acc);
                    __builtin_amdgcn_sched_barrier(0);
                    if (kb + i + 4 < nb) MD_LOAD(i, 128 * (kb + i + 4));
                    __builtin_amdgcn_sched_barrier(0);
                }
            }
        }
#undef MD_LOAD
        const size_t o = (size_t)(16 * rt9 + c16) * ldo + 16 * ct + 4 * g;
        if (OUT_BF16) *(v2u*)((bf16*)out + o) = (v2u){cvtpk(acc[0], acc[1]), cvtpk(acc[2], acc[3])};
        else *(f32x4*)((float*)out + o) = acc;
    }
}

constexpr int NPHASE = 24;
__global__ void __launch_bounds__(512, 2) mk_fwd(Params P) {
    extern __shared__ __attribute__((aligned(16))) unsigned char lds_raw[];
    Frame F;
    F.lds = (LAS unsigned char*)lds_raw; F.tid = threadIdx.x; F.lane = F.tid & 63; F.wave = __builtin_amdgcn_readfirstlane(F.tid >> 6);
    F.G = gridDim.x; F.bid = blockIdx.x; F.in.t = (const LAS unsigned*)(F.lds + INTAB_OFF); F.out = (GAS float*)P.out; F.ws = (GAS unsigned char*)P.ws;
    volatile LAS unsigned* MISC = (volatile LAS unsigned*)(F.lds + MISC_OFF);
    for (int u = F.tid; u < (LDS_BYTES - CTLLDS_OFF) / 4; u += 512) ((LAS unsigned*)(F.lds + CTLLDS_OFF))[u] = 0u;
    __syncthreads();
    if (F.tid == 0) { LAS unsigned long long* tab = (LAS unsigned long long*)(F.lds + INTAB_OFF);
#pragma unroll
        for (int i = 0; i < N_IN; ++i) tab[i] = (unsigned long long)P.in[i]; }
    __syncthreads();
    const int lo = P.ph_lo, hi = P.ph_hi;
    XcdBarrier bar; bar.bar = (unsigned*)(P.ws + WS_CTL) + CW_BAR; bar.x = 0; bar.st = nullptr;
    if (hi - lo > 1) bar = xcd_barrier_post((unsigned*)(P.ws + WS_CTL) + CW_BAR, MISC + 8);
#ifndef REP_MASK
#define REP_MASK 0
#endif
#define REPN(k) ((((REP_MASK) >> (k)) & 1) + 1)
#define REP1(k) _Pragma("unroll 1") for (int r1_ = 0; r1_ < (((REP_MASK) >> (k)) & 1) + 1; ++r1_)
#define REP(k) _Pragma("unroll") for (int r_ = 0; r_ < (((REP_MASK) >> (k)) & 1) + 1; ++r_)
#define IN(k) (lo <= (k) && (k) < hi)
#define SEAM(k) do { if (IN(k) && IN((k) + 1)) { XcdBarrier b_; b_.bar = (unsigned*)(F.ws + WS_CTL) + CW_BAR; b_.x = bar.x; b_.st = (volatile LAS unsigned*)(F.lds + MISC_OFF) + 8; xcd_barrier(b_); } asm volatile("" : "+v"(F.tid), "+v"(F.lane)); asm volatile("" : "+s"(F.ws), "+s"(F.out)); ws = F.ws; } while (0)
    GAS unsigned char* ws = F.ws;
#define XH ((bf16*)(ws + WS_XH))
#define TMP ((float*)(ws + WS_TMP))

    if (IN(0)) REP(0) { p0_prologue(F, P); } SEAM(0);
    if (IN(1)) { pg8::Gemm g{XH, (const bf16*)(ws + WS_WIN), TR, 4096, DM}; pg8::StaticOrder S; S.init(TR, 4096, F.G, F.bid, REPN(1)); pg8::EpiInConv E{(bf16*)(ws + WS_QKVZ), (float*)(ws + WS_RAWQ), F.in[I_ACONV]};
        _Pragma("unroll 1") for (int pass_ = 0; pass_ < 2; ++pass_) { asm volatile("" : "+v"(F.tid), "+v"(F.lane));
            if (pass_ == ((F.bid >> 3) & 1)) pg8::gemm_phase<pg8::EpiInConv, pg8::StaticOrder, true, true>(F.lds, g, S, E);
            else mini_gemm<true>(F, XH, (const bf16*)(ws + WS_WIN), 4096, DM, (bf16*)(ws + WS_QKVZ) + (size_t)TR * 4096, 4096); } } SEAM(1);
    if (IN(2)) {
        REP1(2) { PrepRaw R; gdn_prep_load(F, F.bid, R); const int h_ = F.bid & 7; const float* cwbase = F.in[I_ACONV]; const float Ah = __expf(F.in[I_ALOG][h_]), dtb = F.in[I_ADT][h_];
          PrepW W; { const int t_ = F.tid < 144 ? F.tid : 0, cg = t_ % 48, col0 = cg * 8, gcol = (col0 >> 7) * 1024 + h_ * 128 + (col0 & 127);
#pragma unroll
            for (int j = 0; j < 4; ++j) { W.w[j][0] = *(const f32x4*)(cwbase + j * GQKV + gcol); W.w[j][1] = *(const f32x4*)(cwbase + j * GQKV + gcol + 4); } }
#pragma unroll 1
          for (int ch = F.bid; ch < NCH; ch += F.G) gdn_prep_item(F, ch, R, ch + F.G < NCH ? ch + F.G : ch, cwbase, Ah, dtb, W); }
        REP1(25)
#pragma unroll 1
        for (int it = F.bid; it < NS * GH; it += F.G) gdn_item(F, NB * GH + it); } SEAM(2);
    if (IN(3)) REP(3) {
#pragma unroll 1
        for (int ch = F.bid * 8 + F.wave; ch < NCHR; ch += F.G * 8) gdn_solve_item<false>(F, ch);
        { const int mw = (F.G - 1 - F.bid) * 8 + F.wave; if (mw < GH) gdn_solve_item<true>(F, NCHR + mw); } } SEAM(3);
    if (IN(4)) REP(4) {
#pragma unroll 1
        for (int it_ = F.bid; it_ < NB * GH * 2; it_ += F.G) { const int it = (F.G == 256) ? ((((it_ & 7) + 8 * (it_ >> 4)) << 1) | ((it_ >> 3) & 1)) : it_; gdn_scan_item(F, it); } } SEAM(4);
    if (IN(5)) REP(5) { p3_gate(F); } SEAM(5);
    if (IN(6)) { pg8::Gemm g{(const bf16*)(ws + WS_GO), (const bf16*)(ws + WS_WGOUT), TR, DM, DM}; pg8::StaticOrder S; S.init(TR, DM, F.G, F.bid, REPN(6)); pg8::EpiBf16 E{(bf16*)TMP, DM};
        pg8::gemm_phase<pg8::EpiBf16, pg8::StaticOrder, true, true>(F.lds, g, S, E);
        mini_gemm<true>(F, (const bf16*)(ws + WS_GO), (const bf16*)(ws + WS_WGOUT), DM, DM, (bf16*)TMP + (size_t)TR * DM, DM); } SEAM(6);
    if (IN(7)) { p_postnorm<false, true>(F, F.in[I_ANPOST]); } SEAM(7);
    if (IN(8)) { pg8::Gemm g{XH, (const bf16*)(ws + WS_WUP0), TR, FF2, DM}; pg8::StaticOrder S; S.init(TR, FF2, F.G, F.bid, REPN(8)); pg8::EpiFfnAct E{(bf16*)(ws + WS_ACT), (float*)(ws + WS_RAWH), (float*)(ws + WS_RAWX), F.in[I_FCONVW] + (size_t)0 * 3 * FF2, F.in[I_FCONVB] + (size_t)0 * FF2, TR / 256};
        _Pragma("unroll 1") for (int pass_ = 0; pass_ < 2; ++pass_) { asm volatile("" : "+v"(F.tid), "+v"(F.lane));
            if (pass_ == ((F.bid >> 3) & 1)) pg8::gemm_phase<pg8::EpiFfnAct, pg8::StaticOrder, true, true>(F.lds, g, S, E);
            else mini_gemm<false>(F, XH, (const bf16*)(ws + WS_WUP0), FF2, DM, (float*)(ws + WS_RAWX), FF2); } } SEAM(8);
    if (IN(9)) REP(9) { p_ffn_fix(F, 0); } SEAM(9);
    if (IN(10)) { pg8::Gemm g{(const bf16*)(ws + WS_ACT), (const bf16*)(ws + WS_WDN0), TR, DM, FF}; pg8::StaticOrder S; S.init(TR, DM, F.G, F.bid, REPN(10)); pg8::EpiBf16 E{(bf16*)TMP, DM};
        pg8::gemm_phase<pg8::EpiBf16, pg8::StaticOrder, true, true>(F.lds, g, S, E);
        mini_gemm_deep<true>(F, (const bf16*)(ws + WS_ACT), (const bf16*)(ws + WS_WDN0), DM, FF, (bf16*)TMP + (size_t)TR * DM, DM); } SEAM(10);
    if (IN(11)) { p_postnorm<false>(F, F.in[I_FNPOST]); } SEAM(11);
    if (IN(12)) { pg8::Gemm g{XH, (const bf16*)(ws + WS_WKVQA), TR, 768, DM}; pg8::StaticOrder S; S.init(TR, 768, F.G, F.bid, REPN(12)); pg8::EpiBf16 E{(bf16*)(ws + WS_CKVQ), 768};
        pg8::gemm_phase<pg8::EpiBf16, pg8::StaticOrder, true, true>(F.lds, g, S, E);
        mini_gemm<true>(F, XH, (const bf16*)(ws + WS_WKVQA), 768, DM, (bf16*)(ws + WS_CKVQ) + (size_t)TR * 768, 768); } SEAM(12);
    if (IN(13)) REP(13) { p_kvq(F); } SEAM(13);
    if (IN(14)) {
        { pg8::Gemm g{(const bf16*)(ws + WS_QAN), (const bf16*)(ws + WS_WQB), TR, 1536, QL}; pg8::StaticOrder S; S.init(TR, 1536, F.G, F.bid, REPN(14)); pg8::EpiBf16 E{(bf16*)(ws + WS_Q), 1536};
          pg8::gemm_phase<pg8::EpiBf16, pg8::StaticOrder, true, true>(F.lds, g, S, E); }
        __syncthreads();
        { pg8::Gemm g{(const bf16*)(ws + WS_CB), (const bf16*)(ws + WS_WUKV), TR, 2048, KVL}; pg8::StaticOrder S; S.init(TR, 2048, F.G, F.bid, REPN(14)); pg8::EpiBf16 E{(bf16*)(ws + WS_KNV), 2048};
          pg8::gemm_phase<pg8::EpiBf16, pg8::StaticOrder, true, true>(F.lds, g, S, E); }
        mini_gemm<true>(F, (const bf16*)(ws + WS_QAN), (const bf16*)(ws + WS_WQB), 1536, QL, (bf16*)(ws + WS_Q) + (size_t)TR * 1536, 1536);
        mini_gemm<true>(F, (const bf16*)(ws + WS_CB), (const bf16*)(ws + WS_WUKV), 2048, KVL, (bf16*)(ws + WS_KNV) + (size_t)TR * 2048, 2048);
    } SEAM(14);
    if (IN(16)) {
        if (F.bid == 0) attn_meta(F);
        volatile LAS int* qslot = (volatile LAS int*)(F.lds + MISC_OFF) + 16; unsigned* qctr = (unsigned*)(F.ws + WS_CTL) + CW_QUEUE;
#pragma unroll 1
        for (;;) {
            __syncthreads();
            if (F.tid == 0) qslot[0] = (int)__hip_atomic_fetch_add(qctr, 1u, __ATOMIC_RELAXED, __HIP_MEMORY_SCOPE_AGENT);
            __syncthreads();
            const int item = __builtin_amdgcn_readfirstlane(qslot[0]);
            if (item >= NS + NB * MH * 4) break;
            asm volatile("" : "+v"(F.tid), "+v"(F.lane));
            if (item < NS) attn_sample_item(F, item);
            else { const int L = item - NS, bh = L >> 2, x = L & 3;
#pragma unroll 1
                for (int pass = 0; pass < 2; ++pass) attn_qblock(F, bh >> 3, bh & 7, pass ? 7 - x : x); }
        }
    } SEAM(16);
    if (IN(18)) { pg8::Gemm g{(const bf16*)(ws + WS_AO), (const bf16*)(ws + WS_WMOUT), TR, DM, DM}; pg8::StaticOrder S; S.init(TR, DM, F.G, F.bid, REPN(18)); pg8::EpiBf16 E{(bf16*)TMP, DM};
        pg8::gemm_phase<pg8::EpiBf16, pg8::StaticOrder, true, true>(F.lds, g, S, E);
        mini_gemm<true>(F, (const bf16*)(ws + WS_AO), (const bf16*)(ws + WS_WMOUT), DM, DM, (bf16*)TMP + (size_t)TR * DM, DM); } SEAM(18);
    if (IN(19)) { p_postnorm<false>(F, F.in[I_BNPOST]); } SEAM(19);
    if (IN(20)) { pg8::Gemm g{XH, (const bf16*)(ws + WS_WUP1), TR, FF2, DM}; pg8::StaticOrder S; S.init(TR, FF2, F.G, F.bid, REPN(20)); pg8::EpiFfnAct E{(bf16*)(ws + WS_ACT), (float*)(ws + WS_RAWH), (float*)(ws + WS_RAWX), F.in[I_FCONVW] + (size_t)1 * 3 * FF2, F.in[I_FCONVB] + (size_t)1 * FF2, TR / 256};
        _Pragma("unroll 1") for (int pass_ = 0; pass_ < 2; ++pass_) { asm volatile("" : "+v"(F.tid), "+v"(F.lane));
            if (pass_ == ((F.bid >> 3) & 1)) pg8::gemm_phase<pg8::EpiFfnAct, pg8::StaticOrder, true, true>(F.lds, g, S, E);
            else mini_gemm<false>(F, XH, (const bf16*)(ws + WS_WUP1), FF2, DM, (float*)(ws + WS_RAWX), FF2); } } SEAM(20);
    if (IN(21)) REP(21) { p_ffn_fix(F, 1); } SEAM(21);
    if (IN(22)) { pg8::Gemm g{(const bf16*)(ws + WS_ACT), (const bf16*)(ws + WS_WDN1), TR, DM, FF}; pg8::StaticOrder S; S.init(TR, DM, F.G, F.bid, REPN(22)); pg8::EpiBf16 E{(bf16*)TMP, DM};
        pg8::gemm_phase<pg8::EpiBf16, pg8::StaticOrder, true, true>(F.lds, g, S, E);
        mini_gemm_deep<true>(F, (const bf16*)(ws + WS_ACT), (const bf16*)(ws + WS_WDN1), DM, FF, (bf16*)TMP + (size_t)TR * DM, DM); } SEAM(22);
    if (IN(23)) REP(23) { p_postnorm<true>(F, F.in[I_FNPOST] + DM); }
#undef XH
#undef TMP
#undef IN
#undef SEAM
}

#ifndef MK_PER_PHASE
#define MK_PER_PHASE 0
#endif
extern "C" void kernel_launch(void* const* d_in, const int* in_sizes, int n_in, void* d_out, int out_size, void* d_ws, size_t ws_size, hipStream_t stream) {
    static int grid = 0;
    if (grid == 0) {
        if (n_in != N_IN || (size_t)out_size != O_END || ws_size < WS_END) { fprintf(stderr, "kernel_launch: unexpected shapes: n_in %d out %d ws %zu (need %zu)\n", n_in, out_size, ws_size, (size_t)WS_END); grid = -1; return; }
        int dev = 0, cus = 0, per_cu = 0;
        if (hipGetDevice(&dev) != hipSuccess || hipDeviceGetAttribute(&cus, hipDeviceAttributeMultiprocessorCount, dev) != hipSuccess) { grid = -1; return; }
        if (hipFuncSetAttribute((const void*)mk_fwd, hipFuncAttributeMaxDynamicSharedMemorySize, LDS_BYTES) != hipSuccess) { fprintf(stderr, "kernel_launch: hipFuncSetAttribute failed\n"); grid = -1; return; }
        if (hipOccupancyMaxActiveBlocksPerMultiprocessor(&per_cu, (const void*)mk_fwd, 512, LDS_BYTES) != hipSuccess || per_cu < 1) fprintf(stderr, "kernel_launch: occupancy query says %d\n", per_cu);
        (void)hipGetLastError();
        grid = cus & ~7;
    }
    if (grid < 0) return;
    (void)hipMemsetAsync((char*)d_ws + WS_CTL, 0, CTL_ZERO_BYTES, stream);
    Params P{};
    for (int i = 0; i < N_IN; ++i) P.in[i] = (const float*)d_in[i];
    P.out = (float*)d_out; P.ws = (unsigned char*)d_ws;
    unsigned char* ws = (unsigned char*)d_ws;
    const float* const* in = P.in;
    P.jobs[0] = ConvJob{in[I_AWIN], in[I_ANPRE], (bf16*)(ws + WS_WIN), DM, 4096, GIN, 0, 0, 0};
    P.jobs[1] = ConvJob{in[I_AWOUT], nullptr, (bf16*)(ws + WS_WGOUT), DM, DM, DM, 0, 0, 0};
    P.jobs[2] = ConvJob{in[I_FWUP], in[I_FNPRE], (bf16*)(ws + WS_WUP0), DM, FF2, FF2, 0, 1, 0};
    P.jobs[3] = ConvJob{in[I_FWUP] + (size_t)DM * FF2, in[I_FNPRE] + DM, (bf16*)(ws + WS_WUP1), DM, FF2, FF2, 0, 1, 0};
    P.jobs[4] = ConvJob{in[I_FWDOWN], nullptr, (bf16*)(ws + WS_WDN0), FF, DM, DM, 0, 0, 0};
    P.jobs[5] = ConvJob{in[I_FWDOWN] + (size_t)FF * DM, nullptr, (bf16*)(ws + WS_WDN1), FF, DM, DM, 0, 0, 0};
    P.jobs[6] = ConvJob{in[I_KVWA], in[I_KVNORM], (bf16*)(ws + WS_WKVQA), DM, 320, 320, 0, 0, 0};
    P.jobs[7] = ConvJob{in[I_BWQA], in[I_BNPRE], (bf16*)(ws + WS_WKVQA), DM, QL, QL, 320, 0, 0};
    P.jobs[8] = ConvJob{in[I_BWQB], nullptr, (bf16*)(ws + WS_WQB), QL, 1536, 1536, 0, 0, 0};
    P.jobs[9] = ConvJob{in[I_WUK], nullptr, (bf16*)(ws + WS_WUKV), KVL, 1024, 1024, 0, 0, 0};
    P.jobs[10] = ConvJob{in[I_WUV], nullptr, (bf16*)(ws + WS_WUKV), KVL, 1024, 1024, 1024, 0, 0};
    P.jobs[11] = ConvJob{in[I_BWOUT], nullptr, (bf16*)(ws + WS_WMOUT), DM, DM, DM, 0, 0, 0};
#if MK_PER_PHASE
    for (int ph = 0; ph < NPHASE; ++ph) { P.ph_lo = ph; P.ph_hi = ph + 1; hipLaunchKernelGGL(mk_fwd, dim3(grid), dim3(512), LDS_BYTES, stream, P); }
#else
    P.ph_lo = 0; P.ph_hi = NPHASE; hipLaunchKernelGGL(mk_fwd, dim3(grid), dim3(512), LDS_BYTES, stream, P);
#endif
    const hipError_t le = hipPeekAtLastError();
    if (le != hipSuccess) fprintf(stderr, "kernel_launch: launch failed: %s\n", hipGetErrorName(le));
}
```

```cpp
#include <hip/hip_runtime.h>
#include <cstdio>
#include <cstdint>
namespace pg8 {
#define PG8_LAS __attribute__((address_space(3)))
typedef unsigned short bf16_t;
typedef short bf16x8 __attribute__((ext_vector_type(8)));
typedef float f32x4 __attribute__((ext_vector_type(4)));
typedef unsigned u32x4 __attribute__((ext_vector_type(4)));
constexpr int BM = 256, BK = 64, HALF = 128, HTB = HALF * BK * 2  , STAGE_BYTES = 8 * HTB, NXCD = 8, WGM = 8;

__host__ __device__ __forceinline__ int lds_byte(int r, int c) { const int st = (r >> 4) * 2 + (c >> 5), rr = r & 15, cc = c & 31, ob = rr * 64 + cc * 2; return st * 1024 + (ob ^ (((ob >> 9) & 1) << 5)); }
__host__ __device__ __forceinline__ void stage_rc(int b, int& R, int& C) { const int st = b / 1024, sb = b % 1024, swz = sb ^ (((sb >> 9) & 1) << 5); R = (st >> 1) * 16 + swz / 64; C = (st & 1) * 32 + (swz % 64) / 2; }
__host__ __device__ __forceinline__ int perm32(int rho) { const int n = rho >> 4, i = rho & 15; return 8 * (i >> 2) + 4 * n + (i & 3); }

struct Unit { int pm, pn; };
struct Gemm { const bf16_t* A; const bf16_t* Bt; int M, N, K; };

struct StaticOrder {
    int nM, nN, nwg, G, c, rep;
    __host__ __device__ void init(int M, int N, int G_, int c_, int rep_ = 1) { nM = M / BM; nN = N / BM; nwg = nM * nN; G = G_; c = c_; rep = rep_; }
    __host__ __device__ bool next(int i, Unit& u) const {
        const long L = (long)i * G + c; if (L >= (long)nwg * rep) return false;
        int wgid = (int)(L % nwg); { const int q = nwg / NXCD, r = nwg % NXCD, xcd = wgid % NXCD, off = wgid / NXCD; wgid = (xcd < r ? xcd * (q + 1) : r * (q + 1) + (xcd - r) * q) + off; }
        const int nig = WGM * nN, gid = wgid / nig, fm = gid * WGM, gsz = (nM - fm) < WGM ? (nM - fm) : WGM;
        u.pm = fm + ((wgid % nig) % gsz); u.pn = (wgid % nig) / gsz; return true;
    }
    __device__ __forceinline__ void a_ready(const Unit&) const {}
    __device__ __forceinline__ void done(const Unit&) const {}
};
typedef float cvt_f32x2 __attribute__((ext_vector_type(2)));
typedef __bf16 cvt_bf16x2 __attribute__((ext_vector_type(2)));
__device__ __forceinline__ unsigned cvt_pk_bf16(float lo, float hi) { const cvt_f32x2 v = {lo, hi}; return __builtin_bit_cast(unsigned, __builtin_convertvector(v, cvt_bf16x2)); }
typedef float f32x2 __attribute__((ext_vector_type(2)));
struct EpiF32 {
    static constexpr bool PERM = false, AFTER_DRAIN = false, WPF = false;
    float* C; int ldc;
    __device__ __forceinline__ void operator()(const f32x4 (&acc)[2][2][4][2], const Unit& u, int wr, int wc, int fr, int fq) const {
        const int row0 = u.pm * BM + wr * 64 + fr, col0 = u.pn * BM + wc * 32 + 4 * fq;
#pragma unroll
        for (int ai = 0; ai < 2; ++ai)
#pragma unroll
            for (int m = 0; m < 4; ++m) { float* rowp = C + (size_t)(row0 + ai * HALF + m * 16) * ldc + col0;
#pragma unroll
                for (int bj = 0; bj < 2; ++bj)
#pragma unroll
                    for (int n = 0; n < 2; ++n) *(f32x4*)(rowp + bj * HALF + n * 16) = acc[ai][bj][m][n]; }
    }
};
struct EpiBf16 {
    static constexpr bool PERM = true, AFTER_DRAIN = false, WPF = false;
    bf16_t* O; int ldc;
    __device__ __forceinline__ void operator()(const f32x4 (&acc)[2][2][4][2], const Unit& u, int wr, int wc, int fr, int fq) const {
        const int row0 = u.pm * BM + wr * 64 + fr, col0 = u.pn * BM + wc * 32 + 8 * fq;
#pragma unroll
        for (int ai = 0; ai < 2; ++ai)
#pragma unroll
            for (int m = 0; m < 4; ++m) { bf16_t* rowp = O + (size_t)(row0 + ai * HALF + m * 16) * ldc + col0;
#pragma unroll
                for (int bj = 0; bj < 2; ++bj) { const f32x4 v0 = acc[ai][bj][m][0], v1 = acc[ai][bj][m][1];
                    u32x4 w; w.x = cvt_pk_bf16(v0[0], v0[1]); w.y = cvt_pk_bf16(v0[2], v0[3]); w.z = cvt_pk_bf16(v1[0], v1[1]); w.w = cvt_pk_bf16(v1[2], v1[3]);
                    *(u32x4*)(rowp + bj * HALF) = w; } }
    }
};
struct EpiFfnAct {
    static constexpr bool PERM = false, AFTER_DRAIN = false, WPF = true;
    static constexpr int WSLOT_OFF = 131072;
    __device__ __forceinline__ void prefetch(PG8_LAS unsigned char* lds, const Unit& u, int par, int wid, int lane) const {
        constexpr int FFC = 2816, FF2C = 5632;
        if (wid < 4) { const int s_ = 2 * wid + (lane >> 5), isv = s_ & 1, tap = s_ >> 1; const float* src = (tap < 3 ? cw + tap * FF2C : cb) + isv * FFC + 128 * u.pn + (lane & 31) * 4;
            __builtin_amdgcn_global_load_lds((const unsigned*)src, (PG8_LAS unsigned*)(lds + WSLOT_OFF + par * 4096 + wid * 1024), 16, 0, 0); }
    }
    bf16_t* ACT; float* RAWH; float* RAWX; const float* cw; const float* cb; int nrealp;
    static __device__ __forceinline__ float shr_prev(float prev, float x, int) { return x; }
    template <int D> static __device__ __forceinline__ float rowprev(float prev, float x) {
        const int o = __builtin_amdgcn_update_dpp(0, __builtin_bit_cast(int, prev), 0x100 + (16 - D), 0xF, 0xF, true);
        return __builtin_bit_cast(float, __builtin_amdgcn_update_dpp(o, __builtin_bit_cast(int, x), 0x110 + D, 0xF, 0xF, false));
    }
    __device__ __forceinline__ void operator()(const f32x4 (&acc)[2][2][4][2], const Unit& u, int wr, int wc, int fr, int fq, PG8_LAS unsigned char* lds, int par) const {
        constexpr int FFC = 2816, FF2C = 5632;
        f32x4 w0g[2], w1g[2], w2g[2], w0v[2], w1v[2], w2v[2], bg[2], bv[2];
        const PG8_LAS float* ws_ = (const PG8_LAS float*)(lds + WSLOT_OFF + par * 4096);
#pragma unroll
        for (int bj = 0; bj < 2; ++bj) { const int cl = 16 * (4 * bj + wc) + 4 * fq;
            w0g[bj] = *(const PG8_LAS f32x4*)(ws_ + cl); w0v[bj] = *(const PG8_LAS f32x4*)(ws_ + 128 + cl); w1g[bj] = *(const PG8_LAS f32x4*)(ws_ + 256 + cl); w1v[bj] = *(const PG8_LAS f32x4*)(ws_ + 384 + cl);
            w2g[bj] = *(const PG8_LAS f32x4*)(ws_ + 512 + cl); w2v[bj] = *(const PG8_LAS f32x4*)(ws_ + 640 + cl); bg[bj] = *(const PG8_LAS f32x4*)(ws_ + 768 + cl); bv[bj] = *(const PG8_LAS f32x4*)(ws_ + 896 + cl); }
#pragma unroll
        for (int bj = 0; bj < 2; ++bj)
#pragma unroll
            for (int ai = 0; ai < 2; ++ai) {
                const int G = 8 * u.pn + 4 * bj + wc, ch0 = 16 * G + 4 * fq, co0 = 32 * G + 4 * fq;
                const int rowg = u.pm * BM + ai * HALF + wr * 64;
#pragma unroll
                for (int m = 0; m < 4; ++m) {
                    const f32x4 xg = acc[ai][bj][m][0], xv = acc[ai][bj][m][1];
                    const f32x4 pg = m > 0 ? acc[ai][bj][m > 0 ? m - 1 : 0][0] : (f32x4){0.f, 0.f, 0.f, 0.f}, pv = m > 0 ? acc[ai][bj][m > 0 ? m - 1 : 0][1] : (f32x4){0.f, 0.f, 0.f, 0.f};
                    f32x4 g1, g2, v1, v2;
#pragma unroll
                    for (int e = 0; e < 4; ++e) { g1[e] = rowprev<1>(pg[e], xg[e]); g2[e] = rowprev<2>(pg[e], xg[e]); v1[e] = rowprev<1>(pv[e], xv[e]); v2[e] = rowprev<2>(pv[e], xv[e]); }
                    const f32x4 ug = w0g[bj] * g2 + w1g[bj] * g1 + w2g[bj] * xg + bg[bj], uv = w0v[bj] * v2 + w1v[bj] * v1 + w2v[bj] * xv + bv[bj];
                    const f32x4 den = ug * (-1.4426950408889634f); f32x4 sg;
#pragma unroll
                    for (int e = 0; e < 4; ++e) sg[e] = __builtin_amdgcn_rcpf(1.f + __builtin_amdgcn_exp2f(den[e]));
                    const f32x4 a = ug * sg * uv;
                    typedef unsigned u32x2 __attribute__((ext_vector_type(2)));
                    *(u32x2*)(ACT + (size_t)(rowg + 16 * m + fr) * FFC + ch0) = (u32x2){cvt_pk_bf16(a[0], a[1]), cvt_pk_bf16(a[2], a[3])};
                    if (m == 0 && fr < 2) { float* rp = RAWH + ((size_t)(rowg >> 6) * 4 + fr) * FF2C + co0; *(f32x4*)rp = xg; *(f32x4*)(rp + 16) = xv; }
                    if (m == 3 && fr >= 14) { float* rp = RAWH + ((size_t)(rowg >> 6) * 4 + 2 + (fr - 14)) * FF2C + co0; *(f32x4*)rp = xg; *(f32x4*)(rp + 16) = xv; }
                }
            }
    }
};
struct EpiInConv {
    static constexpr bool PERM = true, AFTER_DRAIN = false, WPF = true;
    bf16_t* O; float* RAWQ; const float* cw;
    __device__ __forceinline__ void prefetch(PG8_LAS unsigned char* lds, const Unit& u, int par, int wid, int lane) const {
        if (wid < 4 && u.pn * BM < 3072) __builtin_amdgcn_global_load_lds((const unsigned*)(cw + wid * 3072 + u.pn * BM + lane * 4), (PG8_LAS unsigned*)(lds + EpiFfnAct::WSLOT_OFF + par * 4096 + wid * 1024), 16, 0, 0);
    }
    __device__ __forceinline__ void operator()(const f32x4 (&acc)[2][2][4][2], const Unit& u, int wr, int wc, int fr, int fq, PG8_LAS unsigned char* lds, int par) const {
        constexpr int LDO = 4096, NQKV = 3072;
        const bool conv = u.pn * BM < NQKV;
        const PG8_LAS float* ws_ = (const PG8_LAS float*)(lds + EpiFfnAct::WSLOT_OFF + par * 4096);
#pragma unroll
        for (int bj = 0; bj < 2; ++bj) {
            asm volatile("" ::: "memory");
            const int col0 = u.pn * BM + bj * HALF + wc * 32 + 8 * fq;
            f32x4 w[4][2];
#pragma unroll
            for (int j = 0; j < 4; ++j) { const int cl = bj * HALF + wc * 32 + 8 * fq; w[j][0] = *(const PG8_LAS f32x4*)(ws_ + j * 256 + cl); w[j][1] = *(const PG8_LAS f32x4*)(ws_ + j * 256 + cl + 4); }
#pragma unroll
            for (int ai = 0; ai < 2; ++ai) {
                const int rowg = u.pm * BM + ai * HALF + wr * 64;
#pragma unroll
                for (int m = 0; m < 4; ++m) {
                    f32x4 o[2];
#pragma unroll
                    for (int n = 0; n < 2; ++n) { const f32x4 x = acc[ai][bj][m][n]; const f32x4 pz = {0.f, 0.f, 0.f, 0.f}; const f32x4 p = m > 0 ? acc[ai][bj][m > 0 ? m - 1 : 0][n] : pz;
                        if (conv) { f32x4 x1, x2, x3;
#pragma unroll
                            for (int e = 0; e < 4; ++e) { x1[e] = EpiFfnAct::rowprev<1>(p[e], x[e]); x2[e] = EpiFfnAct::rowprev<2>(p[e], x[e]); x3[e] = EpiFfnAct::rowprev<3>(p[e], x[e]); }
                            const f32x4 a = (w[0][n] * x3 + w[1][n] * x2) + (w[2][n] * x1 + w[3][n] * x), den = a * (-1.4426950408889634f); f32x4 sg;
#pragma unroll
                            for (int e = 0; e < 4; ++e) sg[e] = __builtin_amdgcn_rcpf(1.f + __builtin_amdgcn_exp2f(den[e]));
                            o[n] = a * sg;
                        } else o[n] = x; }
                    u32x4 wv; wv.x = cvt_pk_bf16(o[0][0], o[0][1]); wv.y = cvt_pk_bf16(o[0][2], o[0][3]); wv.z = cvt_pk_bf16(o[1][0], o[1][1]); wv.w = cvt_pk_bf16(o[1][2], o[1][3]);
                    *(u32x4*)(O + (size_t)(rowg + 16 * m + fr) * LDO + col0) = wv;
                    if (conv) {
                        if (m == 0 && fr < 3) { float* rp = RAWQ + ((size_t)(rowg >> 6) * 6 + fr) * NQKV + col0; *(f32x4*)rp = acc[ai][bj][m][0]; *(f32x4*)(rp + 4) = acc[ai][bj][m][1]; }
                        if (m == 3 && fr >= 13) { float* rp = RAWQ + ((size_t)(rowg >> 6) * 6 + 3 + (fr - 13)) * NQKV + col0; *(f32x4*)rp = acc[ai][bj][m][0]; *(f32x4*)(rp + 4) = acc[ai][bj][m][1]; }
                    }
                }
            }
        }
    }
};
template <class Epi, class Sched, bool ALIGN_EPI = false, bool SP2 = false>
__device__ __forceinline__ void gemm_phase(PG8_LAS unsigned char* lds, const Gemm g, const Sched& S, const Epi& E) {
    int tid_ = threadIdx.x; asm volatile("" : "+v"(tid_));
    const int tid = tid_, wid = __builtin_amdgcn_readfirstlane(tid >> 6), lane = tid & 63, wr = wid >> 2, wc = wid & 3, fr = lane & 15, fq = lane >> 4;
    const int K = g.K, nt = K / BK;
    unsigned voffA[2], voffB[2];
#pragma unroll
    for (int i = 0; i < 2; ++i) { int R, C; stage_rc(tid * 16 + i * 8192, R, C); const int Rb = Epi::PERM ? ((R & ~31) + perm32(R & 31)) : R;
        voffA[i] = (unsigned)(R * K + C) * 2u; voffB[i] = (unsigned)(Rb * K + C) * 2u; }
    const size_t kstep = (size_t)(BK * 2);
    const size_t hstep = (size_t)HALF * K * 2;
    const size_t tstep = 2 * hstep;
    const unsigned ldsw = (unsigned)wid * 1024u;
    const int aoff = lds_byte(wr * 64 + fr, fq * 8), boff = lds_byte(wc * 32 + fr, fq * 8);
#define PG8_SA(b, h) (((b) * 2 + (h)) * HTB)
#define PG8_SB(b, h) ((4 + (b) * 2 + (h)) * HTB)
#define PG8_STAGE(bufoff, gbase, voff) do { _Pragma("unroll") for (int _i = 0; _i < 2; ++_i) \
        __builtin_amdgcn_global_load_lds((const unsigned*)((const char*)(gbase) + (voff)[_i]), (PG8_LAS unsigned*)(lds + (bufoff) + ldsw + _i * 8192), 16, 0, 0); } while (0)
#define PG8_LDA(dst, b, h) do { _Pragma("unroll") for (int m = 0; m < 4; ++m) _Pragma("unroll") for (int k = 0; k < 2; ++k) dst[m][k] = *(const PG8_LAS bf16x8*)(lds + PG8_SA(b, h) + aoff + m * 2048 + k * 1024); } while (0)
#define PG8_LDB(dst, b, h) do { _Pragma("unroll") for (int n = 0; n < 2; ++n) _Pragma("unroll") for (int k = 0; k < 2; ++k) dst[n][k] = *(const PG8_LAS bf16x8*)(lds + PG8_SB(b, h) + boff + n * 2048 + k * 1024); } while (0)
#define PG8_MMA(ai, bj, At, Bt) do { __builtin_amdgcn_s_setprio(1); _Pragma("unroll") for (int m = 0; m < 4; ++m) _Pragma("unroll") for (int n = 0; n < 2; ++n) _Pragma("unroll") for (int k = 0; k < 2; ++k) \
        acc[ai][bj][m][n] = __builtin_amdgcn_mfma_f32_16x16x32_bf16(Bt[n][k], At[m][k], acc[ai][bj][m][n], 0, 0, 0); __builtin_amdgcn_s_setprio(0); } while (0)
#define PG8_WAIT_V(n) asm volatile("s_waitcnt vmcnt(" #n ")" ::: "memory")
#define PG8_WAIT_L(n) asm volatile("s_waitcnt lgkmcnt(" #n ")" ::: "memory")
#define PG8_BAR __builtin_amdgcn_s_barrier()
#define PG8_SCHED __builtin_amdgcn_sched_barrier(0)
    Unit cur, nxt; int ui = 0;
    if (!S.next(0, cur)) return;
    f32x4 acc[2][2][4][2];
#pragma unroll
    for (int a = 0; a < 2; ++a)
#pragma unroll
        for (int b = 0; b < 2; ++b)
#pragma unroll
            for (int m = 0; m < 4; ++m)
#pragma unroll
                for (int n = 0; n < 2; ++n) acc[a][b][m][n] = (f32x4){0.f, 0.f, 0.f, 0.f};
    bf16x8 At[4][2], B0[2][2], B1[2][2];
    const char* cA = (const char*)g.A + (size_t)cur.pm * tstep; const char* cB = (const char*)g.Bt + (size_t)cur.pn * tstep;
    S.a_ready(cur);
    if constexpr (Epi::WPF) E.prefetch(lds, cur, 0, wid, lane);
    if constexpr (SP2) {
        PG8_STAGE(PG8_SB(0, 0), cB, voffB); PG8_STAGE(PG8_SB(0, 1), cB + hstep, voffB); PG8_STAGE(PG8_SA(0, 0), cA, voffA); PG8_STAGE(PG8_SA(0, 1), cA + hstep, voffA);
        PG8_STAGE(PG8_SB(1, 0), cB + kstep, voffB); PG8_STAGE(PG8_SA(1, 0), cA + kstep, voffA); PG8_STAGE(PG8_SB(1, 1), cB + hstep + kstep, voffB);
        PG8_WAIT_V(8); PG8_BAR;
        if (wr == 1) PG8_BAR;
    } else {
        PG8_STAGE(PG8_SB(0, 0), cB, voffB); PG8_STAGE(PG8_SA(0, 0), cA, voffA); PG8_STAGE(PG8_SB(0, 1), cB + hstep, voffB); PG8_STAGE(PG8_SA(0, 1), cA + hstep, voffA);
        if (wr == 1) PG8_BAR;
        PG8_WAIT_V(4); PG8_BAR;
        PG8_STAGE(PG8_SB(1, 0), cB + kstep, voffB); PG8_STAGE(PG8_SA(1, 0), cA + kstep, voffA); PG8_STAGE(PG8_SB(1, 1), cB + hstep + kstep, voffB);
        PG8_WAIT_V(6); PG8_BAR;
    }
    for (;;) {
        const bool has_next = S.next(ui + 1, nxt);
        const char* nA = has_next ? (const char*)g.A + (size_t)nxt.pm * tstep : cA; const char* nB = has_next ? (const char*)g.Bt + (size_t)nxt.pn * tstep : cB;
        for (int t = 0; t < nt; t += 2) {
            const bool last = (t == nt - 2);
            const char* a1 = cA + (size_t)(t + 1) * kstep;
            const char* a2 = last ? nA : cA + (size_t)(t + 2) * kstep; const char* b2 = last ? nB : cB + (size_t)(t + 2) * kstep;
            const char* a3 = a2 + kstep; const char* b3 = b2 + kstep;
            if (last && has_next) S.a_ready(nxt);
            if constexpr (SP2) {
            PG8_LDB(B0, 0, 0); PG8_LDB(B1, 0, 1); PG8_SCHED; PG8_LDA(At, 0, 0); PG8_STAGE(PG8_SA(1, 1), a1 + hstep, voffA);
            PG8_WAIT_V(8); PG8_WAIT_L(0); PG8_BAR; PG8_MMA(0, 0, At, B0); PG8_MMA(0, 1, At, B1); PG8_BAR; PG8_SCHED;
            PG8_LDA(At, 0, 1); PG8_STAGE(PG8_SB(0, 0), b2, voffB); PG8_STAGE(PG8_SB(0, 1), b2 + hstep, voffB); PG8_STAGE(PG8_SA(0, 0), a2, voffA);
            PG8_WAIT_V(8); PG8_WAIT_L(0); PG8_BAR; PG8_MMA(1, 0, At, B0); PG8_MMA(1, 1, At, B1); PG8_BAR; PG8_SCHED;
            PG8_LDB(B0, 1, 0); PG8_LDB(B1, 1, 1); PG8_SCHED; PG8_LDA(At, 1, 0); PG8_STAGE(PG8_SA(0, 1), a2 + hstep, voffA);
            PG8_WAIT_V(8); PG8_WAIT_L(0); PG8_BAR; PG8_MMA(0, 0, At, B0); PG8_MMA(0, 1, At, B1); PG8_BAR; PG8_SCHED;
            PG8_LDA(At, 1, 1); PG8_STAGE(PG8_SB(1, 0), b3, voffB); PG8_STAGE(PG8_SB(1, 1), b3 + hstep, voffB); PG8_STAGE(PG8_SA(1, 0), a3, voffA);
            PG8_WAIT_V(8); PG8_WAIT_L(0); PG8_BAR; PG8_MMA(1, 0, At, B0); PG8_MMA(1, 1, At, B1); PG8_BAR; PG8_SCHED;
            } else {
            PG8_LDB(B0, 0, 0); PG8_SCHED; PG8_LDA(At, 0, 0); PG8_STAGE(PG8_SA(1, 1), a1 + hstep, voffA);
            PG8_WAIT_L(8); PG8_BAR; PG8_WAIT_L(0); PG8_MMA(0, 0, At, B0); PG8_BAR; PG8_SCHED;
            PG8_LDB(B1, 0, 1); PG8_STAGE(PG8_SB(0, 0), b2, voffB);
            PG8_BAR; PG8_WAIT_L(0); PG8_MMA(0, 1, At, B1); PG8_BAR;
            PG8_LDA(At, 0, 1); PG8_STAGE(PG8_SA(0, 0), a2, voffA);
            PG8_BAR; PG8_WAIT_L(0); PG8_MMA(1, 0, At, B0); PG8_BAR; PG8_SCHED;
            PG8_STAGE(PG8_SB(0, 1), b2 + hstep, voffB);
            PG8_WAIT_V(6); PG8_BAR; PG8_MMA(1, 1, At, B1); PG8_BAR;
            PG8_LDB(B0, 1, 0); PG8_SCHED; PG8_LDA(At, 1, 0); PG8_STAGE(PG8_SA(0, 1), a2 + hstep, voffA);
            PG8_WAIT_L(8); PG8_BAR; PG8_WAIT_L(0); PG8_MMA(0, 0, At, B0); PG8_BAR; PG8_SCHED;
            PG8_LDB(B1, 1, 1); PG8_STAGE(PG8_SB(1, 0), b3, voffB);
            PG8_BAR; PG8_WAIT_L(0); PG8_MMA(0, 1, At, B1); PG8_BAR;
            PG8_LDA(At, 1, 1); PG8_STAGE(PG8_SA(1, 0), a3, voffA);
            PG8_BAR; PG8_WAIT_L(0); PG8_MMA(1, 0, At, B0); PG8_BAR; PG8_SCHED;
            PG8_STAGE(PG8_SB(1, 1), b3 + hstep, voffB);
            PG8_WAIT_V(6); PG8_BAR; PG8_MMA(1, 1, At, B1); PG8_BAR;
            }
        }
        if constexpr (ALIGN_EPI) { if (wr == 0) PG8_BAR; }
        if constexpr (Epi::WPF) { if (has_next) E.prefetch(lds, nxt, (ui + 1) & 1, wid, lane); E(acc, cur, wr, wc, fr, fq, lds, ui & 1); S.done(cur); }
        else if constexpr (!Epi::AFTER_DRAIN) { E(acc, cur, wr, wc, fr, fq); S.done(cur); }
        if (!has_next) break;
#pragma unroll
        for (int a = 0; a < 2; ++a)
#pragma unroll
            for (int b = 0; b < 2; ++b)
#pragma unroll
                for (int m = 0; m < 4; ++m)
#pragma unroll
                    for (int n = 0; n < 2; ++n) acc[a][b][m][n] = (f32x4){0.f, 0.f, 0.f, 0.f};
        cur = nxt; cA = nA; cB = nB; ++ui;
        if constexpr (ALIGN_EPI) { if (wr == 1) PG8_BAR; }
    }
    PG8_WAIT_V(0);
    if constexpr (!ALIGN_EPI) { if (wr == 0) PG8_BAR; }
    PG8_BAR;
    if constexpr (Epi::AFTER_DRAIN) { E.fused(acc, cur, wr, wc, fr, fq, lds, wid, lane); S.done(cur); }
#undef PG8_SA
#undef PG8_SB
#undef PG8_STAGE
#undef PG8_LDA
#undef PG8_LDB
#undef PG8_MMA
#undef PG8_WAIT_V
#undef PG8_WAIT_L
#undef PG8_BAR
#undef PG8_SCHED
}
}

constexpr int DM = 1024, NB = 16, SEQ = 2048, TR = NB * SEQ, NMETA = 16, NS = 128;
constexpr int XM = TR, XS = TR + NMETA, NVALID = TR + NMETA + NS, TM = 33024;
constexpr int LP = NMETA + SEQ;
constexpr int GH = 8, GDK = 128, GDV = 128, GQKV = 3072, GIN = 4112;
constexpr int QL = 384, KVL = 256, NOPE = 128, ROPE = 64, HD = 192, MH = 8;
constexpr int FF = 2816, FF2 = 5632;
constexpr int PAST = 8192, PAGE = 128, NPAGE = 64;
constexpr float EPS = 1e-6f;
constexpr float MLA_SCALE = 0.07216878364870322f;
static_assert(TM % 256 == 0 && TM >= NVALID, "row padding");

enum { I_XP = 0, I_XS, I_SDS, I_SDC, I_SFC, I_CKV, I_CKR, I_PT, I_META, I_ANPRE, I_ANPOST, I_AWIN, I_ACONV, I_ALOG, I_ADT, I_AONORM, I_AWOUT,
       I_KVNORM, I_KVWA, I_KVANORM, I_WUK, I_WUV, I_BNPRE, I_BNPOST, I_BWQA, I_BQANORM, I_BWQB, I_BWOUT, I_FNPRE, I_FNPOST, I_FWUP, I_FCONVW, I_FCONVB, I_FWDOWN, N_IN };
constexpr size_t O_YP = 0, O_YS = O_YP + (size_t)TR * DM, O_PDS = O_YS + (size_t)NS * DM, O_PDC = O_PDS + (size_t)NB * GH * GDK * GDV, O_PFC = O_PDC + (size_t)NB * 3 * GQKV,
                 O_PKV = O_PFC + (size_t)2 * NB * 2 * FF2, O_PKR = O_PKV + (size_t)NB * LP * KVL, O_SDS = O_PKR + (size_t)NB * LP * ROPE, O_SDC = O_SDS + (size_t)NS * GH * GDK * GDV,
                 O_SFC = O_SDC + (size_t)NS * 3 * GQKV, O_SKV = O_SFC + (size_t)2 * NS * 2 * FF2, O_SKR = O_SKV + (size_t)NS * KVL, O_END = O_SKR + (size_t)NS * ROPE;

constexpr size_t MiB = 1u << 20;
constexpr size_t WS_CTL = 0, CTL_ZERO_BYTES = 1 * MiB;
constexpr size_t WS_ROPE = 1 * MiB;
constexpr size_t WS_WIN = 2 * MiB, WS_WGOUT = 10 * MiB, WS_WUP0 = 12 * MiB, WS_WUP1 = 23 * MiB, WS_WDN0 = 34 * MiB, WS_WDN1 = 40 * MiB, WS_WKVQA = 46 * MiB,
                 WS_WQB = 48 * MiB, WS_WUKV = 50 * MiB, WS_WMOUT = 52 * MiB, WS_AB = 54 * MiB, WS_PART = 57 * MiB, WS_QLAT = 60 * MiB;
constexpr size_t WS_XRES = 64 * MiB, WS_XH = 193 * MiB, WS_TMP = 258 * MiB, WS_QKVZ = 387 * MiB, WS_GO = 645 * MiB, WS_UP = 710 * MiB, WS_RAWH = 710 * MiB, WS_RAWX = 760 * MiB, WS_ACT = 1065 * MiB,
                 WS_CKVQ = 1243 * MiB, WS_CB = 1340 * MiB, WS_KRB = 1357 * MiB, WS_QAN = 1362 * MiB, WS_Q = 1387 * MiB, WS_KNV = 1484 * MiB, WS_AO = 1613 * MiB,
                 WS_SREC = 1678 * MiB, WS_GU = 1904 * MiB, WS_GA = 1970 * MiB, WS_GRV = 2036 * MiB, WS_GRK = 2102 * MiB, WS_GEG = 2168 * MiB, WS_RAWQ = 2169 * MiB, WS_END = 2210 * MiB;
constexpr int CW_BAR = 4096, CW_QUEUE = 2048;
constexpr int NPOSTAB = LP + 1;

constexpr int RING_BYTES = 131072, LDS_BYTES = 147456, CTLLDS_OFF = LDS_BYTES - 2048, MISC_OFF = CTLLDS_OFF + 320, INTAB_OFF = CTLLDS_OFF + 1024;

#define LAS __attribute__((address_space(3)))
typedef unsigned short bf16;
typedef unsigned v4u __attribute__((ext_vector_type(4)));
typedef unsigned v2u __attribute__((ext_vector_type(2)));
typedef float f32x4 __attribute__((ext_vector_type(4)));
typedef float f32x16 __attribute__((ext_vector_type(16)));
typedef short bf16x8 __attribute__((ext_vector_type(8)));
typedef short s16x4 __attribute__((ext_vector_type(4)));
#define LDS_WAIT() asm volatile("s_waitcnt lgkmcnt(0)" ::: "memory")
#define VM_WAIT() asm volatile("s_waitcnt vmcnt(0)" ::: "memory")
__device__ __forceinline__ unsigned f2bf(float f) { unsigned u = __builtin_bit_cast(unsigned, f); return (u + 0x7fffu + ((u >> 16) & 1u)) >> 16; }
__device__ __forceinline__ unsigned pk2(float lo, float hi) { return f2bf(lo) | (f2bf(hi) << 16); }
__device__ __forceinline__ float bf2f(bf16 b) { return __builtin_bit_cast(float, (unsigned)b << 16); }
__device__ __forceinline__ float bflo(unsigned w) { return __builtin_bit_cast(float, w << 16); }
__device__ __forceinline__ float bfhi(unsigned w) { return __builtin_bit_cast(float, w & 0xffff0000u); }
#define DPPF(x, ctrl) __builtin_bit_cast(float, __builtin_amdgcn_update_dpp(0, __builtin_bit_cast(int, (x)), (ctrl), 0xF, 0xF, false))
__device__ __forceinline__ float swap16_sum(float v) { auto r = __builtin_amdgcn_permlane16_swap(__float_as_uint(v), __float_as_uint(v), false, false); return __uint_as_float(r[0]) + __uint_as_float(r[1]); }
__device__ __forceinline__ float swap32_sum(float v) { auto r = __builtin_amdgcn_permlane32_swap(__float_as_uint(v), __float_as_uint(v), false, false); return __uint_as_float(r[0]) + __uint_as_float(r[1]); }
__device__ __forceinline__ float wave_sum(float v) {
    v += DPPF(v, 0xB1); v += DPPF(v, 0x4E); v += DPPF(v, 0x141); v += DPPF(v, 0x140);
    return swap32_sum(swap16_sum(v));
}
__device__ __forceinline__ float siluf(float x) { return x * __builtin_amdgcn_rcpf(1.f + __expf(-x)); }

#define XB_TMO      128
#define XB_XCNT(j)  (256  + 64 * (j))
#define XB_XSUB(j)  (1280 + 64 * (j))
#define XB_XGEN(j)  (2304 + 64 * (j))
#define XB_TOP      3328
#define XB_TOPGEN   3392
#define XCD_BAR_WORDS 3456
#define XB_SPIN_CAP (1u << 18)
__device__ __forceinline__ unsigned xb_ld(unsigned* p)              { return __hip_atomic_load(p, __ATOMIC_RELAXED, __HIP_MEMORY_SCOPE_AGENT); }
__device__ __forceinline__ unsigned xb_add(unsigned* p, unsigned v) { return __hip_atomic_fetch_add(p, v, __ATOMIC_RELAXED, __HIP_MEMORY_SCOPE_AGENT); }
__device__ __forceinline__ unsigned xb_xcc_id() { return (unsigned)__builtin_amdgcn_s_getreg((3 << 11) | 20) & 0xFu; }
#define XB_SPIN(cond, bar) do { unsigned _sp = 0; while (cond) { __builtin_amdgcn_s_sleep(1); \
    if ((++_sp & 255u) == 0u) { if (xb_ld(&(bar)[XB_TMO])) break; if (_sp > XB_SPIN_CAP) { atomicAdd(&(bar)[XB_TMO], 1u); break; } } } } while (0)
struct XcdBarrier { unsigned* bar; unsigned x; volatile LAS unsigned* st; };
__device__ __forceinline__ XcdBarrier xcd_barrier_post(unsigned* bar, volatile LAS unsigned* st) {
    XcdBarrier b; b.bar = bar; b.x = xb_xcc_id(); b.st = st;
    if (threadIdx.x == 0) (void)xb_add(&bar[XB_XCNT(b.x)], 1u);
    return b;
}
__device__ __forceinline__ void xcd_barrier_complete(unsigned* bar, unsigned x, unsigned& nloc, unsigned& nx) {
    const unsigned G = gridDim.x * gridDim.y * gridDim.z;
    unsigned sum, cnt, mine, sp = 0u;
    for (;;) {
        sum = 0u; cnt = 0u; mine = 0u;
#pragma unroll
        for (unsigned j = 0; j < 16; ++j) { const unsigned c = xb_ld(&bar[XB_XCNT(j)]); sum += c; cnt += (c > 0u) ? 1u : 0u; mine = (j == x) ? c : mine; }
        if (sum == G) break;
        __builtin_amdgcn_s_sleep(1);
        if ((++sp & 255u) == 0u) { if (xb_ld(&bar[XB_TMO])) break; if (sp > XB_SPIN_CAP) { atomicAdd(&bar[XB_TMO], 1u); break; } }
    }
    nloc = mine > 0u ? mine : 1u; nx = cnt > 0u ? cnt : 1u;
}
__device__ __forceinline__ void xcd_barrier(const XcdBarrier& b) {
    asm volatile("s_waitcnt vmcnt(0)" ::: "memory");
    __syncthreads();
    if (threadIdx.x == 0) {
        unsigned* bar = b.bar;
        __builtin_amdgcn_s_waitcnt(0);
        unsigned nloc = b.st[0], nx = b.st[1];
        if (nloc == 0u) { xcd_barrier_complete(bar, b.x, nloc, nx); b.st[0] = nloc; b.st[1] = nx; }
        const unsigned old = xb_add(&bar[XB_XSUB(b.x)], 1u);
        const unsigned gen = old / nloc;
        if (old + 1u == (gen + 1u) * nloc) {
            __builtin_amdgcn_fence(__ATOMIC_RELEASE, "agent");
            asm volatile("s_waitcnt vmcnt(0)" ::: "memory");
            const unsigned og = xb_add(&bar[XB_TOP], 1u);
            const unsigned tg = og / nx;
            if (og + 1u == (tg + 1u) * nx) xb_add(&bar[XB_TOPGEN], 1u);
            else XB_SPIN(xb_ld(&bar[XB_TOPGEN]) == tg, bar);
            __builtin_amdgcn_fence(__ATOMIC_ACQUIRE, "agent");
            xb_add(&bar[XB_XGEN(b.x)], 1u);
            asm volatile("s_waitcnt vmcnt(0)" ::: "memory");
        } else {
            XB_SPIN(xb_ld(&bar[XB_XGEN(b.x)]) == gen, bar);
            __builtin_amdgcn_fence(__ATOMIC_ACQUIRE, "agent");
            asm volatile("s_waitcnt vmcnt(0)" ::: "memory");
        }
    }
    __syncthreads();
}

struct ConvJob { const float* src; const float* gain; bf16* dst; int K, N, ld, row_off, mode, pad; };
constexpr int NJOBS = 12;
struct Params {
    const float* in[N_IN];
    float* out; unsigned char* ws;
    ConvJob jobs[NJOBS];
    int ph_lo, ph_hi;
};
#define GAS __attribute__((address_space(1)))
struct InTab { const LAS unsigned* t;
    __device__ __forceinline__ const float* operator[](int i) const { const unsigned lo = __builtin_amdgcn_readfirstlane(t[2 * i]), hi = __builtin_amdgcn_readfirstlane(t[2 * i + 1]); return (const float*)(GAS const float*)(((unsigned long long)hi << 32) | lo); } };
struct Frame {
    LAS unsigned char* lds;
    int tid, lane, wave, G, bid;
    InTab in; GAS float* out; GAS unsigned char* ws;
};
__device__ __forceinline__ int prow(int b, int pos) { return pos < NMETA ? XM + pos : b * SEQ + (pos - NMETA); }

template <bool GAIN> __device__ __forceinline__ void p0_transpose_item(const ConvJob& J, LAS float* scr, int item, int lane) {
    const int nblk = J.N / 32, kb = item / nblk, nb = item % nblk, k0 = 64 * kb, n0 = 32 * nb;
    const int kr = lane >> 3, c4 = (lane & 7) * 4;
    f32x4 v[8]; float gn[8];
#pragma unroll
    for (int i = 0; i < 8; ++i) { const int kk = 8 * i + kr; v[i] = *(const f32x4*)(J.src + (size_t)(k0 + kk) * J.ld + n0 + c4); gn[i] = GAIN ? J.gain[k0 + kk] : 1.f; }
#pragma unroll
    for (int i = 0; i < 8; ++i) { const int kk = 8 * i + kr; LAS float* d = scr + kk * 33 + c4; d[0] = v[i].x * gn[i]; d[1] = v[i].y * gn[i]; d[2] = v[i].z * gn[i]; d[3] = v[i].w * gn[i]; }
    LDS_WAIT(); asm volatile("" ::: "memory");
    const int c = lane & 7;
#pragma unroll
    for (int j = 0; j < 4; ++j) { const int n = (lane >> 3) + 8 * j; const LAS float* s = scr + (8 * c) * 33 + n;
        v4u o; o.x = pk2(s[0 * 33], s[1 * 33]); o.y = pk2(s[2 * 33], s[3 * 33]); o.z = pk2(s[4 * 33], s[5 * 33]); o.w = pk2(s[6 * 33], s[7 * 33]);
        const int sc_ = n0 + n; int drow = J.row_off + sc_; if (J.mode == 1) { const int isv = sc_ >= FF ? 1 : 0, ch = sc_ - isv * FF; drow = 32 * (ch >> 4) + 16 * isv + (ch & 15); }
        *(v4u*)(J.dst + (size_t)drow * J.K + k0 + 8 * c) = o; }
    LDS_WAIT(); asm volatile("" ::: "memory");
}
__device__ __forceinline__ void p0_prologue(Frame& F, const Params& P) {
    const int gw = F.bid * 8 + F.wave, NGW = F.G * 8;
    {
        LAS float* scr = (LAS float*)(F.lds + F.wave * 16384);
        int base = 0;
#ifndef P0A
#define P0A 1
#define P0C 1
#endif
#pragma unroll 1
        for (int j_ = 0; j_ < NJOBS * P0A; ++j_) { const int j = j_ % NJOBS; if (j == 0) base = 0;
            const ConvJob J = P.jobs[j]; const int nit = (J.K / 64) * (J.N / 32);
            int first = (gw - base % NGW + NGW) % NGW;
            if (J.gain) { _Pragma("unroll 1") for (int it = first; it < nit; it += NGW) p0_transpose_item<true>(J, scr, it, F.lane); }
            else { _Pragma("unroll 1") for (int it = first; it < nit; it += NGW) p0_transpose_item<false>(J, scr, it, F.lane); }
            base += nit;
        }
        bf16* wz = (bf16*)(F.ws + WS_WKVQA) + (size_t)704 * DM;
        for (int i = F.bid * 512 + F.tid; i < 64 * DM / 8; i += F.G * 512) ((v4u*)wz)[i] = (v4u){0u, 0u, 0u, 0u};
    }
    {
        float* ctab = (float*)(F.ws + WS_ROPE); float* stab = ctab + NPOSTAB * 32;
        for (int idx = F.bid * 512 + F.tid; idx < NPOSTAB * 32; idx += F.G * 512) {
            const int pi = idx >> 5, i = idx & 31; const int pos = pi < LP ? pi : PAST;
            double inv = 1.0; for (int k = 0; k < i; ++k) inv *= 0.74989420933245582730;
            double c1 = 1.0, s1 = inv, tc = 1.0, ts = inv; const double x2 = inv * inv;
            for (int k = 1; k < 14; ++k) { tc *= -x2 / (double)((2 * k - 1) * (2 * k)); ts *= -x2 / (double)((2 * k) * (2 * k + 1)); c1 += tc; s1 += ts; }
            double rc = 1.0, rs = 0.0, bc = c1, bs = s1; int e = pos;
            for (int k = 0; k < 14; ++k) { if (e & 1) { const double t = rc * bc - rs * bs; rs = rc * bs + rs * bc; rc = t; } const double t2 = bc * bc - bs * bs; bs = 2.0 * bc * bs; bc = t2; e >>= 1; }
            ctab[idx] = (float)rc; stab[idx] = (float)rs;
        }
    }
    __syncthreads();
    asm volatile("" : "+s"(F.ws));
    LAS float* wab = (LAS float*)F.lds;
    { const float* win = F.in[I_AWIN]; const float* g = F.in[I_ANPRE];
      for (int idx = F.tid; idx < DM * 16; idx += 512) { const int k = idx >> 4, q = idx & 15, j = k >> 8, ln = (k >> 2) & 63, i = k & 3; wab[(((j * 4 + i) * 4 + (q >> 2)) * 64 + ln) * 4 + (q & 3)] = win[(size_t)k * GIN + 4096 + q] * g[k]; } }
    __syncthreads();
    float* XRES = (float*)(F.ws + WS_XRES); bf16* XH = (bf16*)(F.ws + WS_XH); float* AB = (float*)(F.ws + WS_AB);
#pragma unroll 1
    for (int rb_ = gw * 2; rb_ < TM * P0C; rb_ += NGW * 2) { const int rb = rb_ % TM;
        f32x4 v[2][4]; float msk[2];
#pragma unroll
        for (int u = 0; u < 2; ++u) { const int row = rb + u; const float* src = F.in[I_XP];
            if (row < TR) src = F.in[I_XP] + (size_t)row * DM; else if (row < XS) src = F.in[I_META] + (size_t)(row - XM) * DM; else if (row < NVALID) src = F.in[I_XS] + (size_t)(row - XS) * DM;
            msk[u] = row < NVALID ? 1.f : 0.f;
#pragma unroll
            for (int j = 0; j < 4; ++j) v[u][j] = ((const f32x4*)src)[64 * j + F.lane]; }
#pragma unroll
        for (int u = 0; u < 2; ++u) { const int row = rb + u; float ss = 0.f;
#pragma unroll
            for (int j = 0; j < 4; ++j) { v[u][j] = v[u][j] * msk[u]; ss += (v[u][j].x * v[u][j].x + v[u][j].y * v[u][j].y) + (v[u][j].z * v[u][j].z + v[u][j].w * v[u][j].w); }
            ss = wave_sum(ss); const float rstd = rsqrtf(ss * (1.f / DM) + EPS);
            unsigned long long* xh = (unsigned long long*)(XH + (size_t)row * DM);
#pragma unroll
            for (int j = 0; j < 4; ++j) { v[u][j] = v[u][j] * rstd; xh[64 * j + F.lane] = (unsigned long long)pk2(v[u][j].x, v[u][j].y) | ((unsigned long long)pk2(v[u][j].z, v[u][j].w) << 32); }
            if (row >= NVALID) continue;
            float a[16];
#pragma unroll
            for (int q = 0; q < 16; ++q) a[q] = 0.f;
#pragma unroll
            for (int j = 0; j < 4; ++j)
#pragma unroll
                for (int i = 0; i < 4; ++i) { const float xv = v[u][j][i]; const LAS f32x4* wr = (const LAS f32x4*)wab + (j * 4 + i) * 256 + F.lane;
#pragma unroll
                    for (int q4 = 0; q4 < 4; ++q4) { const f32x4 w = wr[q4 * 64]; a[4 * q4 + 0] += xv * w.x; a[4 * q4 + 1] += xv * w.y; a[4 * q4 + 2] += xv * w.z; a[4 * q4 + 3] += xv * w.w; } }
#pragma unroll
            for (int i = 0; i < 8; ++i) { auto r_ = __builtin_amdgcn_permlane32_swap(__float_as_uint(a[i]), __float_as_uint(a[i + 8]), false, false); a[i] = __uint_as_float(r_[0]) + __uint_as_float(r_[1]); }
#pragma unroll
            for (int i = 0; i < 4; ++i) { auto r_ = __builtin_amdgcn_permlane16_swap(__float_as_uint(a[i]), __float_as_uint(a[i + 4]), false, false); a[i] = __uint_as_float(r_[0]) + __uint_as_float(r_[1]); }
            { const bool b3 = (F.lane & 8) != 0, b2 = (F.lane & 4) != 0;
#pragma unroll
              for (int i = 0; i < 2; ++i) { const float keep = b3 ? a[i + 2] : a[i], send = b3 ? a[i] : a[i + 2]; a[i] = keep + DPPF(send, 0x140); }
              { const float keep = b2 ? a[1] : a[0], send = b2 ? a[0] : a[1]; a[0] = keep + DPPF(send, 0x141); } }
            a[0] += DPPF(a[0], 0x4E); a[0] += DPPF(a[0], 0xB1);
            if ((F.lane & 3) == 0) { const int idx = ((F.lane >> 5) & 1) * 8 + ((F.lane >> 4) & 1) * 4 + ((F.lane >> 3) & 1) * 2 + ((F.lane >> 2) & 1); AB[(size_t)row * 16 + idx] = a[0]; }
        }
    }
}

__device__ __forceinline__ void gdn_item(Frame& F, int item) {
    const bool is_p = item < NB * GH;
    const int b = is_p ? item >> 3 : 0, h = item & 7, s = is_p ? 0 : (item - NB * GH) >> 3;
    const int dv = F.tid & 127, qd = __builtin_amdgcn_readfirstlane(F.tid >> 7);
    LAS float* qs = (LAS float*)F.lds; LAS float* ks = qs + 16 * 128; LAS float* vs = ks + 16 * 128; LAS float* red = vs + 16 * 128; LAS float* red2 = red + 512; LAS float* egs = red2 + 512; LAS float* bes = egs + 16;
    const bf16* QKVZ = (const bf16*)(F.ws + WS_QKVZ); const float* AB = (const float*)(F.ws + WS_AB); bf16* OB = (bf16*)(F.ws + WS_TMP);
    const float* cw = F.in[I_ACONV]; const float* sdc = F.in[I_SDC];
    float S[32];
    if (is_p) {
#pragma unroll
        for (int i = 0; i < 32; ++i) S[i] = 0.f;
    } else { const float* s0 = F.in[I_SDS] + ((size_t)(s * GH + h) * GDK + 32 * qd) * GDV + dv;
#pragma unroll
        for (int i = 0; i < 32; ++i) S[i] = s0[(size_t)i * GDV]; }
    const float Ah = __expf(F.in[I_ALOG][h]), dtb = F.in[I_ADT][h];
    const int nchunk = is_p ? LP / 16 : 1, ntok = is_p ? 16 : 1;
#pragma unroll 1
    for (int ch = 0; ch < nchunk; ++ch) {
        for (int idx = F.tid; idx < ntok * 384; idx += 512) {
            const int ti = idx / 384, c = idx - ti * 384, part = c >> 7, cc = c & 127, col = part * 1024 + h * 128 + cc;
            float acc = 0.f;
#pragma unroll
            for (int j = 0; j < 4; ++j) {
                float xv;
                if (is_p) { const int pos = ch * 16 + ti - 3 + j; xv = pos < 0 ? 0.f : bf2f(QKVZ[(size_t)prow(b, pos) * 4096 + col]); }
                else xv = j < 3 ? sdc[(size_t)(s * 3 + j) * GQKV + col] : bf2f(QKVZ[(size_t)(XS + s) * 4096 + col]);
                acc += cw[j * GQKV + col] * xv;
            }
            acc = siluf(acc);
            (part == 0 ? qs : part == 1 ? ks : vs)[ti * 128 + cc] = acc;
        }
        if (F.tid < ntok) { const int row = is_p ? prow(b, ch * 16 + F.tid) : XS + s; const float a = AB[(size_t)row * 16 + h], bb = AB[(size_t)row * 16 + 8 + h];
            const float x = a + dtb, sp = x > 20.f ? x : log1pf(__expf(x)); egs[F.tid] = __expf(-Ah * sp); bes[F.tid] = 1.f / (1.f + __expf(-bb)); }
        __syncthreads();
        for (int vv = F.wave; vv < 2 * ntok; vv += 8) { const int ti = vv >> 1, isk = vv & 1; LAS float* p = (isk ? ks : qs) + ti * 128; const float x0 = p[F.lane], x1 = p[F.lane + 64];
            const float ss = wave_sum(x0 * x0 + x1 * x1); const float r = rsqrtf(ss + EPS) * (isk ? 1.f : 0.08838834764831845f); p[F.lane] = x0 * r; p[F.lane + 64] = x1 * r; }
        __syncthreads();
#pragma unroll 1
        for (int ti = 0; ti < ntok; ++ti) {
            float kk[32]; float p = 0.f;
#pragma unroll
            for (int i = 0; i < 32; ++i) { kk[i] = ks[ti * 128 + 32 * qd + i]; p += kk[i] * S[i]; }
            red[qd * 128 + dv] = p; __syncthreads();
            const float kS = (red[dv] + red[128 + dv]) + (red[256 + dv] + red[384 + dv]);
            const float eg = egs[ti], be = bes[ti], u = be * (vs[ti * 128 + dv] - eg * kS);
            float op = 0.f;
#pragma unroll
            for (int i = 0; i < 32; ++i) { S[i] = eg * S[i] + kk[i] * u; op += qs[ti * 128 + 32 * qd + i] * S[i]; }
            red2[qd * 128 + dv] = op; __syncthreads();
            if (qd == 0) { const float o = (red2[dv] + red2[128 + dv]) + (red2[256 + dv] + red2[384 + dv]);
                const int row = is_p ? prow(b, ch * 16 + ti) : XS + s;
                if (!is_p || ch > 0 || b == 0) OB[(size_t)row * DM + h * 128 + dv] = (bf16)f2bf(o); }
        }
        __syncthreads();
    }
    GAS float* so = is_p ? F.out + O_PDS + ((size_t)(b * GH + h) * GDK + 32 * qd) * GDV + dv : F.out + O_SDS + ((size_t)(s * GH + h) * GDK + 32 * qd) * GDV + dv;
#pragma unroll
    for (int i = 0; i < 32; ++i) so[(size_t)i * GDV] = S[i];
}

__device__ __forceinline__ void p3_gate(Frame& F) {
    const int gw = F.bid * 8 + F.wave, NGW = F.G * 8;
    const bf16* OB = (const bf16*)(F.ws + WS_TMP); const bf16* QKVZ = (const bf16*)(F.ws + WS_QKVZ); bf16* GO = (bf16*)(F.ws + WS_GO);
    const float* on = F.in[I_AONORM];
    f32x4 g4[4];
#pragma unroll
    for (int j = 0; j < 4; ++j) g4[j] = ((const f32x4*)on)[((16 * F.lane) & 127) / 4 + j];
    for (int row = gw; row < NVALID; row += NGW) {
        const v4u* op = (const v4u*)(OB + (size_t)row * DM + 16 * F.lane); const v4u* zp = (const v4u*)(QKVZ + (size_t)row * 4096 + 3072 + 16 * F.lane);
        f32x4 o[4]; float ss = 0.f; const v4u o0 = op[0], o1 = op[1]; const unsigned ow[8] = {o0.x, o0.y, o0.z, o0.w, o1.x, o1.y, o1.z, o1.w};
#pragma unroll
        for (int j = 0; j < 4; ++j) { o[j] = (f32x4){bflo(ow[2 * j]), bfhi(ow[2 * j]), bflo(ow[2 * j + 1]), bfhi(ow[2 * j + 1])}; ss += (o[j].x * o[j].x + o[j].y * o[j].y) + (o[j].z * o[j].z + o[j].w * o[j].w); }
        ss += DPPF(ss, 0xB1); ss += DPPF(ss, 0x4E); ss += DPPF(ss, 0x141);
        const float rstd = rsqrtf(ss * (1.f / 128.f) + EPS);
        const v4u z0 = zp[0], z1 = zp[1]; const unsigned zw[8] = {z0.x, z0.y, z0.z, z0.w, z1.x, z1.y, z1.z, z1.w};
        unsigned w[8];
#pragma unroll
        for (int j = 0; j < 4; ++j) { const f32x4 y = o[j] * rstd * g4[j];
            w[2 * j] = pk2(y.x * siluf(bflo(zw[2 * j])), y.y * siluf(bfhi(zw[2 * j]))); w[2 * j + 1] = pk2(y.z * siluf(bflo(zw[2 * j + 1])), y.w * siluf(bfhi(zw[2 * j + 1]))); }
        v4u* gp = (v4u*)(GO + (size_t)row * DM + 16 * F.lane); gp[0] = (v4u){w[0], w[1], w[2], w[3]}; gp[1] = (v4u){w[4], w[5], w[6], w[7]};
    }
    const int gt = F.bid * 512 + F.tid, NGT = F.G * 512;
    { const float* RAWQ = (const float*)(F.ws + WS_RAWQ);
      for (int i = gt; i < NB * 3 * GQKV; i += NGT) { const int c = i % GQKV, j = (i / GQKV) % 3, b = i / (3 * GQKV); F.out[O_PDC + i] = RAWQ[((size_t)(b * 32 + 31) * 6 + 3 + j) * GQKV + c]; } }
    for (int i = gt; i < NS * 3 * GQKV; i += NGT) { const int c = i % GQKV, j = (i / GQKV) % 3, s = i / (3 * GQKV);
        F.out[O_SDC + i] = j < 2 ? F.in[I_SDC][(size_t)(s * 3 + j + 1) * GQKV + c] : bf2f(QKVZ[(size_t)(XS + s) * 4096 + c]); }
}

template <bool LAST, bool FIRST = false> __device__ __forceinline__ void p_postnorm(Frame& F, const float* gpost) {
    const int gw = F.bid * 8 + F.wave, NGW = F.G * 8;
    const bf16* TMPB = (const bf16*)(F.ws + WS_TMP); bf16* XH = (bf16*)(F.ws + WS_XH); float* RS = (float*)(F.ws + WS_GEG);
    f32x4 g[4];
#pragma unroll
    for (int j = 0; j < 4; ++j) g[j] = ((const f32x4*)gpost)[64 * j + F.lane];
    static_assert(NVALID % 2 == 0, "two rows per wave iteration");
    const float* xin_p = F.in[I_XP]; const float* xin_m = F.in[I_META]; const float* xin_s = F.in[I_XS];
#pragma unroll 1
    for (int rb = gw * 2; rb < NVALID; rb += NGW * 2) {
        f32x4 t[2][4], x[2][4];
#pragma unroll
        for (int u = 0; u < 2; ++u) { const v2u* tp = (const v2u*)(TMPB + (size_t)(rb + u) * DM); const v2u* xb = (const v2u*)(XH + (size_t)(rb + u) * DM); const float iv = FIRST ? 1.f : RS[rb + u];
            const int row = rb + u; const f32x4* xp = (const f32x4*)(row < TR ? xin_p + (size_t)row * DM : (row < XS ? xin_m + (size_t)(row - XM) * DM : xin_s + (size_t)(row - XS) * DM));
#pragma unroll
            for (int j = 0; j < 4; ++j) { const v2u w = tp[64 * j + F.lane]; t[u][j] = (f32x4){bflo(w.x), bfhi(w.x), bflo(w.y), bfhi(w.y)};
                if (FIRST) x[u][j] = xp[64 * j + F.lane]; else { const v2u q = xb[64 * j + F.lane]; x[u][j] = (f32x4){bflo(q.x), bfhi(q.x), bflo(q.y), bfhi(q.y)} * iv; } } }
#pragma unroll
        for (int u = 0; u < 2; ++u) { const int row = rb + u; float ss = 0.f;
#pragma unroll
            for (int j = 0; j < 4; ++j) ss += (t[u][j].x * t[u][j].x + t[u][j].y * t[u][j].y) + (t[u][j].z * t[u][j].z + t[u][j].w * t[u][j].w);
            ss = wave_sum(ss); const float rstd = rsqrtf(ss * (1.f / DM) + EPS); float s2 = 0.f;
#pragma unroll
            for (int j = 0; j < 4; ++j) { x[u][j] = x[u][j] + t[u][j] * rstd * g[j]; s2 += (x[u][j].x * x[u][j].x + x[u][j].y * x[u][j].y) + (x[u][j].z * x[u][j].z + x[u][j].w * x[u][j].w); }
            if (LAST) {
                GAS float* yo = row < TR ? F.out + O_YP + (size_t)row * DM : (row >= XS ? F.out + O_YS + (size_t)(row - XS) * DM : nullptr);
                if (yo) {
#pragma unroll
                    for (int j = 0; j < 4; ++j) ((f32x4*)yo)[64 * j + F.lane] = x[u][j]; }
            } else {
                s2 = wave_sum(s2); const float m2 = s2 * (1.f / DM) + EPS, r2 = rsqrtf(m2);
                unsigned long long* xh = (unsigned long long*)(XH + (size_t)row * DM);
                if (F.lane == 0) RS[row] = sqrtf(m2);
#pragma unroll
                for (int j = 0; j < 4; ++j) { const f32x4 y = x[u][j] * r2; xh[64 * j + F.lane] = (unsigned long long)pk2(y.x, y.y) | ((unsigned long long)pk2(y.z, y.w) << 32); }
            }
        }
    }
}

__device__ __forceinline__ void ld8(const bf16* p, float (&o)[8]) { const v4u w = *(const v4u*)p; o[0] = bflo(w.x); o[1] = bfhi(w.x); o[2] = bflo(w.y); o[3] = bfhi(w.y); o[4] = bflo(w.z); o[5] = bfhi(w.z); o[6] = bflo(w.w); o[7] = bfhi(w.w); }
__device__ __forceinline__ void ld8f(const float* p, float (&o)[8]) { const f32x4 a = ((const f32x4*)p)[0], b = ((const f32x4*)p)[1]; o[0] = a.x; o[1] = a.y; o[2] = a.z; o[3] = a.w; o[4] = b.x; o[5] = b.y; o[6] = b.z; o[7] = b.w; }
__device__ __forceinline__ int ffperm(int ch, int isv) { return 32 * (ch >> 4) + 16 * isv + (ch & 15); }
__device__ __forceinline__ void p_ffn_fix(Frame& F, int layer) {
    bf16* ACT = (bf16*)(F.ws + WS_ACT); const float* RAWH = (const float*)(F.ws + WS_RAWH); const float* RAWX = (const float*)(F.ws + WS_RAWX);
    const float* cw = F.in[I_FCONVW] + (size_t)layer * 3 * FF2; const float* cb = F.in[I_FCONVB] + (size_t)layer * FF2; const float* sfc = F.in[I_SFC] + (size_t)layer * NS * 2 * FF2;
    const int gt = F.bid * 512 + F.tid, NGT = F.G * 512; constexpr int CG = FF / 8, NG = TR / 64;
#pragma unroll 1
    for (int i = gt; i < (NG * 2 + NMETA + NS) * CG; i += NGT) {
        const int task = i / CG, ch0 = (i - task * CG) * 8, cog = ffperm(ch0, 0), cov = cog + 16;
        const float* p2; const float* p1; const float* p0; float k1 = 1.f, k0 = 1.f; int row; bool smp = false; int sidx = 0;
        if (task < NG * 2) { const int g = task >> 1, j = task & 1; row = 64 * g + j; const bool bstart = ((64 * g) & (SEQ - 1)) == 0;
            const float* prev3 = bstart ? RAWX + (size_t)15 * FF2 : RAWH + ((size_t)(g - 1) * 4 + 3) * FF2; const float* prev2 = bstart ? RAWX + (size_t)14 * FF2 : RAWH + ((size_t)(g - 1) * 4 + 2) * FF2;
            const float* c0 = RAWH + ((size_t)g * 4) * FF2; const float* c1 = c0 + FF2;
            if (j == 0) { p2 = c0; p1 = prev3; p0 = prev2; } else { p2 = c1; p1 = c0; p0 = prev3; } }
        else { const int rr = task - NG * 2; row = XM + rr; smp = rr >= NMETA; sidx = smp ? rr - NMETA : 0; p2 = RAWX + (size_t)rr * FF2;
            p1 = (!smp && rr >= 1) ? p2 - FF2 : RAWX; p0 = (!smp && rr >= 2) ? p2 - 2 * FF2 : RAWX; k1 = (!smp && rr >= 1) ? 1.f : 0.f; k0 = (!smp && rr >= 2) ? 1.f : 0.f; }
        float x2g[8], x2v[8], x1g[8], x1v[8], x0g[8], x0v[8], s1g[8], s1v[8], s0g[8], s0v[8];
        ld8f(p2 + cog, x2g); ld8f(p2 + cov, x2v); ld8f(p1 + cog, x1g); ld8f(p1 + cov, x1v); ld8f(p0 + cog, x0g); ld8f(p0 + cov, x0v);
        const float ks = smp ? 1.f : 0.f;
        ld8f(sfc + (size_t)(sidx * 2 + 1) * FF2 + ch0, s1g); ld8f(sfc + (size_t)(sidx * 2 + 1) * FF2 + FF + ch0, s1v); ld8f(sfc + (size_t)(sidx * 2) * FF2 + ch0, s0g); ld8f(sfc + (size_t)(sidx * 2) * FF2 + FF + ch0, s0v);
        float w0g[8], w1g[8], w2g[8], w0v[8], w1v[8], w2v[8], bg[8], bv[8];
        ld8f(cw + ch0, w0g); ld8f(cw + FF2 + ch0, w1g); ld8f(cw + 2 * FF2 + ch0, w2g); ld8f(cw + FF + ch0, w0v); ld8f(cw + FF2 + FF + ch0, w1v); ld8f(cw + 2 * FF2 + FF + ch0, w2v); ld8f(cb + ch0, bg); ld8f(cb + FF + ch0, bv);
        float a[8];
#pragma unroll
        for (int k = 0; k < 8; ++k) { const float q0g = k0 * x0g[k] + ks * s0g[k], q0v = k0 * x0v[k] + ks * s0v[k], q1g = k1 * x1g[k] + ks * s1g[k], q1v = k1 * x1v[k] + ks * s1v[k];
            const float ug = w0g[k] * q0g + w1g[k] * q1g + w2g[k] * x2g[k] + bg[k], uv = w0v[k] * q0v + w1v[k] * q1v + w2v[k] * x2v[k] + bv[k]; a[k] = siluf(ug) * uv; }
        *(v4u*)(ACT + (size_t)row * FF + ch0) = (v4u){pk2(a[0], a[1]), pk2(a[2], a[3]), pk2(a[4], a[5]), pk2(a[6], a[7])};
    }
    GAS float* pfc = F.out + O_PFC + (size_t)layer * NB * 2 * FF2; GAS float* sfo = F.out + O_SFC + (size_t)layer * NS * 2 * FF2;
    for (int i = gt; i < NB * 2 * FF2; i += NGT) { const int c = i % FF2, j = (i / FF2) & 1, b = i / (2 * FF2); const int isv = c >= FF ? 1 : 0; pfc[i] = RAWH[((size_t)(b * 32 + 31) * 4 + 2 + j) * FF2 + ffperm(c - isv * FF, isv)]; }
    for (int i = gt; i < NS * 2 * FF2; i += NGT) { const int c = i % FF2, j = (i / FF2) & 1, s_ = i / (2 * FF2); const int isv = c >= FF ? 1 : 0;
        sfo[i] = j == 0 ? sfc[(size_t)(s_ * 2 + 1) * FF2 + c] : RAWX[(size_t)(NMETA + s_) * FF2 + ffperm(c - isv * FF, isv)]; }
}

__device__ __forceinline__ void p_kvq(Frame& F) {
    const int gw = F.bid * 8 + F.wave, NGW = F.G * 8;
    const bf16* CK = (const bf16*)(F.ws + WS_CKVQ); bf16* CB = (bf16*)(F.ws + WS_CB); bf16* KRB = (bf16*)(F.ws + WS_KRB); bf16* QAN = (bf16*)(F.ws + WS_QAN);
    const float* ctab = (const float*)(F.ws + WS_ROPE); const float* stab = ctab + NPOSTAB * 32;
    const f32x4 gk = ((const f32x4*)F.in[I_KVANORM])[F.lane];
    float gq[6];
#pragma unroll
    for (int j = 0; j < 6; ++j) gq[j] = F.in[I_BQANORM][F.lane + 64 * j];
    for (int row = gw; row < NVALID; row += NGW) {
        const bf16* cr = CK + (size_t)row * 768;
        const v2u lw = ((const v2u*)cr)[F.lane]; f32x4 lat = {bflo(lw.x), bfhi(lw.x), bflo(lw.y), bfhi(lw.y)}; float ss = wave_sum((lat.x * lat.x + lat.y * lat.y) + (lat.z * lat.z + lat.w * lat.w));
        lat = lat * rsqrtf(ss * (1.f / KVL) + EPS) * gk;
        const int posidx = row < TR ? NMETA + (row & (SEQ - 1)) : (row < XS ? row - XM : LP);
        const int i = F.lane & 31; const float x1 = bf2f(cr[256 + i]), x2 = bf2f(cr[288 + i]), cs = ctab[posidx * 32 + i], sn = stab[posidx * 32 + i];
        const float kr = F.lane < 32 ? x1 * cs - x2 * sn : x2 * cs + x1 * sn;
        ((v2u*)(CB + (size_t)row * KVL))[F.lane] = (v2u){pk2(lat.x, lat.y), pk2(lat.z, lat.w)};
        KRB[(size_t)row * ROPE + F.lane] = (bf16)f2bf(kr);
        if (row < TR) { const int b = row >> 11, t = row & (SEQ - 1); ((f32x4*)(F.out + O_PKV + ((size_t)b * LP + NMETA + t) * KVL))[F.lane] = lat; F.out[O_PKR + ((size_t)b * LP + NMETA + t) * ROPE + F.lane] = kr; }
        else if (row < XS) { const int m = row - XM;
            for (int b = 0; b < NB; ++b) { ((f32x4*)(F.out + O_PKV + ((size_t)b * LP + m) * KVL))[F.lane] = lat; F.out[O_PKR + ((size_t)b * LP + m) * ROPE + F.lane] = kr; } }
        else { const int s = row - XS; ((f32x4*)(F.out + O_SKV + (size_t)s * KVL))[F.lane] = lat; F.out[O_SKR + (size_t)s * ROPE + F.lane] = kr; }
        float qa[6]; float sq = 0.f;
#pragma unroll
        for (int j = 0; j < 6; ++j) { qa[j] = bf2f(cr[320 + F.lane + 64 * j]); sq += qa[j] * qa[j]; }
        sq = wave_sum(sq); const float rq = rsqrtf(sq * (1.f / QL) + EPS);
#pragma unroll
        for (int j = 0; j < 6; ++j) QAN[(size_t)row * QL + F.lane + 64 * j] = (bf16)f2bf(qa[j] * rq * gq[j]);
    }
}
__device__ __forceinline__ void p_qrope(Frame& F) {
    const int gw = F.bid * 8 + F.wave, NGW = F.G * 8;
    bf16* Q = (bf16*)(F.ws + WS_Q); const float* ctab = (const float*)(F.ws + WS_ROPE); const float* stab = ctab + NPOSTAB * 32;
    for (int row = gw; row < NVALID; row += NGW) {
        const int posidx = row < TR ? NMETA + (row & (SEQ - 1)) : (row < XS ? row - XM : LP);
#pragma unroll
        for (int j = 0; j < 4; ++j) { const int idx = F.lane + 64 * j, h = idx >> 5, i = idx & 31; bf16* q = Q + (size_t)row * 1536 + h * HD + NOPE + i;
            const float x1 = bf2f(q[0]), x2 = bf2f(q[32]), cs = ctab[posidx * 32 + i], sn = stab[posidx * 32 + i];
            q[0] = (bf16)f2bf(x1 * cs - x2 * sn); q[32] = (bf16)f2bf(x2 * cs + x1 * sn); }
    }
}

constexpr int SHM_K = 64 * HD * 2, SHM_V = 64 * 128 * 2;
constexpr int ATT_K = 0, ATT_V = 2 * SHM_K, ATT_WS = ATT_V + 3 * SHM_V, ATT_QPE = ATT_WS + 8 * 64 * 4;
static_assert(ATT_QPE + 8 * 4096 <= CTLLDS_OFF, "attention LDS");
#define KSWZ(row, colB) ((row) * 384 + ((colB) ^ ((((row) >> 1) & 7) << 4)))
__device__ __forceinline__ int v_st(int k, int c) { const int kk = (k & ~0xC) | ((k & 4) << 1) | ((k & 8) >> 1); return ((kk >> 3) * 4 + (c >> 5)) * 512 + ((kk & 7) * 32 + (c & 31)) * 2; }
__device__ __forceinline__ int v_rd_base(int lane) { return ((lane & 3) << 3) | (((lane >> 2) & 3) << 6) | (((lane >> 4) & 1) << 5) | (((lane >> 5) & 1) << 8); }
constexpr int v_rd_off(int d0, int ks, int half) { return d0 * 512 + ks * 4096 + half * 2048; }
__device__ __forceinline__ int crow(int r, int hi) { return (r & 3) + 8 * (r >> 2) + 4 * hi; }
__device__ __forceinline__ unsigned cvtpk(float lo, float hi) { return pg8::cvt_pk_bf16(lo, hi); }
__device__ __forceinline__ bf16x8 pack8f(const f32x4 a, const f32x4 b) { v4u w = {cvtpk(a.x, a.y), cvtpk(a.z, a.w), cvtpk(b.x, b.y), cvtpk(b.z, b.w)}; return *reinterpret_cast<bf16x8*>(&w); }
__device__ __forceinline__ f32x4 mfma16(bf16x8 a, bf16x8 b, f32x4 c) { return __builtin_amdgcn_mfma_f32_16x16x32_bf16(a, b, c, 0, 0, 0); }
constexpr float ATT_THR = 8.f;
__device__ __forceinline__ void partialSM(f32x16& p0, f32x16& p1, float& m_reg, float& mn, float& alpha) {
    float pmax = p0[0];
#pragma unroll
    for (int r = 1; r < 16; ++r) pmax = fmaxf(pmax, p0[r]);
#pragma unroll
    for (int r = 0; r < 16; ++r) pmax = fmaxf(pmax, p1[r]);
    { auto rr = __builtin_amdgcn_permlane32_swap(__float_as_uint(pmax), __float_as_uint(pmax), false, false);
      pmax = fmaxf(__uint_as_float(rr[0]), __uint_as_float(rr[1])); }
    constexpr float C2 = 1.4426950408889634f * MLA_SCALE;
    if (__builtin_expect(__all((pmax - m_reg) * MLA_SCALE <= ATT_THR), 1)) { mn = m_reg; alpha = 1.f; }
    else { mn = fmaxf(m_reg, pmax); alpha = __builtin_amdgcn_exp2f((m_reg - mn) * C2); m_reg = mn; }
    const float mnL = -mn * C2;
#pragma unroll
    for (int r = 0; r < 16; ++r) p0[r] = fmaf(p0[r], C2, mnL);
#pragma unroll
    for (int r = 0; r < 16; ++r) p1[r] = fmaf(p1[r], C2, mnL);
#pragma unroll
    for (int r = 0; r < 16; ++r) p0[r] = __builtin_amdgcn_exp2f(p0[r]);
}
__device__ __forceinline__ void finishSM(f32x16& p0, f32x16& p1, float alpha, float& l_reg, bf16x8& pa0, bf16x8& pa1, bf16x8& pa2, bf16x8& pa3) {
#pragma unroll
    for (int r = 0; r < 16; ++r) p1[r] = __builtin_amdgcn_exp2f(p1[r]);
    float ps = 0;
#pragma unroll
    for (int r = 0; r < 16; ++r) ps += p0[r];
#pragma unroll
    for (int r = 0; r < 16; ++r) ps += p1[r];
    { auto rr = __builtin_amdgcn_permlane32_swap(__float_as_uint(ps), __float_as_uint(ps), false, false);
      ps = __uint_as_float(rr[0]) + __uint_as_float(rr[1]); }
    l_reg = l_reg * alpha + ps;
#define PK4(P, B_, OUT) do { unsigned a0 = cvtpk(P[B_+0], P[B_+1]), a1 = cvtpk(P[B_+2], P[B_+3]);                          \
        unsigned b0 = cvtpk(P[B_+4], P[B_+5]), b1 = cvtpk(P[B_+6], P[B_+7]);                                             \
        auto r0 = __builtin_amdgcn_permlane32_swap(a0, b0, false, false); auto r1 = __builtin_amdgcn_permlane32_swap(a1, b1, false, false); \
        v4u w = {r0[0], r1[0], r0[1], r1[1]}; OUT = *reinterpret_cast<bf16x8*>(&w); } while (0)
    PK4(p0, 0, pa0); PK4(p0, 8, pa1); PK4(p1, 0, pa2); PK4(p1, 8, pa3);
#undef PK4
}
__device__ __forceinline__ void qkt192(f32x16& p0, f32x16& p1, const LAS char* Kb, int r32, int hi, const bf16x8* qr, const LAS char* qpe) {
    p0 = f32x16{}; p1 = f32x16{};
    const LAS char* kb[4];
#pragma unroll
    for (int dd = 0; dd < 4; ++dd) kb[dd] = Kb + KSWZ(r32, (dd * 16 + hi * 8) * 2);
#pragma unroll
    for (int d0 = 0; d0 < 12; ++d0) { const LAS char* a = kb[d0 & 3] + (d0 >> 2) * 128;
        const bf16x8 b0 = *(const LAS bf16x8*)a, b1 = *(const LAS bf16x8*)(a + 32 * 384);
        const bf16x8 qf = d0 < 8 ? qr[d0 & 7] : *(const LAS bf16x8*)(qpe + (d0 & 3) * 1024);
        p0 = __builtin_amdgcn_mfma_f32_32x32x16_bf16(b0, qf, p0, 0, 0, 0);
        p1 = __builtin_amdgcn_mfma_f32_32x32x16_bf16(b1, qf, p1, 0, 0, 0);
        if ((d0 & 3) == 3) __builtin_amdgcn_sched_barrier(0); }
}
__device__ __forceinline__ void pv_tile(f32x16* o, int vb0, bf16x8 pa0, bf16x8 pa1, bf16x8 pa2, bf16x8 pa3) {
#define TRRD(dst, off) asm volatile("ds_read_b64_tr_b16 %0, %1 offset:%2" : "=&v"(dst) : "v"(vb0), "i"(off) : "memory")
#define PV_D0(d0) do { s16x4 l0, l1, l2, l3, h0, h1, h2, h3; constexpr int b_ = v_rd_off(d0, 0, 0); \
        TRRD(l0, b_); TRRD(h0, b_ + 2048); TRRD(l1, b_ + 4096); TRRD(h1, b_ + 6144); TRRD(l2, b_ + 8192); TRRD(h2, b_ + 10240); TRRD(l3, b_ + 12288); TRRD(h3, b_ + 14336); \
        asm volatile("s_waitcnt lgkmcnt(0)" ::: "memory"); __builtin_amdgcn_sched_barrier(0); \
        o[d0] = __builtin_amdgcn_mfma_f32_32x32x16_bf16(pa0, (bf16x8){l0[0], l0[1], l0[2], l0[3], h0[0], h0[1], h0[2], h0[3]}, o[d0], 0, 0, 0);   \
        o[d0] = __builtin_amdgcn_mfma_f32_32x32x16_bf16(pa1, (bf16x8){l1[0], l1[1], l1[2], l1[3], h1[0], h1[1], h1[2], h1[3]}, o[d0], 0, 0, 0);   \
        o[d0] = __builtin_amdgcn_mfma_f32_32x32x16_bf16(pa2, (bf16x8){l2[0], l2[1], l2[2], l2[3], h2[0], h2[1], h2[2], h2[3]}, o[d0], 0, 0, 0);   \
        o[d0] = __builtin_amdgcn_mfma_f32_32x32x16_bf16(pa3, (bf16x8){l3[0], l3[1], l3[2], l3[3], h3[0], h3[1], h3[2], h3[3]}, o[d0], 0, 0, 0); } while (0)
    PV_D0(0); PV_D0(1); PV_D0(2); PV_D0(3);
#undef PV_D0
#undef TRRD
}
__device__ __forceinline__ void attn_qblock(Frame& F, int b, int h, int qb) {
    const int wid = F.wave, lane = F.lane, r32 = lane & 31, hi = lane >> 5;
    const bf16* Q = (const bf16*)(F.ws + WS_Q); const bf16* KNV = (const bf16*)(F.ws + WS_KNV); const bf16* KRB = (const bf16*)(F.ws + WS_KRB); bf16* AO = (bf16*)(F.ws + WS_AO);
    LAS char* K_lds = (LAS char*)F.lds + ATT_K; LAS char* V_lds = (LAS char*)F.lds + ATT_V;
    LAS float* wsf = (LAS float*)(F.lds + ATT_WS) + wid * 64; LAS float* li_l = wsf; LAS float* al_l = wsf + 32;
    bf16x8 qr[8]; LAS char* qpe = (LAS char*)F.lds + ATT_QPE + wid * 4096 + lane * 16;
    { const bf16* qp = Q + (size_t)(b * SEQ + qb * 256 + wid * 32 + r32) * 1536 + h * HD + hi * 8;
#pragma unroll
      for (int d0 = 0; d0 < 8; ++d0) qr[d0] = *(const bf16x8*)(qp + d0 * 16);
      const float* ctab = (const float*)(F.ws + WS_ROPE); const float* stab = ctab + NPOSTAB * 32; const int pidx = (NMETA + qb * 256 + wid * 32 + r32) * 32 + hi * 8;
#pragma unroll
      for (int pr = 0; pr < 2; ++pr) { const v4u wa = *(const v4u*)(qp + (8 + pr) * 16), wb = *(const v4u*)(qp + (10 + pr) * 16);
          const f32x4 c0 = *(const f32x4*)(ctab + pidx + 16 * pr), c1 = *(const f32x4*)(ctab + pidx + 16 * pr + 4), s0 = *(const f32x4*)(stab + pidx + 16 * pr), s1 = *(const f32x4*)(stab + pidx + 16 * pr + 4);
          const float xa[8] = {bflo(wa.x), bfhi(wa.x), bflo(wa.y), bfhi(wa.y), bflo(wa.z), bfhi(wa.z), bflo(wa.w), bfhi(wa.w)}, xb[8] = {bflo(wb.x), bfhi(wb.x), bflo(wb.y), bfhi(wb.y), bflo(wb.z), bfhi(wb.z), bflo(wb.w), bfhi(wb.w)};
          const float cs[8] = {c0.x, c0.y, c0.z, c0.w, c1.x, c1.y, c1.z, c1.w}, sn[8] = {s0.x, s0.y, s0.z, s0.w, s1.x, s1.y, s1.z, s1.w};
          float oa[8], ob[8];
#pragma unroll
          for (int e = 0; e < 8; ++e) { oa[e] = xa[e] * cs[e] - xb[e] * sn[e]; ob[e] = xb[e] * cs[e] + xa[e] * sn[e]; }
          const v4u va = {cvtpk(oa[0], oa[1]), cvtpk(oa[2], oa[3]), cvtpk(oa[4], oa[5]), cvtpk(oa[6], oa[7])}, vb = {cvtpk(ob[0], ob[1]), cvtpk(ob[2], ob[3]), cvtpk(ob[4], ob[5]), cvtpk(ob[6], ob[7])};
          *(LAS v4u*)(qpe + pr * 1024) = va; *(LAS v4u*)(qpe + (2 + pr) * 1024) = vb; } }
    const int NT = 1 + 4 * (qb + 1);
    unsigned k0o[3], k1o[3], v0o[2], v1o[2];
#pragma unroll
    for (int j = 0; j < 3; ++j) { const int off = 1024 * (wid * 3 + j) + 16 * lane, row = off / 384, cb = off - row * 384, colB = cb ^ (((row >> 1) & 7) << 4), col = colB >> 1; const bool isr = col >= 128;
        const unsigned rb = isr ? (unsigned)(ROPE * 2) : 4096u, cpart = isr ? (unsigned)(WS_KRB + (size_t)(col - 128) * 2) : (unsigned)(WS_KNV + (size_t)(h * 128 + col) * 2);
        k0o[j] = (unsigned)(XM + (row < 16 ? row : 15)) * rb + cpart; k1o[j] = ((unsigned)(b * SEQ + row) * rb + cpart) | (isr ? 1u : 0u); }
#pragma unroll
    for (int j = 0; j < 2; ++j) { const int off = 1024 * (wid * 2 + j) + 16 * lane, sub = off >> 9, within = off & 511, kk = (sub >> 2) * 8 + (within >> 6), k = (kk & ~0xC) | ((kk & 4) << 1) | ((kk & 8) >> 1);
        const unsigned cpart = (unsigned)(WS_KNV + (size_t)(1024 + h * 128 + (sub & 3) * 32 + ((within & 63) >> 1)) * 2);
        v0o[j] = (unsigned)(XM + (k < 16 ? k : 15)) * 4096u + cpart; v1o[j] = (unsigned)(b * SEQ + k) * 4096u + cpart; }
    const GAS unsigned char* wsb = F.ws;
#define KDMA0(bi) do { _Pragma("unroll") for (int j_ = 0; j_ < 3; ++j_) __builtin_amdgcn_global_load_lds((const unsigned*)(wsb + k0o[j_]), (LAS unsigned*)(K_lds + (bi) * SHM_K + (wid * 3 + j_) * 1024), 16, 0, 0); } while (0)
#define VDMA0(bi) do { _Pragma("unroll") for (int j_ = 0; j_ < 2; ++j_) __builtin_amdgcn_global_load_lds((const unsigned*)(wsb + v0o[j_]), (LAS unsigned*)(V_lds + (bi) * SHM_V + (wid * 2 + j_) * 1024), 16, 0, 0); } while (0)
#define KDMA(t, bi) do { _Pragma("unroll") for (int j_ = 0; j_ < 3; ++j_) { const unsigned o_ = (k1o[j_] & ~1u) + (unsigned)((t) - 1) * ((k1o[j_] & 1u) ? 64u * (unsigned)(ROPE * 2) : 64u * 4096u); \
            __builtin_amdgcn_global_load_lds((const unsigned*)(wsb + o_), (LAS unsigned*)(K_lds + (bi) * SHM_K + (wid * 3 + j_) * 1024), 16, 0, 0); } } while (0)
#define VDMA(t, bi) do { _Pragma("unroll") for (int j_ = 0; j_ < 2; ++j_) { const unsigned o_ = v1o[j_] + (unsigned)((t) - 1) * (64u * 4096u); \
            __builtin_amdgcn_global_load_lds((const unsigned*)(wsb + o_), (LAS unsigned*)(V_lds + (bi) * SHM_V + (wid * 2 + j_) * 1024), 16, 0, 0); } } while (0)
    const int vb0 = (int)(unsigned)(uintptr_t)V_lds + v_rd_base(lane);
    const int qlo = qb * 256 + wid * 32, qm = qlo + r32 - 4 * hi;
    KDMA0(0); VDMA0(0); KDMA(1, 1); VDMA(1, 1);
    float m_reg = -1e30f, l_reg = 0.f; f32x16 o[4] = {};
    const float NEG = -__builtin_inff();
    f32x16 pA0, pA1, pB0, pB1; float mnA, mnB, alA, alB; bf16x8 pa0, pa1, pa2, pa3;
#define RESC(a) do { if (__any((a) < 1.f)) { if (hi == 0) al_l[r32] = (a); LDS_WAIT(); \
        _Pragma("unroll") for (int d_ = 0; d_ < 4; ++d_) _Pragma("unroll") for (int r = 0; r < 16; ++r) o[d_][r] *= al_l[crow(r, hi)]; } } while (0)
#define MASKT(P0_, P1_, t_) do { const int kb_ = ((t_) - 1) * 64; if (kb_ + 63 > qlo) { const int dq = qm - kb_; \
        _Pragma("unroll") for (int r = 0; r < 16; ++r) { const int c = (r & 3) + 8 * (r >> 2); if (dq - c < 0) P0_[r] = NEG; if (dq - c - 32 < 0) P1_[r] = NEG; } } } while (0)
    asm volatile("s_waitcnt vmcnt(5)" ::: "memory"); asm volatile("s_waitcnt lgkmcnt(0)" ::: "memory"); __builtin_amdgcn_s_barrier(); asm volatile("" ::: "memory");
    qkt192(pA0, pA1, K_lds, r32, hi, qr, qpe);
#pragma unroll
    for (int r = 0; r < 16; ++r) { const int c = (r & 3) + 8 * (r >> 2) + 4 * hi; if (c >= NMETA) pA0[r] = NEG; pA1[r] = NEG; }
    partialSM(pA0, pA1, m_reg, mnA, alA);
    int vprev = 0, vcur = 1;
#define HALF_STEP(PX0, PX1, mnX, alX, PY0, PY1, alY, t_) do { \
        asm volatile("s_waitcnt vmcnt(2)" ::: "memory"); asm volatile("s_waitcnt lgkmcnt(0)" ::: "memory"); __builtin_amdgcn_s_barrier(); asm volatile("" ::: "memory");     \
        const int vnext_ = vcur == 2 ? 0 : vcur + 1; \
        if ((t_) + 1 < NT) { KDMA((t_) + 1, ((t_) + 1) & 1); VDMA((t_) + 1, vnext_); } \
        qkt192(PX0, PX1, K_lds + ((t_) & 1) * SHM_K, r32, hi, qr, qpe); \
        finishSM(PY0, PY1, alY, l_reg, pa0, pa1, pa2, pa3); __builtin_amdgcn_sched_barrier(0); \
        pv_tile(o, vb0 + vprev * SHM_V, pa0, pa1, pa2, pa3); \
        MASKT(PX0, PX1, t_); partialSM(PX0, PX1, m_reg, mnX, alX); \
        RESC(alX); \
        vprev = vcur; vcur = vnext_; } while (0)
#pragma unroll 1
    for (int t = 1; t + 1 < NT; t += 2) {
        HALF_STEP(pB0, pB1, mnB, alB, pA0, pA1, alA, t);
        HALF_STEP(pA0, pA1, mnA, alA, pB0, pB1, alB, t + 1);
    }
    asm volatile("s_waitcnt vmcnt(0)" ::: "memory"); asm volatile("s_waitcnt lgkmcnt(0)" ::: "memory"); __builtin_amdgcn_s_barrier(); asm volatile("" ::: "memory");
    finishSM(pA0, pA1, alA, l_reg, pa0, pa1, pa2, pa3); __builtin_amdgcn_sched_barrier(0);
    pv_tile(o, vb0 + vprev * SHM_V, pa0, pa1, pa2, pa3);
#undef HALF_STEP
#undef MASKT
#undef RESC
    { int ln = F.lane; asm volatile("" : "+v"(ln));
      const int r32e = ln & 31, hie = ln >> 5; LAS float* li_e = (LAS float*)(F.lds + ATT_WS) + wid * 64;
      if (hie == 0) li_e[r32e] = l_reg; LDS_WAIT();
      bf16* Ow = (bf16*)(F.ws + WS_AO) + (size_t)(b * SEQ + qb * 256 + wid * 32) * DM + h * 128;
#pragma unroll
      for (int r = 0; r < 16; ++r) { const int orow = crow(r, hie); const float rl = __builtin_amdgcn_rcpf(li_e[orow]);
#pragma unroll
          for (int d0 = 0; d0 < 4; ++d0) { const float v = o[d0][r] * rl; const float vn = DPPF(v, 0xB1);
              if ((r32e & 1) == 0) *(unsigned*)(Ow + (size_t)orow * DM + d0 * 32 + r32e) = cvtpk(v, vn); } } }
    __syncthreads();
#undef KDMA
#undef VDMA
#undef KDMA0
#undef VDMA0
}
__device__ __forceinline__ void attn_meta(Frame& F) {
    const bf16* Q = (const bf16*)(F.ws + WS_Q); const bf16* KNV = (const bf16*)(F.ws + WS_KNV); const bf16* KRB = (const bf16*)(F.ws + WS_KRB); bf16* AO = (bf16*)(F.ws + WS_AO);
    for (int it = F.wave; it < NMETA * MH; it += 8) {
        const int m = it >> 3, h = it & 7;
        const bf16* q = Q + (size_t)(XM + m) * 1536 + h * HD;
        const float q0 = bf2f(q[F.lane]), q1 = bf2f(q[64 + F.lane]); float q2;
        { const float* ctab = (const float*)(F.ws + WS_ROPE); const float* stab = ctab + NPOSTAB * 32; const int i = F.lane & 31; const float x = bf2f(q[128 + F.lane]), y = [&]{ auto r_ = __builtin_amdgcn_permlane32_swap(__float_as_uint(x), __float_as_uint(x), false, false); return F.lane < 32 ? __uint_as_float(r_[1]) : __uint_as_float(r_[0]); }(), cs = ctab[m * 32 + i], sn = stab[m * 32 + i];
          q2 = F.lane < 32 ? x * cs - y * sn : x * cs + y * sn; }
        float sc[NMETA]; float mx = -1e30f;
#pragma unroll
        for (int k = 0; k < NMETA; ++k) { const bf16* kn = KNV + (size_t)(XM + k) * 2048 + h * 128; const float d = wave_sum(q0 * bf2f(kn[F.lane]) + q1 * bf2f(kn[64 + F.lane]) + q2 * bf2f(KRB[(size_t)(XM + k) * ROPE + F.lane]));
            sc[k] = k <= m ? d * MLA_SCALE : -1e30f; mx = fmaxf(mx, sc[k]); }
        float l = 0.f, o0 = 0.f, o1 = 0.f;
#pragma unroll
        for (int k = 0; k < NMETA; ++k) { const float p = k <= m ? __expf(sc[k] - mx) : 0.f; l += p; const bf16* v = KNV + (size_t)(XM + k) * 2048 + 1024 + h * 128; o0 += p * bf2f(v[F.lane]); o1 += p * bf2f(v[64 + F.lane]); }
        AO[(size_t)(XM + m) * DM + h * 128 + F.lane] = (bf16)f2bf(o0 / l); AO[(size_t)(XM + m) * DM + h * 128 + 64 + F.lane] = (bf16)f2bf(o1 / l);
    }
}
__device__ __forceinline__ void attn_sample_item(Frame& F, int s) {
    const int tid = F.tid, lane = F.lane, wid = F.wave;
    const bf16* Q = (const bf16*)(F.ws + WS_Q) + (size_t)(XS + s) * 1536;
    LAS float* qn = (LAS float*)F.lds;
    LAS float* qlat = qn + 8 * 192;
    LAS float* qpe = qlat + 8 * 256;
    LAS float* xm = qpe + 8 * 64;
    LAS float* xl = xm + 64;
    LAS float* ssf = xl + 64;
    LAS int* ptl = (LAS int*)(ssf + 64);
    LAS float* xo = (LAS float*)(ptl + 64);
    LAS float* olat = xo + 8 * 8 * 256;
    for (int i = tid; i < 8 * 192; i += 512) qn[i] = bf2f(Q[i]);
    if (tid < NPAGE) ptl[tid] = ((const int*)F.in[I_PT])[s * NPAGE + tid];
    __syncthreads();
    { const float* wuk = F.in[I_WUK] + wid * 128 + lane; const float q0 = qn[wid * 192 + lane], q1 = qn[wid * 192 + 64 + lane];
#pragma unroll 1
      for (int rb = 0; rb < 256; rb += 64) {
          float a[64];
#pragma unroll
          for (int r = 0; r < 64; ++r) { const float* w = wuk + (size_t)(rb + r) * 1024; a[r] = q0 * w[0] + q1 * w[64]; }
#pragma unroll
          for (int i = 0; i < 32; ++i) { auto r_ = __builtin_amdgcn_permlane32_swap(__float_as_uint(a[i]), __float_as_uint(a[i + 32]), false, false); a[i] = __uint_as_float(r_[0]) + __uint_as_float(r_[1]); }
#pragma unroll
          for (int i = 0; i < 16; ++i) { auto r_ = __builtin_amdgcn_permlane16_swap(__float_as_uint(a[i]), __float_as_uint(a[i + 16]), false, false); a[i] = __uint_as_float(r_[0]) + __uint_as_float(r_[1]); }
#define SA_DPP(x, ctrl) __builtin_bit_cast(float, __builtin_amdgcn_update_dpp(0, __builtin_bit_cast(int, (x)), (ctrl), 0xF, 0xF, false))
          { const bool b3 = (lane & 8) != 0, b2 = (lane & 4) != 0, b1 = (lane & 2) != 0, b0 = (lane & 1) != 0;
#pragma unroll
            for (int i = 0; i < 8; ++i) { const float keep = b3 ? a[i + 8] : a[i], send = b3 ? a[i] : a[i + 8]; a[i] = keep + SA_DPP(send, 0x140); }
#pragma unroll
            for (int i = 0; i < 4; ++i) { const float keep = b2 ? a[i + 4] : a[i], send = b2 ? a[i] : a[i + 4]; a[i] = keep + SA_DPP(send, 0x141); }
#pragma unroll
            for (int i = 0; i < 2; ++i) { const float keep = b1 ? a[i + 2] : a[i], send = b1 ? a[i] : a[i + 2]; a[i] = keep + SA_DPP(send, 0x1B); }
            { const float keep = b0 ? a[1] : a[0], send = b0 ? a[0] : a[1]; a[0] = keep + SA_DPP(send, 0xB1); } }
          qlat[wid * 256 + rb + lane] = a[0];
      }
      { const float* ctab = (const float*)(F.ws + WS_ROPE); const float* stab = ctab + NPOSTAB * 32; const int i = lane & 31; const float x1 = qn[wid * 192 + 128 + i], x2 = qn[wid * 192 + 160 + i], cs = ctab[LP * 32 + i], sn = stab[LP * 32 + i];
        qpe[tid] = lane < 32 ? x1 * cs - x2 * sn : x2 * cs + x1 * sn; } }
    __syncthreads();
    const GAS float* cs = F.out + O_SKV + (size_t)s * KVL; const GAS float* krs = F.out + O_SKR + (size_t)s * ROPE;
    { const f32x4 qv = *(const LAS f32x4*)(qlat + wid * 256 + 4 * lane), cv = ((const f32x4*)cs)[lane];
      const float d = wave_sum((qv.x * cv.x + qv.y * cv.y) + (qv.z * cv.z + qv.w * cv.w) + qpe[wid * 64 + lane] * krs[lane]); if (lane == 0) ssf[wid] = d * MLA_SCALE; }
    const int c16 = lane & 15, g = lane >> 4;
    LAS bf16x8* qfl = (LAS bf16x8*)(olat + 8 * 256);
#pragma unroll
    for (int ks = 0; ks < 10; ++ks) { f32x4 a = {0.f, 0.f, 0.f, 0.f}, b = a;
        if (c16 < 8) { const LAS float* qq = ks < 8 ? qlat + c16 * 256 + 32 * ks + 8 * g : qpe + c16 * 64 + 32 * (ks - 8) + 8 * g; a = *(const LAS f32x4*)qq; b = *(const LAS f32x4*)(qq + 4); }
        if (wid == 0) qfl[ks * 64 + lane] = pack8f(a, b); }
    __syncthreads();
    float o[8][4]; float m_run = -1e30f, l_run = 0.f;
#pragma unroll
    for (int h = 0; h < 8; ++h) { o[h][0] = 0.f; o[h][1] = 0.f; o[h][2] = 0.f; o[h][3] = 0.f; }
    const float* ckv = F.in[I_CKV]; const float* ckr = F.in[I_CKR];
    LAS char* vt = (LAS char*)xo + wid * (16 * 528);
    const unsigned lo_t = (unsigned)(c16 * KVL + 8 * g) * 4u, lo_r = (unsigned)(c16 * ROPE + 8 * g) * 4u;
    const char* ckvb = (const char*)ckv; const char* ckrb = (const char*)ckr;
#define SA_LOADT(gi_) do { const unsigned page_ = (unsigned)__builtin_amdgcn_readfirstlane(ptl[wid * 8 + ((gi_) >> 3)]); const unsigned row_ = page_ * (unsigned)PAGE + (unsigned)(((gi_) & 7) * 16); \
        const unsigned ka_ = row_ * (unsigned)(KVL * 4) + lo_t, ra_ = row_ * (unsigned)(ROPE * 4) + lo_r; \
        _Pragma("unroll") for (int ks = 0; ks < 8; ++ks) { t[2 * ks] = *(const f32x4*)(ckvb + (ka_ + 128u * ks)); t[2 * ks + 1] = *(const f32x4*)(ckvb + (ka_ + 128u * ks + 16u)); } \
        t[16] = *(const f32x4*)(ckrb + ra_); t[17] = *(const f32x4*)(ckrb + (ra_ + 16u)); t[18] = *(const f32x4*)(ckrb + (ra_ + 128u)); t[19] = *(const f32x4*)(ckrb + (ra_ + 144u)); } while (0)
    f32x4 t[20];
    SA_LOADT(0);
#pragma unroll 1
    for (int gi = 0; gi < 64; ++gi) {
        bf16x8 kf[10];
#pragma unroll
        for (int ks = 0; ks < 10; ++ks) kf[ks] = pack8f(t[2 * ks], t[2 * ks + 1]);
        __builtin_amdgcn_sched_barrier(0);
        if (gi < 63) SA_LOADT(gi + 1);
        __builtin_amdgcn_sched_barrier(0);
        f32x4 acc = {0.f, 0.f, 0.f, 0.f};
#pragma unroll
        for (int ks = 0; ks < 10; ++ks) acc = mfma16(kf[ks], qfl[ks * 64 + lane], acc);
#pragma unroll
        for (int ks = 0; ks < 8; ++ks) *(LAS bf16x8*)(vt + c16 * 528 + (32 * ks + 8 * g) * 2) = kf[ks];
        float sc[4], mx;
#pragma unroll
        for (int r = 0; r < 4; ++r) sc[r] = acc[r] * MLA_SCALE;
        mx = fmaxf(fmaxf(sc[0], sc[1]), fmaxf(sc[2], sc[3]));
        { auto r_ = __builtin_amdgcn_permlane16_swap(__float_as_uint(mx), __float_as_uint(mx), false, false); mx = fmaxf(__uint_as_float(r_[0]), __uint_as_float(r_[1])); }
        { auto r_ = __builtin_amdgcn_permlane32_swap(__float_as_uint(mx), __float_as_uint(mx), false, false); mx = fmaxf(__uint_as_float(r_[0]), __uint_as_float(r_[1])); }
        const float mnew = fmaxf(m_run, mx), alpha = __expf(m_run - mnew); float pr[4], ps;
#pragma unroll
        for (int r = 0; r < 4; ++r) pr[r] = __expf(sc[r] - mnew);
        ps = (pr[0] + pr[1]) + (pr[2] + pr[3]);
        { auto r_ = __builtin_amdgcn_permlane16_swap(__float_as_uint(ps), __float_as_uint(ps), false, false); ps = __uint_as_float(r_[0]) + __uint_as_float(r_[1]); }
        { auto r_ = __builtin_amdgcn_permlane32_swap(__float_as_uint(ps), __float_as_uint(ps), false, false); ps = __uint_as_float(r_[0]) + __uint_as_float(r_[1]); }
        l_run = l_run * alpha + ps; m_run = mnew;
        LDS_WAIT();
        v2u cw_[16];
#pragma unroll
        for (int k = 0; k < 16; ++k) cw_[k] = *(const LAS v2u*)(vt + k * 528 + lane * 8);
#pragma unroll
        for (int h = 0; h < 8; ++h) { const float ah = __builtin_bit_cast(float, __builtin_amdgcn_readlane(__builtin_bit_cast(int, alpha), h));
            o[h][0] *= ah; o[h][1] *= ah; o[h][2] *= ah; o[h][3] *= ah;
#pragma unroll
            for (int k = 0; k < 16; ++k) { const float pk = __builtin_bit_cast(float, __builtin_amdgcn_readlane(__builtin_bit_cast(int, pr[k & 3]), (k >> 2) * 16 + h));
                o[h][0] += pk * bflo(cw_[k].x); o[h][1] += pk * bfhi(cw_[k].x); o[h][2] += pk * bflo(cw_[k].y); o[h][3] += pk * bfhi(cw_[k].y); } }
    }
#undef SA_LOADT
#undef SA_DPP
    __syncthreads();
    if (lane < 8) { xm[wid * 8 + lane] = m_run; xl[wid * 8 + lane] = l_run; }
#pragma unroll
    for (int h = 0; h < 8; ++h) *(LAS f32x4*)(xo + (size_t)(wid * 8 + h) * 256 + 4 * lane) = (f32x4){o[h][0], o[h][1], o[h][2], o[h][3]};
    __syncthreads();
    for (int e = tid; e < 8 * 256; e += 512) { const int h = e >> 8, r = e & 255; const float ms = ssf[h]; float M = ms;
#pragma unroll
        for (int w = 0; w < 8; ++w) M = fmaxf(M, xm[w * 8 + h]);
        const float es = __expf(ms - M); float acc = es * cs[r], L = es;
#pragma unroll
        for (int w = 0; w < 8; ++w) { const float e_ = __expf(xm[w * 8 + h] - M); acc += xo[(size_t)(w * 8 + h) * 256 + r] * e_; L += xl[w * 8 + h] * e_; }
        olat[e] = acc / L; }
    __syncthreads();
    const float* wuv = F.in[I_WUV]; bf16* AO = (bf16*)(F.ws + WS_AO) + (size_t)(XS + s) * DM;
    for (int e = tid; e < 8 * 128; e += 512) { const int h = e >> 7; const LAS float* ol = olat + h * 256; float acc = 0.f;
#pragma unroll 8
        for (int r = 0; r < 256; ++r) acc += ol[r] * wuv[(size_t)r * 1024 + e];
        AO[e] = (bf16)f2bf(acc); }
    __syncthreads();
}

constexpr int NCHR = NB * 32 * GH, NCH = NCHR + GH;
constexpr int TS = 132;
constexpr int SREC = 57344;
constexpr int SR_W = 0, SR_Q = 16384, SR_AT = 32768, SR_KT = 40960;

struct PrepRaw { v4u x[6]; f32x4 fx[4][2]; float ab_a, ab_b; };
struct PrepW { f32x4 w[4][2]; };
__device__ __forceinline__ void gdn_prep_load(Frame& F, int ch, PrepRaw& R) {
    if (ch >= NCHR) return;
    const int tid = F.tid, h = ch & 7, bc = ch >> 3, b = bc >> 5, c = bc & 31, row0 = b * SEQ + c * 64;
    const bf16* QKVZ = (const bf16*)(F.ws + WS_QKVZ);
#pragma unroll
    for (int k = 0; k < 6; ++k) { const int uu = tid + 512 * k, tok = uu / 48, cg = uu - tok * 48, col0 = cg * 8, gcol = (col0 >> 7) * 1024 + h * 128 + (col0 & 127);
        R.x[k] = *(const v4u*)(QKVZ + (size_t)(row0 + tok) * 4096 + gcol); }
    if (tid < 144) { const int tok = tid / 48, cg = tid - tok * 48, col0 = cg * 8, gcol = (col0 >> 7) * 1024 + h * 128 + (col0 & 127), grp = b * 32 + c; const float* RAWQ = (const float*)(F.ws + WS_RAWQ);
#pragma unroll
        for (int j = 0; j < 4; ++j) { const int r = tok - 3 + j;
            if (r >= 0 || c > 0) { const float* p = RAWQ + ((size_t)(r >= 0 ? grp : grp - 1) * 6 + (r >= 0 ? r : 6 + r)) * GQKV + gcol; R.fx[j][0] = *(const f32x4*)p; R.fx[j][1] = *(const f32x4*)(p + 4); }
            else { const v4u q = *(const v4u*)(QKVZ + (size_t)(XM + NMETA + r) * 4096 + gcol); R.fx[j][0] = (f32x4){bflo(q.x), bfhi(q.x), bflo(q.y), bfhi(q.y)}; R.fx[j][1] = (f32x4){bflo(q.z), bfhi(q.z), bflo(q.w), bfhi(q.w)}; } } }
    if (F.wave == 7) { const float* AB = (const float*)(F.ws + WS_AB); R.ab_a = AB[(size_t)(row0 + F.lane) * 16 + h]; R.ab_b = AB[(size_t)(row0 + F.lane) * 16 + 8 + h]; }
}
__device__ __forceinline__ void gdn_prep_item(Frame& F, int ch, PrepRaw& R, int next_ch, const float* cwbase, float Ah, float dtb, const PrepW& W) {
    asm volatile("" : "+v"(F.tid), "+v"(F.lane));
    const int tid = F.tid, lane = F.lane, wave = F.wave;
    const bool meta = ch >= NCHR; const int h = ch & 7, bc = ch >> 3, b = bc >> 5, c = bc & 31;
    const int row0 = meta ? XM : b * SEQ + c * 64;
    LAS float* qf = (LAS float*)F.lds; LAS float* kf = qf + 64 * TS; LAS float* vf = kf + 64 * TS; LAS float* gcs = vf + 64 * TS; LAS float* bes = gcs + 64;
    GAS unsigned char* srec = F.ws + WS_SREC + (size_t)ch * SREC;
    const bf16* QKVZ = (const bf16*)(F.ws + WS_QKVZ);
    if (!meta) {
#pragma unroll
        for (int k = 0; k < 6; ++k) { const int uu = tid + 512 * k, tok = uu / 48, cg = uu - tok * 48, col0 = cg * 8, part = col0 >> 7, cc = col0 & 127;
            if (k == 0 && tid < 144) continue;
            const v4u q = R.x[k]; LAS float* tile = (part == 0 ? qf : (part == 1 ? kf : vf)) + tok * TS + cc;
            *(LAS f32x4*)tile = (f32x4){bflo(q.x), bfhi(q.x), bflo(q.y), bfhi(q.y)}; *(LAS f32x4*)(tile + 4) = (f32x4){bflo(q.z), bfhi(q.z), bflo(q.w), bfhi(q.w)}; }
        if (tid < 144) { const int tok = tid / 48, cg = tid - tok * 48, col0 = cg * 8, part = col0 >> 7, cc = col0 & 127;
            float acc8[8];
#pragma unroll
            for (int e = 0; e < 8; ++e) acc8[e] = 0.f;
#pragma unroll
            for (int j = 0; j < 4; ++j) { const float wj[8] = {W.w[j][0].x, W.w[j][0].y, W.w[j][0].z, W.w[j][0].w, W.w[j][1].x, W.w[j][1].y, W.w[j][1].z, W.w[j][1].w};
                const float xr[8] = {R.fx[j][0].x, R.fx[j][0].y, R.fx[j][0].z, R.fx[j][0].w, R.fx[j][1].x, R.fx[j][1].y, R.fx[j][1].z, R.fx[j][1].w};
#pragma unroll
                for (int e = 0; e < 8; ++e) acc8[e] += wj[e] * xr[e]; }
            LAS float* tile = (part == 0 ? qf : (part == 1 ? kf : vf)) + tok * TS + cc;
            *(LAS f32x4*)tile = (f32x4){siluf(acc8[0]), siluf(acc8[1]), siluf(acc8[2]), siluf(acc8[3])}; *(LAS f32x4*)(tile + 4) = (f32x4){siluf(acc8[4]), siluf(acc8[5]), siluf(acc8[6]), siluf(acc8[7])}; }
    } else if (tid < 384) {
        const int cg = tid % 48, tg = tid / 48, col0 = cg * 8, part = col0 >> 7, cc = col0 & 127, gcol = part * 1024 + h * 128 + cc;
        const float* cw = cwbase + gcol;
        float w[4][8];
#pragma unroll
        for (int j = 0; j < 4; ++j) ld8f(cw + j * GQKV, w[j]);
        float x[11][8];
#pragma unroll
        for (int r = 0; r < 11; ++r) { const int tt = 8 * tg - 3 + r; const bool ok = tt >= 0 && tt < NMETA; const float m_ = ok ? 1.f : 0.f;
            ld8(QKVZ + (size_t)(ok ? XM + tt : XM) * 4096 + gcol, x[r]);
#pragma unroll
            for (int e = 0; e < 8; ++e) x[r][e] *= m_; }
        LAS float* tile = part == 0 ? qf : (part == 1 ? kf : vf);
#pragma unroll
        for (int t = 0; t < 8; ++t) { const int tok = 8 * tg + t; float o[8];
#pragma unroll
            for (int e = 0; e < 8; ++e) { const float a = (w[0][e] * x[t][e] + w[1][e] * x[t + 1][e]) + (w[2][e] * x[t + 2][e] + w[3][e] * x[t + 3][e]); o[e] = tok >= NMETA ? 0.f : siluf(a); }
            *(LAS f32x4*)(tile + tok * TS + cc) = (f32x4){o[0], o[1], o[2], o[3]}; *(LAS f32x4*)(tile + tok * TS + cc + 4) = (f32x4){o[4], o[5], o[6], o[7]}; }
    }
    const float ab_a = R.ab_a, ab_b = R.ab_b;
    asm volatile("" ::: "memory"); gdn_prep_load(F, next_ch, R);
    if (wave == 7) {
        const bool nul = meta && lane >= NMETA; float a = ab_a, bb = ab_b;
        if (meta) { const float* AB = (const float*)(F.ws + WS_AB); const int row = nul ? XM : row0 + lane; a = AB[(size_t)row * 16 + h]; bb = AB[(size_t)row * 16 + 8 + h]; }
        const float x = a + dtb, sp = x > 20.f ? x : log1pf(__expf(x)); float g = nul ? 0.f : -Ah * sp;
#pragma unroll
        for (int o = 1; o < 64; o <<= 1) { const float t = __shfl_up(g, o); if (lane >= o) g += t; }
        gcs[lane] = g; bes[lane] = nul ? 0.f : 1.f / (1.f + __expf(-bb));
    }
    __syncthreads();
#ifndef PR2
#define PR2 1
#define PR3 1
#define PR4 1
#endif
    _Pragma("unroll 1") for (int pr2 = 0; pr2 < PR2; ++pr2)
#pragma unroll 8
    for (int v = wave * 16; v < wave * 16 + 16; ++v) { const int tok = v >> 1, isk = v & 1; LAS float* p = (isk ? kf : qf) + tok * TS; const float x0 = p[lane], x1 = p[lane + 64];
        const float ss = wave_sum(x0 * x0 + x1 * x1); const float r = rsqrtf(ss + EPS) * (isk ? 1.f : 0.08838834764831845f); p[lane] = x0 * r; p[lane + 64] = x1 * r; }
    __syncthreads();
    const int r16 = lane & 15, g = lane >> 4;
#pragma unroll 2
    for (int jj = wave; jj < 32 * PR3; jj += 8) {
        const bool isA = (jj & 31) < 16; const int ta = (jj >> 2) & 3, tb = jj & 3;
        const bool live = isA ? (tb <= ta) : (tb >= ta);
        f32x4 acc = {0.f, 0.f, 0.f, 0.f};
        if (live) {
            const LAS float* pa = kf + (16 * ta + r16) * TS + 8 * g; const LAS float* pb = (isA ? kf : qf) + (16 * tb + r16) * TS + 8 * g;
#pragma unroll
            for (int ks = 0; ks < 4; ++ks) { const bf16x8 fa = pack8f(*(const LAS f32x4*)(pa + 32 * ks), *(const LAS f32x4*)(pa + 32 * ks + 4)), fb = pack8f(*(const LAS f32x4*)(pb + 32 * ks), *(const LAS f32x4*)(pb + 32 * ks + 4));
                acc = mfma16(fa, fb, acc); }
        }
        if (isA) { if (live) { float* GA = (float*)(F.ws + WS_GA) + (size_t)ch * 4096; const int j = 16 * tb + r16; const float gj = gcs[j];
#pragma unroll
                for (int r = 0; r < 4; ++r) { const int i = 16 * ta + 4 * g + r; GA[i * 64 + j] = i > j ? bes[i] * __expf(gcs[i] - gj) * acc[r] : 0.f; } } }
        else { const int i = 16 * tb + r16; const float gi = gcs[i]; float v[4];
#pragma unroll
            for (int r = 0; r < 4; ++r) { const int j = 16 * ta + 4 * g + r; v[r] = (live && i >= j) ? __expf(gi - gcs[j]) * acc[r] : 0.f; }
            *(v2u*)(srec + SR_AT + ((tb * 2 + (ta >> 1)) * 64 + lane) * 16 + 8 * (ta & 1)) = (v2u){cvtpk(v[0], v[1]), cvtpk(v[2], v[3])}; }
    }
    const float glast = gcs[63];
#pragma unroll 4
    for (int q_ = 0; q_ < 8 * PR4; ++q_) { const int q = q_ & 7;
        const int which = q >> 1, f = (q & 1) * 8 + wave; float v[8];
        if (which == 0) { const int t = f >> 2, ks = f & 3, tok = 16 * t + r16; const float sc = __expf(gcs[tok]); const LAS float* p = qf + tok * TS + 32 * ks + 4 * g;
            const f32x4 a = *(const LAS f32x4*)p, bq = *(const LAS f32x4*)(p + 16);
            *(bf16x8*)(srec + SR_Q + (f * 64 + lane) * 16) = pack8f(a * sc, bq * sc); }
        else if (which == 1) { const int mt = f >> 1, ks = f & 1, dk = 16 * mt + r16;
#pragma unroll
            for (int e = 0; e < 8; ++e) { const int tok = 32 * ks + 16 * (e >> 2) + 4 * g + (e & 3); v[e] = kf[tok * TS + dk] * __expf(glast - gcs[tok]); }
            *(bf16x8*)(srec + SR_KT + (f * 64 + lane) * 16) = pack8f((f32x4){v[0], v[1], v[2], v[3]}, (f32x4){v[4], v[5], v[6], v[7]}); }
        else { const int nt = f >> 1, ks = f & 1, col = 16 * nt + r16; const LAS float* tile = which == 2 ? vf : kf;
#pragma unroll
            for (int e = 0; e < 8; ++e) { const int tok = 32 * ks + 8 * g + e; v[e] = tile[tok * TS + col] * bes[tok] * (which == 2 ? 1.f : __expf(gcs[tok])); }
            *(bf16x8*)(F.ws + (which == 2 ? WS_GRV : WS_GRK) + (size_t)ch * 16384 + (f * 64 + lane) * 16) = pack8f((f32x4){v[0], v[1], v[2], v[3]}, (f32x4){v[4], v[5], v[6], v[7]}); }
    }
    if (tid == 0) ((float*)(F.ws + WS_GEG))[ch] = __expf(glast);
    __syncthreads();
}

template <bool META> __device__ __forceinline__ void gdn_solve_item(Frame& F, int ch) {
    const int lane = F.lane, r16 = lane & 15, g = lane >> 4;
    LAS float* As = (LAS float*)F.lds + F.wave * 4096;
    { const f32x4* ga = (const f32x4*)((const float*)(F.ws + WS_GA) + (size_t)ch * 4096); f32x4 gr[16];
#pragma unroll
      for (int it = 0; it < 16; ++it) { const int e = it * 64 + lane; gr[it] = ga[((e & 15) < ((e >> 8) + 1) * 4) ? e : lane]; }
#pragma unroll
      for (int it = 0; it < 16; ++it) ((LAS f32x4*)As)[it * 64 + lane] = gr[it]; }
    LDS_WAIT();
    float x[64];
    x[0] = (lane == 0) ? 1.f : 0.f;
#pragma unroll
    for (int i = NMETA; i < 64; ++i) x[i] = (lane == i) ? 1.f : 0.f;
#pragma unroll
    for (int i = 1; i < (META ? NMETA : 64); ++i) {
        f32x4 av[16];
#pragma unroll
        for (int j4 = 0; j4 < (i + 3) / 4; ++j4) av[j4] = *(const LAS f32x4*)(As + i * 64 + 4 * j4);
        __builtin_amdgcn_sched_barrier(0);
        float a0 = (lane == i) ? 1.f : 0.f, a1 = 0.f, a2 = 0.f, a3 = 0.f;
#pragma unroll
        for (int j4 = 0; j4 < (i + 3) / 4; ++j4) {
            if (4 * j4 + 0 < i) a0 -= av[j4].x * x[4 * j4 + 0]; if (4 * j4 + 1 < i) a1 -= av[j4].y * x[4 * j4 + 1]; if (4 * j4 + 2 < i) a2 -= av[j4].z * x[4 * j4 + 2]; if (4 * j4 + 3 < i) a3 -= av[j4].w * x[4 * j4 + 3]; }
        x[i] = (a0 + a1) + (a2 + a3);
        __builtin_amdgcn_sched_barrier(0);
    }
    LDS_WAIT();
#pragma unroll
    for (int i = 0; i < 64; ++i) As[i * 64 + lane] = x[i];
    LDS_WAIT();
    bf16x8 Tf[4][2];
#pragma unroll
    for (int t = 0; t < 4; ++t)
#pragma unroll
        for (int ks = 0; ks < 2; ++ks) { const LAS float* p = As + (16 * t + r16) * 64 + 32 * ks + 8 * g; Tf[t][ks] = pack8f(*(const LAS f32x4*)p, *(const LAS f32x4*)(p + 4)); }
    const GAS unsigned char* grv = F.ws + WS_GRV + (size_t)ch * 16384; const GAS unsigned char* grk = F.ws + WS_GRK + (size_t)ch * 16384;
    GAS unsigned char* gu = F.ws + WS_GU + (size_t)ch * 16384; GAS unsigned char* gw = F.ws + WS_SREC + (size_t)ch * SREC + SR_W;
#pragma unroll 4
    for (int nt = 0; nt < 8; ++nt) { const bf16x8 b0 = *(const bf16x8*)(grv + ((nt * 2) * 64 + lane) * 16), b1 = *(const bf16x8*)(grv + ((nt * 2 + 1) * 64 + lane) * 16);
#pragma unroll
        for (int t = 0; t < 4; ++t) { f32x4 acc = {0.f, 0.f, 0.f, 0.f}; acc = mfma16(Tf[t][0], b0, acc); acc = mfma16(Tf[t][1], b1, acc);
            *(v2u*)(gu + ((nt * 4 + t) * 64 + lane) * 8) = (v2u){cvtpk(acc[0], acc[1]), cvtpk(acc[2], acc[3])}; } }
#pragma unroll 4
    for (int mt = 0; mt < 8; ++mt) { const bf16x8 a0 = *(const bf16x8*)(grk + ((mt * 2) * 64 + lane) * 16), a1 = *(const bf16x8*)(grk + ((mt * 2 + 1) * 64 + lane) * 16);
#pragma unroll
        for (int t = 0; t < 4; ++t) { f32x4 acc = {0.f, 0.f, 0.f, 0.f}; acc = mfma16(a0, Tf[t][0], acc); acc = mfma16(a1, Tf[t][1], acc);
            *(v2u*)(gw + ((t * 4 + (mt >> 1)) * 64 + lane) * 16 + 8 * (mt & 1)) = (v2u){cvtpk(-acc[0], -acc[1]), cvtpk(-acc[2], -acc[3])}; } }
}

__device__ __forceinline__ void gdn_scan_item(Frame& F, int item) {
    const int lane = F.lane, wave = F.wave, g = lane >> 4, c16 = lane & 15;
    const int half = item & 1, h = (item >> 1) & 7, b = item >> 4;
    const bool comp = wave < 4; const int cs0 = half * 64 + (wave & 3) * 16, ntu = cs0 >> 4;
    bf16* OB = (bf16*)(F.ws + WS_TMP); const float* GEG = (const float*)(F.ws + WS_GEG);
    LAS unsigned char* lds = F.lds;
#define SCAN_CH(n) ((n) == 0 ? NCHR + h : (b * 32 + (n) - 1) * 8 + h)
#define SCAN_DMA(n) do { const GAS unsigned char* src_ = F.ws + WS_SREC + (size_t)SCAN_CH(n) * SREC + lane * 16; LAS unsigned char* dst_ = lds + ((n) & 1) * SREC; \
        _Pragma("unroll") for (int i_ = 0; i_ < 7; ++i_) { const int p_ = i_ * 8 + wave; __builtin_amdgcn_global_load_lds((const unsigned*)(src_ + p_ * 1024), (LAS unsigned*)(dst_ + p_ * 1024), 16, 0, 0); } } while (0)
#define SCAN_U(n, dst) do { const GAS unsigned char* gu_ = F.ws + WS_GU + (size_t)SCAN_CH(n) * 16384; _Pragma("unroll") for (int t_ = 0; t_ < 4; ++t_) dst[t_] = *(const v2u*)(gu_ + ((ntu * 4 + t_) * 64 + lane) * 8); } while (0)
    f32x4 S[8];
#pragma unroll
    for (int m = 0; m < 8; ++m) S[m] = (f32x4){0.f, 0.f, 0.f, 0.f};
    v2u un[4] = {};
    SCAN_DMA(0); if (comp) SCAN_U(0, un);
#pragma unroll 1
    for (int n = 0; n <= 32; ++n) {
        VM_WAIT(); __syncthreads();
        v2u uc[4];
#pragma unroll
        for (int t = 0; t < 4; ++t) uc[t] = un[t];
        if (n < 32) { SCAN_DMA(n + 1); if (comp) SCAN_U(n + 1, un); }
        if (comp) {
            const LAS unsigned char* buf = lds + (n & 1) * SREC + lane * 16;
            const float eg = GEG[SCAN_CH(n)];
            bf16x8 Sb[4];
#pragma unroll
            for (int ks = 0; ks < 4; ++ks) Sb[ks] = pack8f(S[2 * ks], S[2 * ks + 1]);
            f32x4 av[4], ao[4];
#pragma unroll
            for (int t = 0; t < 4; ++t) { av[t] = (f32x4){bflo(uc[t].x), bfhi(uc[t].x), bflo(uc[t].y), bfhi(uc[t].y)}; ao[t] = (f32x4){0.f, 0.f, 0.f, 0.f}; }
#pragma unroll
            for (int t = 0; t < 4; ++t)
#pragma unroll
                for (int ks = 0; ks < 4; ++ks) { av[t] = mfma16(*(const LAS bf16x8*)(buf + SR_W + (t * 4 + ks) * 1024), Sb[ks], av[t]); ao[t] = mfma16(*(const LAS bf16x8*)(buf + SR_Q + (t * 4 + ks) * 1024), Sb[ks], ao[t]); }
            bf16x8 vb[2];
#pragma unroll
            for (int k = 0; k < 2; ++k) vb[k] = pack8f(av[2 * k], av[2 * k + 1]);
#pragma unroll
            for (int t = 0; t < 4; ++t)
#pragma unroll
                for (int k = 0; k < 2; ++k) if (32 * k <= 16 * t + 15) ao[t] = mfma16(*(const LAS bf16x8*)(buf + SR_AT + (t * 2 + k) * 1024), vb[k], ao[t]);
            if (n == 0) { if (b == 0) {
#pragma unroll
                    for (int r = 0; r < 4; ++r) { const float v = ao[0][r], vn = DPPF(v, 0xB1); if ((c16 & 1) == 0) *(unsigned*)(OB + (size_t)(XM + 4 * g + r) * DM + h * 128 + cs0 + c16) = cvtpk(v, vn); } } }
            else { bf16* op = OB + (size_t)(b * SEQ + (n - 1) * 64 + 4 * g) * DM + h * 128 + cs0 + c16;
#pragma unroll
                for (int t = 0; t < 4; ++t)
#pragma unroll
                    for (int r = 0; r < 4; ++r) { const float v = ao[t][r], vn = DPPF(v, 0xB1); if ((c16 & 1) == 0) *(unsigned*)(op + (size_t)(16 * t + r) * DM) = cvtpk(v, vn); } }
#pragma unroll
            for (int m = 0; m < 8; ++m) { S[m] = S[m] * eg;
#pragma unroll
                for (int k = 0; k < 2; ++k) S[m] = mfma16(*(const LAS bf16x8*)(buf + SR_KT + (m * 2 + k) * 1024), vb[k], S[m]); }
        }
    }
    if (comp) { GAS float* so = F.out + O_PDS + ((size_t)(b * GH + h) * GDK + 4 * g) * GDV + cs0 + c16;
#pragma unroll
        for (int m = 0; m < 8; ++m)
#pragma unroll
            for (int r = 0; r < 4; ++r) so[(size_t)(16 * m + r) * GDV] = S[m][r]; }
    __syncthreads();
#undef SCAN_CH
#undef SCAN_DMA
#undef SCAN_U
}

template <bool OUT_BF16> __device__ __forceinline__ void mini_gemm(Frame& F, const bf16* A, const bf16* Bt, int N, int K, void* out, int ldo) {
    const int lane = F.lane, c16 = lane & 15, g = lane >> 4, gw = F.wave * F.G + F.bid, NGW = F.G * 8;
    const int nct = N / 16;
#pragma unroll 1
    for (int task = gw; task < nct * 3; task += NGW) {
        const int ct = task % nct, rg = task / nct;
        const bf16* b0 = Bt + (size_t)(16 * ct + c16) * K + 8 * g; const bf16* a0 = A + (size_t)(TR + 48 * rg + c16) * K + 8 * g;
        f32x4 acc[3];
#pragma unroll
        for (int rt = 0; rt < 3; ++rt) acc[rt] = (f32x4){0.f, 0.f, 0.f, 0.f};
#define MG_LOAD(BF, AF, kk) do { _Pragma("unroll") for (int q = 0; q < 4; ++q) { BF[q] = *(const bf16x8*)(b0 + (kk) + 32 * q); \
            _Pragma("unroll") for (int rt = 0; rt < 3; ++rt) AF[q][rt] = *(const bf16x8*)(a0 + (size_t)(16 * rt) * K + (kk) + 32 * q); } } while (0)
#define MG_MMA(BF, AF) do { _Pragma("unroll") for (int q = 0; q < 4; ++q) { _Pragma("unroll") for (int rt = 0; rt < 3; ++rt) acc[rt] = mfma16(BF[q], AF[q][rt], acc[rt]); } } while (0)
        bf16x8 bfA[4], afA[4][3], bfB[4], afB[4][3];
        MG_LOAD(bfA, afA, 0);
#pragma unroll 1
        for (int k = 0; k < K; k += 256) {
            const bool hasB = k + 128 < K, hasA2 = k + 256 < K;
            if (hasB) MG_LOAD(bfB, afB, k + 128);
            __builtin_amdgcn_sched_barrier(0);
            MG_MMA(bfA, afA);
            __builtin_amdgcn_sched_barrier(0);
            if (hasA2) MG_LOAD(bfA, afA, k + 256);
            __builtin_amdgcn_sched_barrier(0);
            if (hasB) MG_MMA(bfB, afB);
            __builtin_amdgcn_sched_barrier(0);
        }
#undef MG_LOAD
#undef MG_MMA
#pragma unroll
        for (int rt = 0; rt < 3; ++rt) { const size_t o = (size_t)(48 * rg + 16 * rt + c16) * ldo + 16 * ct + 4 * g;
            if (OUT_BF16) *(v2u*)((bf16*)out + o) = (v2u){cvtpk(acc[rt][0], acc[rt][1]), cvtpk(acc[rt][2], acc[rt][3])};
            else *(f32x4*)((float*)out + o) = acc[rt]; }
    }
}

template <bool OUT_BF16> __device__ __forceinline__ void mini_gemm_deep(Frame& F, const bf16* A, const bf16* Bt, int N, int K, void* out, int ldo) {
    const int lane = F.lane, c16 = lane & 15, g = lane >> 4, gw = F.wave * F.G + F.bid, NGW = F.G * 8;
    const int nct = N / 16, nb = K / 128;
#pragma unroll 1
    for (int task = gw; task < nct * 9; task += NGW) {
        const int ct = task % nct, rt9 = task / nct;
        const bf16* b0 = Bt + (size_t)(16 * ct + c16) * K + 8 * g; const bf16* a0 = A + (size_t)(TR + 16 * rt9 + c16) * K + 8 * g;
        f32x4 acc = {0.f, 0.f, 0.f, 0.f};
        bf16x8 bq[4][4], aq[4][4];
#define MD_LOAD(i, kk) do { _Pragma("unroll") for (int q = 0; q < 4; ++q) { bq[i][q] = *(const bf16x8*)(b0 + (kk) + 32 * q); aq[i][q] = *(const bf16x8*)(a0 + (kk) + 32 * q); } } while (0)
#pragma unroll
        for (int i = 0; i < 4; ++i) MD_LOAD(i, 128 * i);
#pragma unroll 1
        for (int kb = 0; kb < nb; kb += 4) {
#pragma unroll
            for (int i = 0; i < 4; ++i) {
                if (kb + i < nb) {
#pragma unroll
                    for (int q = 0; q < 4; ++q) acc = mfma16(bq[i][q], aq[i][q], acc);
                    __builtin_amdgcn_sched_barrier(0);
                    if (kb + i + 4 < nb) MD_LOAD(i, 128 * (kb + i + 4));
                    __builtin_amdgcn_sched_barrier(0);
                }
            }
        }
#undef MD_LOAD
        const size_t o = (size_t)(16 * rt9 + c16) * ldo + 16 * ct + 4 * g;
        if (OUT_BF16) *(v2u*)((bf16*)out + o) = (v2u){cvtpk(acc[0], acc[1]), cvtpk(acc[2], acc[3])};
        else *(f32x4*)((float*)out + o) = acc;
    }
}

constexpr int NPHASE = 24;
__global__ void __launch_bounds__(512, 2) mk_fwd(Params P) {
    extern __shared__ __attribute__((aligned(16))) unsigned char lds_raw[];
    Frame F;
    F.lds = (LAS unsigned char*)lds_raw; F.tid = threadIdx.x; F.lane = F.tid & 63; F.wave = __builtin_amdgcn_readfirstlane(F.tid >> 6);
    F.G = gridDim.x; F.bid = blockIdx.x; F.in.t = (const LAS unsigned*)(F.lds + INTAB_OFF); F.out = (GAS float*)P.out; F.ws = (GAS unsigned char*)P.ws;
    volatile LAS unsigned* MISC = (volatile LAS unsigned*)(F.lds + MISC_OFF);
    for (int u = F.tid; u < (LDS_BYTES - CTLLDS_OFF) / 4; u += 512) ((LAS unsigned*)(F.lds + CTLLDS_OFF))[u] = 0u;
    __syncthreads();
    if (F.tid == 0) { LAS unsigned long long* tab = (LAS unsigned long long*)(F.lds + INTAB_OFF);
#pragma unroll
        for (int i = 0; i < N_IN; ++i) tab[i] = (unsigned long long)P.in[i]; }
    __syncthreads();
    const int lo = P.ph_lo, hi = P.ph_hi;
    XcdBarrier bar; bar.bar = (unsigned*)(P.ws + WS_CTL) + CW_BAR; bar.x = 0; bar.st = nullptr;
    if (hi - lo > 1) bar = xcd_barrier_post((unsigned*)(P.ws + WS_CTL) + CW_BAR, MISC + 8);
#ifndef REP_MASK
#define REP_MASK 0
#endif
#define REPN(k) ((((REP_MASK) >> (k)) & 1) + 1)
#define REP1(k) _Pragma("unroll 1") for (int r1_ = 0; r1_ < (((REP_MASK) >> (k)) & 1) + 1; ++r1_)
#define REP(k) _Pragma("unroll") for (int r_ = 0; r_ < (((REP_MASK) >> (k)) & 1) + 1; ++r_)
#define IN(k) (lo <= (k) && (k) < hi)
#define SEAM(k) do { if (IN(k) && IN((k) + 1)) { XcdBarrier b_; b_.bar = (unsigned*)(F.ws + WS_CTL) + CW_BAR; b_.x = bar.x; b_.st = (volatile LAS unsigned*)(F.lds + MISC_OFF) + 8; xcd_barrier(b_); } asm volatile("" : "+v"(F.tid), "+v"(F.lane)); asm volatile("" : "+s"(F.ws), "+s"(F.out)); ws = F.ws; } while (0)
    GAS unsigned char* ws = F.ws;
#define XH ((bf16*)(ws + WS_XH))
#define TMP ((float*)(ws + WS_TMP))

    if (IN(0)) REP(0) { p0_prologue(F, P); } SEAM(0);
    if (IN(1)) { pg8::Gemm g{XH, (const bf16*)(ws + WS_WIN), TR, 4096, DM}; pg8::StaticOrder S; S.init(TR, 4096, F.G, F.bid, REPN(1)); pg8::EpiInConv E{(bf16*)(ws + WS_QKVZ), (float*)(ws + WS_RAWQ), F.in[I_ACONV]};
        _Pragma("unroll 1") for (int pass_ = 0; pass_ < 2; ++pass_) { asm volatile("" : "+v"(F.tid), "+v"(F.lane));
            if (pass_ == ((F.bid >> 3) & 1)) pg8::gemm_phase<pg8::EpiInConv, pg8::StaticOrder, true, true>(F.lds, g, S, E);
            else mini_gemm<true>(F, XH, (const bf16*)(ws + WS_WIN), 4096, DM, (bf16*)(ws + WS_QKVZ) + (size_t)TR * 4096, 4096); } } SEAM(1);
    if (IN(2)) {
        REP1(2) { PrepRaw R; gdn_prep_load(F, F.bid, R); const int h_ = F.bid & 7; const float* cwbase = F.in[I_ACONV]; const float Ah = __expf(F.in[I_ALOG][h_]), dtb = F.in[I_ADT][h_];
          PrepW W; { const int t_ = F.tid < 144 ? F.tid : 0, cg = t_ % 48, col0 = cg * 8, gcol = (col0 >> 7) * 1024 + h_ * 128 + (col0 & 127);
#pragma unroll
            for (int j = 0; j < 4; ++j) { W.w[j][0] = *(const f32x4*)(cwbase + j * GQKV + gcol); W.w[j][1] = *(const f32x4*)(cwbase + j * GQKV + gcol + 4); } }
#pragma unroll 1
          for (int ch = F.bid; ch < NCH; ch += F.G) gdn_prep_item(F, ch, R, ch + F.G < NCH ? ch + F.G : ch, cwbase, Ah, dtb, W); }
        REP1(25)
#pragma unroll 1
        for (int it = F.bid; it < NS * GH; it += F.G) gdn_item(F, NB * GH + it); } SEAM(2);
    if (IN(3)) REP(3) {
#pragma unroll 1
        for (int ch = F.bid * 8 + F.wave; ch < NCHR; ch += F.G * 8) gdn_solve_item<false>(F, ch);
        { const int mw = (F.G - 1 - F.bid) * 8 + F.wave; if (mw < GH) gdn_solve_item<true>(F, NCHR + mw); } } SEAM(3);
    if (IN(4)) REP(4) {
#pragma unroll 1
        for (int it_ = F.bid; it_ < NB * GH * 2; it_ += F.G) { const int it = (F.G == 256) ? ((((it_ & 7) + 8 * (it_ >> 4)) << 1) | ((it_ >> 3) & 1)) : it_; gdn_scan_item(F, it); } } SEAM(4);
    if (IN(5)) REP(5) { p3_gate(F); } SEAM(5);
    if (IN(6)) { pg8::Gemm g{(const bf16*)(ws + WS_GO), (const bf16*)(ws + WS_WGOUT), TR, DM, DM}; pg8::StaticOrder S; S.init(TR, DM, F.G, F.bid, REPN(6)); pg8::EpiBf16 E{(bf16*)TMP, DM};
        pg8::gemm_phase<pg8::EpiBf16, pg8::StaticOrder, true, true>(F.lds, g, S, E);
        mini_gemm_deep<true>(F, (const bf16*)(ws + WS_GO), (const bf16*)(ws + WS_WGOUT), DM, DM, (bf16*)TMP + (size_t)TR * DM, DM); } SEAM(6);
    if (IN(7)) { p_postnorm<false, true>(F, F.in[I_ANPOST]); } SEAM(7);
    if (IN(8)) { pg8::Gemm g{XH, (const bf16*)(ws + WS_WUP0), TR, FF2, DM}; pg8::StaticOrder S; S.init(TR, FF2, F.G, F.bid, REPN(8)); pg8::EpiFfnAct E{(bf16*)(ws + WS_ACT), (float*)(ws + WS_RAWH), (float*)(ws + WS_RAWX), F.in[I_FCONVW] + (size_t)0 * 3 * FF2, F.in[I_FCONVB] + (size_t)0 * FF2, TR / 256};
        _Pragma("unroll 1") for (int pass_ = 0; pass_ < 2; ++pass_) { asm volatile("" : "+v"(F.tid), "+v"(F.lane));
            if (pass_ == ((F.bid >> 3) & 1)) pg8::gemm_phase<pg8::EpiFfnAct, pg8::StaticOrder, true, true>(F.lds, g, S, E);
            else mini_gemm<false>(F, XH, (const bf16*)(ws + WS_WUP0), FF2, DM, (float*)(ws + WS_RAWX), FF2); } } SEAM(8);
    if (IN(9)) REP(9) { p_ffn_fix(F, 0); } SEAM(9);
    if (IN(10)) { pg8::Gemm g{(const bf16*)(ws + WS_ACT), (const bf16*)(ws + WS_WDN0), TR, DM, FF}; pg8::StaticOrder S; S.init(TR, DM, F.G, F.bid, REPN(10)); pg8::EpiBf16 E{(bf16*)TMP, DM};
        pg8::gemm_phase<pg8::EpiBf16, pg8::StaticOrder, true, true>(F.lds, g, S, E);
        mini_gemm_deep<true>(F, (const bf16*)(ws + WS_ACT), (const bf16*)(ws + WS_WDN0), DM, FF, (bf16*)TMP + (size_t)TR * DM, DM); } SEAM(10);
    if (IN(11)) { p_postnorm<false>(F, F.in[I_FNPOST]); } SEAM(11);
    if (IN(12)) { pg8::Gemm g{XH, (const bf16*)(ws + WS_WKVQA), TR, 768, DM}; pg8::StaticOrder S; S.init(TR, 768, F.G, F.bid, REPN(12)); pg8::EpiBf16 E{(bf16*)(ws + WS_CKVQ), 768};
        pg8::gemm_phase<pg8::EpiBf16, pg8::StaticOrder, true, true>(F.lds, g, S, E);
        mini_gemm_deep<true>(F, XH, (const bf16*)(ws + WS_WKVQA), 768, DM, (bf16*)(ws + WS_CKVQ) + (size_t)TR * 768, 768); } SEAM(12);
    if (IN(13)) REP(13) { p_kvq(F); } SEAM(13);
    if (IN(14)) {
        { pg8::Gemm g{(const bf16*)(ws + WS_QAN), (const bf16*)(ws + WS_WQB), TR, 1536, QL}; pg8::StaticOrder S; S.init(TR, 1536, F.G, F.bid, REPN(14)); pg8::EpiBf16 E{(bf16*)(ws + WS_Q), 1536};
          pg8::gemm_phase<pg8::EpiBf16, pg8::StaticOrder, true, true>(F.lds, g, S, E); }
        __syncthreads();
        { pg8::Gemm g{(const bf16*)(ws + WS_CB), (const bf16*)(ws + WS_WUKV), TR, 2048, KVL}; pg8::StaticOrder S; S.init(TR, 2048, F.G, F.bid, REPN(14)); pg8::EpiBf16 E{(bf16*)(ws + WS_KNV), 2048};
          pg8::gemm_phase<pg8::EpiBf16, pg8::StaticOrder, true, true>(F.lds, g, S, E); }
        mini_gemm<true>(F, (const bf16*)(ws + WS_QAN), (const bf16*)(ws + WS_WQB), 1536, QL, (bf16*)(ws + WS_Q) + (size_t)TR * 1536, 1536);
        mini_gemm<true>(F, (const bf16*)(ws + WS_CB), (const bf16*)(ws + WS_WUKV), 2048, KVL, (bf16*)(ws + WS_KNV) + (size_t)TR * 2048, 2048);
    } SEAM(14);
    if (IN(16)) {
        if (F.bid == 0) attn_meta(F);
        volatile LAS int* qslot = (volatile LAS int*)(F.lds + MISC_OFF) + 16; unsigned* qctr = (unsigned*)(F.ws + WS_CTL) + CW_QUEUE;
#pragma unroll 1
        for (;;) {
            __syncthreads();
            if (F.tid == 0) qslot[0] = (int)__hip_atomic_fetch_add(qctr, 1u, __ATOMIC_RELAXED, __HIP_MEMORY_SCOPE_AGENT);
            __syncthreads();
            const int item = __builtin_amdgcn_readfirstlane(qslot[0]);
            if (item >= NS + NB * MH * 4) break;
            asm volatile("" : "+v"(F.tid), "+v"(F.lane));
            if (item < NS) attn_sample_item(F, item);
            else { const int L = item - NS, bh = L >> 2, x = L & 3;
#pragma unroll 1
                for (int pass = 0; pass < 2; ++pass) attn_qblock(F, bh >> 3, bh & 7, pass ? 7 - x : x); }
        }
    } SEAM(16);
    if (IN(18)) { pg8::Gemm g{(const bf16*)(ws + WS_AO), (const bf16*)(ws + WS_WMOUT), TR, DM, DM}; pg8::StaticOrder S; S.init(TR, DM, F.G, F.bid, REPN(18)); pg8::EpiBf16 E{(bf16*)TMP, DM};
        pg8::gemm_phase<pg8::EpiBf16, pg8::StaticOrder, true, true>(F.lds, g, S, E);
        mini_gemm_deep<true>(F, (const bf16*)(ws + WS_AO), (const bf16*)(ws + WS_WMOUT), DM, DM, (bf16*)TMP + (size_t)TR * DM, DM); } SEAM(18);
    if (IN(19)) { p_postnorm<false>(F, F.in[I_BNPOST]); } SEAM(19);
    if (IN(20)) { pg8::Gemm g{XH, (const bf16*)(ws + WS_WUP1), TR, FF2, DM}; pg8::StaticOrder S; S.init(TR, FF2, F.G, F.bid, REPN(20)); pg8::EpiFfnAct E{(bf16*)(ws + WS_ACT), (float*)(ws + WS_RAWH), (float*)(ws + WS_RAWX), F.in[I_FCONVW] + (size_t)1 * 3 * FF2, F.in[I_FCONVB] + (size_t)1 * FF2, TR / 256};
        _Pragma("unroll 1") for (int pass_ = 0; pass_ < 2; ++pass_) { asm volatile("" : "+v"(F.tid), "+v"(F.lane));
            if (pass_ == ((F.bid >> 3) & 1)) pg8::gemm_phase<pg8::EpiFfnAct, pg8::StaticOrder, true, true>(F.lds, g, S, E);
            else mini_gemm<false>(F, XH, (const bf16*)(ws + WS_WUP1), FF2, DM, (float*)(ws + WS_RAWX), FF2); } } SEAM(20);
    if (IN(21)) REP(21) { p_ffn_fix(F, 1); } SEAM(21);
    if (IN(22)) { pg8::Gemm g{(const bf16*)(ws + WS_ACT), (const bf16*)(ws + WS_WDN1), TR, DM, FF}; pg8::StaticOrder S; S.init(TR, DM, F.G, F.bid, REPN(22)); pg8::EpiBf16 E{(bf16*)TMP, DM};
        pg8::gemm_phase<pg8::EpiBf16, pg8::StaticOrder, true, true>(F.lds, g, S, E);
        mini_gemm_deep<true>(F, (const bf16*)(ws + WS_ACT), (const bf16*)(ws + WS_WDN1), DM, FF, (bf16*)TMP + (size_t)TR * DM, DM); } SEAM(22);
    if (IN(23)) REP(23) { p_postnorm<true>(F, F.in[I_FNPOST] + DM); }
#undef XH
#undef TMP
#undef IN
#undef SEAM
}

#ifndef MK_PER_PHASE
#define MK_PER_PHASE 0
#endif
extern "C" void kernel_launch(void* const* d_in, const int* in_sizes, int n_in, void* d_out, int out_size, void* d_ws, size_t ws_size, hipStream_t stream) {
    static int grid = 0;
    if (grid == 0) {
        if (n_in != N_IN || (size_t)out_size != O_END || ws_size < WS_END) { fprintf(stderr, "kernel_launch: unexpected shapes: n_in %d out %d ws %zu (need %zu)\n", n_in, out_size, ws_size, (size_t)WS_END); grid = -1; return; }
        int dev = 0, cus = 0, per_cu = 0;
        if (hipGetDevice(&dev) != hipSuccess || hipDeviceGetAttribute(&cus, hipDeviceAttributeMultiprocessorCount, dev) != hipSuccess) { grid = -1; return; }
        if (hipFuncSetAttribute((const void*)mk_fwd, hipFuncAttributeMaxDynamicSharedMemorySize, LDS_BYTES) != hipSuccess) { fprintf(stderr, "kernel_launch: hipFuncSetAttribute failed\n"); grid = -1; return; }
        if (hipOccupancyMaxActiveBlocksPerMultiprocessor(&per_cu, (const void*)mk_fwd, 512, LDS_BYTES) != hipSuccess || per_cu < 1) fprintf(stderr, "kernel_launch: occupancy query says %d\n", per_cu);
        (void)hipGetLastError();
        grid = cus & ~7;
    }
    if (grid < 0) return;
    (void)hipMemsetAsync((char*)d_ws + WS_CTL, 0, CTL_ZERO_BYTES, stream);
    Params P{};
    for (int i = 0; i < N_IN; ++i) P.in[i] = (const float*)d_in[i];
    P.out = (float*)d_out; P.ws = (unsigned char*)d_ws;
    unsigned char* ws = (unsigned char*)d_ws;
    const float* const* in = P.in;
    P.jobs[0] = ConvJob{in[I_AWIN], in[I_ANPRE], (bf16*)(ws + WS_WIN), DM, 4096, GIN, 0, 0, 0};
    P.jobs[1] = ConvJob{in[I_AWOUT], nullptr, (bf16*)(ws + WS_WGOUT), DM, DM, DM, 0, 0, 0};
    P.jobs[2] = ConvJob{in[I_FWUP], in[I_FNPRE], (bf16*)(ws + WS_WUP0), DM, FF2, FF2, 0, 1, 0};
    P.jobs[3] = ConvJob{in[I_FWUP] + (size_t)DM * FF2, in[I_FNPRE] + DM, (bf16*)(ws + WS_WUP1), DM, FF2, FF2, 0, 1, 0};
    P.jobs[4] = ConvJob{in[I_FWDOWN], nullptr, (bf16*)(ws + WS_WDN0), FF, DM, DM, 0, 0, 0};
    P.jobs[5] = ConvJob{in[I_FWDOWN] + (size_t)FF * DM, nullptr, (bf16*)(ws + WS_WDN1), FF, DM, DM, 0, 0, 0};
    P.jobs[6] = ConvJob{in[I_KVWA], in[I_KVNORM], (bf16*)(ws + WS_WKVQA), DM, 320, 320, 0, 0, 0};
    P.jobs[7] = ConvJob{in[I_BWQA], in[I_BNPRE], (bf16*)(ws + WS_WKVQA), DM, QL, QL, 320, 0, 0};
    P.jobs[8] = ConvJob{in[I_BWQB], nullptr, (bf16*)(ws + WS_WQB), QL, 1536, 1536, 0, 0, 0};
    P.jobs[9] = ConvJob{in[I_WUK], nullptr, (bf16*)(ws + WS_WUKV), KVL, 1024, 1024, 0, 0, 0};
    P.jobs[10] = ConvJob{in[I_WUV], nullptr, (bf16*)(ws + WS_WUKV), KVL, 1024, 1024, 1024, 0, 0};
    P.jobs[11] = ConvJob{in[I_BWOUT], nullptr, (bf16*)(ws + WS_WMOUT), DM, DM, DM, 0, 0, 0};
#if MK_PER_PHASE
    for (int ph = 0; ph < NPHASE; ++ph) { P.ph_lo = ph; P.ph_hi = ph + 1; hipLaunchKernelGGL(mk_fwd, dim3(grid), dim3(512), LDS_BYTES, stream, P); }
#else
    P.ph_lo = 0; P.ph_hi = NPHASE; hipLaunchKernelGGL(mk_fwd, dim3(grid), dim3(512), LDS_BYTES, stream, P);
#endif
    const hipError_t le = hipPeekAtLastError();
    if (le != hipSuccess) fprintf(stderr, "kernel_launch: launch failed: %s\n", hipGetErrorName(le));
}
```

```cpp
#include <hip/hip_runtime.h>
#include <cstdio>
#include <cstdint>
namespace pg8 {
#define PG8_LAS __attribute__((address_space(3)))
typedef unsigned short bf16_t;
typedef short bf16x8 __attribute__((ext_vector_type(8)));
typedef float f32x4 __attribute__((ext_vector_type(4)));
typedef unsigned u32x4 __attribute__((ext_vector_type(4)));
constexpr int BM = 256, BK = 64, HALF = 128, HTB = HALF * BK * 2  , STAGE_BYTES = 8 * HTB, NXCD = 8, WGM = 8;

__host__ __device__ __forceinline__ int lds_byte(int r, int c) { const int st = (r >> 4) * 2 + (c >> 5), rr = r & 15, cc = c & 31, ob = rr * 64 + cc * 2; return st * 1024 + (ob ^ (((ob >> 9) & 1) << 5)); }
__host__ __device__ __forceinline__ void stage_rc(int b, int& R, int& C) { const int st = b / 1024, sb = b % 1024, swz = sb ^ (((sb >> 9) & 1) << 5); R = (st >> 1) * 16 + swz / 64; C = (st & 1) * 32 + (swz % 64) / 2; }
__host__ __device__ __forceinline__ int perm32(int rho) { const int n = rho >> 4, i = rho & 15; return 8 * (i >> 2) + 4 * n + (i & 3); }

struct Unit { int pm, pn; };
struct Gemm { const bf16_t* A; const bf16_t* Bt; int M, N, K; };

struct StaticOrder {
    int nM, nN, nwg, G, c, rep;
    __host__ __device__ void init(int M, int N, int G_, int c_, int rep_ = 1) { nM = M / BM; nN = N / BM; nwg = nM * nN; G = G_; c = c_; rep = rep_; }
    __host__ __device__ bool next(int i, Unit& u) const {
        const long L = (long)i * G + c; if (L >= (long)nwg * rep) return false;
        int wgid = (int)(L % nwg); { const int q = nwg / NXCD, r = nwg % NXCD, xcd = wgid % NXCD, off = wgid / NXCD; wgid = (xcd < r ? xcd * (q + 1) : r * (q + 1) + (xcd - r) * q) + off; }
        const int nig = WGM * nN, gid = wgid / nig, fm = gid * WGM, gsz = (nM - fm) < WGM ? (nM - fm) : WGM;
        u.pm = fm + ((wgid % nig) % gsz); u.pn = (wgid % nig) / gsz; return true;
    }
    __device__ __forceinline__ void a_ready(const Unit&) const {}
    __device__ __forceinline__ void done(const Unit&) const {}
};
typedef float cvt_f32x2 __attribute__((ext_vector_type(2)));
typedef __bf16 cvt_bf16x2 __attribute__((ext_vector_type(2)));
__device__ __forceinline__ unsigned cvt_pk_bf16(float lo, float hi) { const cvt_f32x2 v = {lo, hi}; return __builtin_bit_cast(unsigned, __builtin_convertvector(v, cvt_bf16x2)); }
typedef float f32x2 __attribute__((ext_vector_type(2)));
struct EpiF32 {
    static constexpr bool PERM = false, AFTER_DRAIN = false, WPF = false;
    float* C; int ldc;
    __device__ __forceinline__ void operator()(const f32x4 (&acc)[2][2][4][2], const Unit& u, int wr, int wc, int fr, int fq) const {
        const int row0 = u.pm * BM + wr * 64 + fr, col0 = u.pn * BM + wc * 32 + 4 * fq;
#pragma unroll
        for (int ai = 0; ai < 2; ++ai)
#pragma unroll
            for (int m = 0; m < 4; ++m) { float* rowp = C + (size_t)(row0 + ai * HALF + m * 16) * ldc + col0;
#pragma unroll
                for (int bj = 0; bj < 2; ++bj)
#pragma unroll
                    for (int n = 0; n < 2; ++n) *(f32x4*)(rowp + bj * HALF + n * 16) = acc[ai][bj][m][n]; }
    }
};
struct EpiBf16 {
    static constexpr bool PERM = true, AFTER_DRAIN = false, WPF = false;
    bf16_t* O; int ldc;
    __device__ __forceinline__ void operator()(const f32x4 (&acc)[2][2][4][2], const Unit& u, int wr, int wc, int fr, int fq) const {
        const int row0 = u.pm * BM + wr * 64 + fr, col0 = u.pn * BM + wc * 32 + 8 * fq;
#pragma unroll
        for (int ai = 0; ai < 2; ++ai)
#pragma unroll
            for (int m = 0; m < 4; ++m) { bf16_t* rowp = O + (size_t)(row0 + ai * HALF + m * 16) * ldc + col0;
#pragma unroll
                for (int bj = 0; bj < 2; ++bj) { const f32x4 v0 = acc[ai][bj][m][0], v1 = acc[ai][bj][m][1];
                    u32x4 w; w.x = cvt_pk_bf16(v0[0], v0[1]); w.y = cvt_pk_bf16(v0[2], v0[3]); w.z = cvt_pk_bf16(v1[0], v1[1]); w.w = cvt_pk_bf16(v1[2], v1[3]);
                    *(u32x4*)(rowp + bj * HALF) = w; } }
    }
};
struct EpiFfnAct {
    static constexpr bool PERM = false, AFTER_DRAIN = false, WPF = true;
    static constexpr int WSLOT_OFF = 131072;
    __device__ __forceinline__ void prefetch(PG8_LAS unsigned char* lds, const Unit& u, int par, int wid, int lane) const {
        constexpr int FFC = 2816, FF2C = 5632;
        if (wid < 4) { const int s_ = 2 * wid + (lane >> 5), isv = s_ & 1, tap = s_ >> 1; const float* src = (tap < 3 ? cw + tap * FF2C : cb) + isv * FFC + 128 * u.pn + (lane & 31) * 4;
            __builtin_amdgcn_global_load_lds((const unsigned*)src, (PG8_LAS unsigned*)(lds + WSLOT_OFF + par * 4096 + wid * 1024), 16, 0, 0); }
    }
    bf16_t* ACT; float* RAWH; float* RAWX; const float* cw; const float* cb; int nrealp;
    static __device__ __forceinline__ float shr_prev(float prev, float x, int) { return x; }
    template <int D> static __device__ __forceinline__ float rowprev(float prev, float x) {
        const int o = __builtin_amdgcn_update_dpp(0, __builtin_bit_cast(int, prev), 0x100 + (16 - D), 0xF, 0xF, true);
        return __builtin_bit_cast(float, __builtin_amdgcn_update_dpp(o, __builtin_bit_cast(int, x), 0x110 + D, 0xF, 0xF, false));
    }
    __device__ __forceinline__ void operator()(const f32x4 (&acc)[2][2][4][2], const Unit& u, int wr, int wc, int fr, int fq, PG8_LAS unsigned char* lds, int par) const {
        constexpr int FFC = 2816, FF2C = 5632;
        f32x4 w0g[2], w1g[2], w2g[2], w0v[2], w1v[2], w2v[2], bg[2], bv[2];
        const PG8_LAS float* ws_ = (const PG8_LAS float*)(lds + WSLOT_OFF + par * 4096);
#pragma unroll
        for (int bj = 0; bj < 2; ++bj) { const int cl = 16 * (4 * bj + wc) + 4 * fq;
            w0g[bj] = *(const PG8_LAS f32x4*)(ws_ + cl); w0v[bj] = *(const PG8_LAS f32x4*)(ws_ + 128 + cl); w1g[bj] = *(const PG8_LAS f32x4*)(ws_ + 256 + cl); w1v[bj] = *(const PG8_LAS f32x4*)(ws_ + 384 + cl);
            w2g[bj] = *(const PG8_LAS f32x4*)(ws_ + 512 + cl); w2v[bj] = *(const PG8_LAS f32x4*)(ws_ + 640 + cl); bg[bj] = *(const PG8_LAS f32x4*)(ws_ + 768 + cl); bv[bj] = *(const PG8_LAS f32x4*)(ws_ + 896 + cl); }
#pragma unroll
        for (int bj = 0; bj < 2; ++bj)
#pragma unroll
            for (int ai = 0; ai < 2; ++ai) {
                const int G = 8 * u.pn + 4 * bj + wc, ch0 = 16 * G + 4 * fq, co0 = 32 * G + 4 * fq;
                const int rowg = u.pm * BM + ai * HALF + wr * 64;
#pragma unroll
                for (int m = 0; m < 4; ++m) {
                    const f32x4 xg = acc[ai][bj][m][0], xv = acc[ai][bj][m][1];
                    const f32x4 pg = m > 0 ? acc[ai][bj][m > 0 ? m - 1 : 0][0] : (f32x4){0.f, 0.f, 0.f, 0.f}, pv = m > 0 ? acc[ai][bj][m > 0 ? m - 1 : 0][1] : (f32x4){0.f, 0.f, 0.f, 0.f};
                    f32x4 g1, g2, v1, v2;
#pragma unroll
                    for (int e = 0; e < 4; ++e) { g1[e] = rowprev<1>(pg[e], xg[e]); g2[e] = rowprev<2>(pg[e], xg[e]); v1[e] = rowprev<1>(pv[e], xv[e]); v2[e] = rowprev<2>(pv[e], xv[e]); }
                    const f32x4 ug = w0g[bj] * g2 + w1g[bj] * g1 + w2g[bj] * xg + bg[bj], uv = w0v[bj] * v2 + w1v[bj] * v1 + w2v[bj] * xv + bv[bj];
                    const f32x4 den = ug * (-1.4426950408889634f); f32x4 sg;
#pragma unroll
                    for (int e = 0; e < 4; ++e) sg[e] = __builtin_amdgcn_rcpf(1.f + __builtin_amdgcn_exp2f(den[e]));
                    const f32x4 a = ug * sg * uv;
                    typedef unsigned u32x2 __attribute__((ext_vector_type(2)));
                    *(u32x2*)(ACT + (size_t)(rowg + 16 * m + fr) * FFC + ch0) = (u32x2){cvt_pk_bf16(a[0], a[1]), cvt_pk_bf16(a[2], a[3])};
                    if (m == 0 && fr < 2) { float* rp = RAWH + ((size_t)(rowg >> 6) * 4 + fr) * FF2C + co0; *(f32x4*)rp = xg; *(f32x4*)(rp + 16) = xv; }
                    if (m == 3 && fr >= 14) { float* rp = RAWH + ((size_t)(rowg >> 6) * 4 + 2 + (fr - 14)) * FF2C + co0; *(f32x4*)rp = xg; *(f32x4*)(rp + 16) = xv; }
                }
            }
    }
};
struct EpiInConv {
    static constexpr bool PERM = true, AFTER_DRAIN = false, WPF = true;
    bf16_t* O; float* RAWQ; const float* cw;
    __device__ __forceinline__ void prefetch(PG8_LAS unsigned char* lds, const Unit& u, int par, int wid, int lane) const {
        if (wid < 4 && u.pn * BM < 3072) __builtin_amdgcn_global_load_lds((const unsigned*)(cw + wid * 3072 + u.pn * BM + lane * 4), (PG8_LAS unsigned*)(lds + EpiFfnAct::WSLOT_OFF + par * 4096 + wid * 1024), 16, 0, 0);
    }
    __device__ __forceinline__ void operator()(const f32x4 (&acc)[2][2][4][2], const Unit& u, int wr, int wc, int fr, int fq, PG8_LAS unsigned char* lds, int par) const {
        constexpr int LDO = 4096, NQKV = 3072;
        const bool conv = u.pn * BM < NQKV;
        const PG8_LAS float* ws_ = (const PG8_LAS float*)(lds + EpiFfnAct::WSLOT_OFF + par * 4096);
#pragma unroll
        for (int bj = 0; bj < 2; ++bj) {
            asm volatile("" ::: "memory");
            const int col0 = u.pn * BM + bj * HALF + wc * 32 + 8 * fq;
            f32x4 w[4][2];
#pragma unroll
            for (int j = 0; j < 4; ++j) { const int cl = bj * HALF + wc * 32 + 8 * fq; w[j][0] = *(const PG8_LAS f32x4*)(ws_ + j * 256 + cl); w[j][1] = *(const PG8_LAS f32x4*)(ws_ + j * 256 + cl + 4); }
#pragma unroll
            for (int ai = 0; ai < 2; ++ai) {
                const int rowg = u.pm * BM + ai * HALF + wr * 64;
#pragma unroll
                for (int m = 0; m < 4; ++m) {
                    f32x4 o[2];
#pragma unroll
                    for (int n = 0; n < 2; ++n) { const f32x4 x = acc[ai][bj][m][n]; const f32x4 pz = {0.f, 0.f, 0.f, 0.f}; const f32x4 p = m > 0 ? acc[ai][bj][m > 0 ? m - 1 : 0][n] : pz;
                        if (conv) { f32x4 x1, x2, x3;
#pragma unroll
                            for (int e = 0; e < 4; ++e) { x1[e] = EpiFfnAct::rowprev<1>(p[e], x[e]); x2[e] = EpiFfnAct::rowprev<2>(p[e], x[e]); x3[e] = EpiFfnAct::rowprev<3>(p[e], x[e]); }
                            const f32x4 a = (w[0][n] * x3 + w[1][n] * x2) + (w[2][n] * x1 + w[3][n] * x), den = a * (-1.4426950408889634f); f32x4 sg;
#pragma unroll
                            for (int e = 0; e < 4; ++e) sg[e] = __builtin_amdgcn_rcpf(1.f + __builtin_amdgcn_exp2f(den[e]));
                            o[n] = a * sg;
                        } else o[n] = x; }
                    u32x4 wv; wv.x = cvt_pk_bf16(o[0][0], o[0][1]); wv.y = cvt_pk_bf16(o[0][2], o[0][3]); wv.z = cvt_pk_bf16(o[1][0], o[1][1]); wv.w = cvt_pk_bf16(o[1][2], o[1][3]);
                    *(u32x4*)(O + (size_t)(rowg + 16 * m + fr) * LDO + col0) = wv;
                    if (conv) {
                        if (m == 0 && fr < 3) { float* rp = RAWQ + ((size_t)(rowg >> 6) * 6 + fr) * NQKV + col0; *(f32x4*)rp = acc[ai][bj][m][0]; *(f32x4*)(rp + 4) = acc[ai][bj][m][1]; }
                        if (m == 3 && fr >= 13) { float* rp = RAWQ + ((size_t)(rowg >> 6) * 6 + 3 + (fr - 13)) * NQKV + col0; *(f32x4*)rp = acc[ai][bj][m][0]; *(f32x4*)(rp + 4) = acc[ai][bj][m][1]; }
                    }
                }
            }
        }
    }
};
template <class Epi, class Sched, bool ALIGN_EPI = false, bool SP2 = false>
__device__ __forceinline__ void gemm_phase(PG8_LAS unsigned char* lds, const Gemm g, const Sched& S, const Epi& E) {
    int tid_ = threadIdx.x; asm volatile("" : "+v"(tid_));
    const int tid = tid_, wid = __builtin_amdgcn_readfirstlane(tid >> 6), lane = tid & 63, wr = wid >> 2, wc = wid & 3, fr = lane & 15, fq = lane >> 4;
    const int K = g.K, nt = K / BK;
    unsigned voffA[2], voffB[2];
#pragma unroll
    for (int i = 0; i < 2; ++i) { int R, C; stage_rc(tid * 16 + i * 8192, R, C); const int Rb = Epi::PERM ? ((R & ~31) + perm32(R & 31)) : R;
        voffA[i] = (unsigned)(R * K + C) * 2u; voffB[i] = (unsigned)(Rb * K + C) * 2u; }
    const size_t kstep = (size_t)(BK * 2);
    const size_t hstep = (size_t)HALF * K * 2;
    const size_t tstep = 2 * hstep;
    const unsigned ldsw = (unsigned)wid * 1024u;
    const int aoff = lds_byte(wr * 64 + fr, fq * 8), boff = lds_byte(wc * 32 + fr, fq * 8);
#define PG8_SA(b, h) (((b) * 2 + (h)) * HTB)
#define PG8_SB(b, h) ((4 + (b) * 2 + (h)) * HTB)
#define PG8_STAGE(bufoff, gbase, voff) do { _Pragma("unroll") for (int _i = 0; _i < 2; ++_i) \
        __builtin_amdgcn_global_load_lds((const unsigned*)((const char*)(gbase) + (voff)[_i]), (PG8_LAS unsigned*)(lds + (bufoff) + ldsw + _i * 8192), 16, 0, 0); } while (0)
#define PG8_LDA(dst, b, h) do { _Pragma("unroll") for (int m = 0; m < 4; ++m) _Pragma("unroll") for (int k = 0; k < 2; ++k) dst[m][k] = *(const PG8_LAS bf16x8*)(lds + PG8_SA(b, h) + aoff + m * 2048 + k * 1024); } while (0)
#define PG8_LDB(dst, b, h) do { _Pragma("unroll") for (int n = 0; n < 2; ++n) _Pragma("unroll") for (int k = 0; k < 2; ++k) dst[n][k] = *(const PG8_LAS bf16x8*)(lds + PG8_SB(b, h) + boff + n * 2048 + k * 1024); } while (0)
#define PG8_MMA(ai, bj, At, Bt) do { __builtin_amdgcn_s_setprio(1); _Pragma("unroll") for (int m = 0; m < 4; ++m) _Pragma("unroll") for (int n = 0; n < 2; ++n) _Pragma("unroll") for (int k = 0; k < 2; ++k) \
        acc[ai][bj][m][n] = __builtin_amdgcn_mfma_f32_16x16x32_bf16(Bt[n][k], At[m][k], acc[ai][bj][m][n], 0, 0, 0); __builtin_amdgcn_s_setprio(0); } while (0)
#define PG8_WAIT_V(n) asm volatile("s_waitcnt vmcnt(" #n ")" ::: "memory")
#define PG8_WAIT_L(n) asm volatile("s_waitcnt lgkmcnt(" #n ")" ::: "memory")
#define PG8_BAR __builtin_amdgcn_s_barrier()
#define PG8_SCHED __builtin_amdgcn_sched_barrier(0)
    Unit cur, nxt; int ui = 0;
    if (!S.next(0, cur)) return;
    f32x4 acc[2][2][4][2];
#pragma unroll
    for (int a = 0; a < 2; ++a)
#pragma unroll
        for (int b = 0; b < 2; ++b)
#pragma unroll
            for (int m = 0; m < 4; ++m)
#pragma unroll
                for (int n = 0; n < 2; ++n) acc[a][b][m][n] = (f32x4){0.f, 0.f, 0.f, 0.f};
    bf16x8 At[4][2], B0[2][2], B1[2][2];
    const char* cA = (const char*)g.A + (size_t)cur.pm * tstep; const char* cB = (const char*)g.Bt + (size_t)cur.pn * tstep;
    S.a_ready(cur);
    if constexpr (Epi::WPF) E.prefetch(lds, cur, 0, wid, lane);
    if constexpr (SP2) {
        PG8_STAGE(PG8_SB(0, 0), cB, voffB); PG8_STAGE(PG8_SB(0, 1), cB + hstep, voffB); PG8_STAGE(PG8_SA(0, 0), cA, voffA); PG8_STAGE(PG8_SA(0, 1), cA + hstep, voffA);
        PG8_STAGE(PG8_SB(1, 0), cB + kstep, voffB); PG8_STAGE(PG8_SA(1, 0), cA + kstep, voffA); PG8_STAGE(PG8_SB(1, 1), cB + hstep + kstep, voffB);
        PG8_WAIT_V(8); PG8_BAR;
        if (wr == 1) PG8_BAR;
    } else {
        PG8_STAGE(PG8_SB(0, 0), cB, voffB); PG8_STAGE(PG8_SA(0, 0), cA, voffA); PG8_STAGE(PG8_SB(0, 1), cB + hstep, voffB); PG8_STAGE(PG8_SA(0, 1), cA + hstep, voffA);
        if (wr == 1) PG8_BAR;
        PG8_WAIT_V(4); PG8_BAR;
        PG8_STAGE(PG8_SB(1, 0), cB + kstep, voffB); PG8_STAGE(PG8_SA(1, 0), cA + kstep, voffA); PG8_STAGE(PG8_SB(1, 1), cB + hstep + kstep, voffB);
        PG8_WAIT_V(6); PG8_BAR;
    }
    for (;;) {
        const bool has_next = S.next(ui + 1, nxt);
        const char* nA = has_next ? (const char*)g.A + (size_t)nxt.pm * tstep : cA; const char* nB = has_next ? (const char*)g.Bt + (size_t)nxt.pn * tstep : cB;
        for (int t = 0; t < nt; t += 2) {
            const bool last = (t == nt - 2);
            const char* a1 = cA + (size_t)(t + 1) * kstep;
            const char* a2 = last ? nA : cA + (size_t)(t + 2) * kstep; const char* b2 = last ? nB : cB + (size_t)(t + 2) * kstep;
            const char* a3 = a2 + kstep; const char* b3 = b2 + kstep;
            if (last && has_next) S.a_ready(nxt);
            if constexpr (SP2) {
            PG8_LDB(B0, 0, 0); PG8_LDB(B1, 0, 1); PG8_SCHED; PG8_LDA(At, 0, 0); PG8_STAGE(PG8_SA(1, 1), a1 + hstep, voffA);
            PG8_WAIT_V(8); PG8_WAIT_L(0); PG8_BAR; PG8_MMA(0, 0, At, B0); PG8_MMA(0, 1, At, B1); PG8_BAR; PG8_SCHED;
            PG8_LDA(At, 0, 1); PG8_STAGE(PG8_SB(0, 0), b2, voffB); PG8_STAGE(PG8_SB(0, 1), b2 + hstep, voffB); PG8_STAGE(PG8_SA(0, 0), a2, voffA);
            PG8_WAIT_V(8); PG8_WAIT_L(0); PG8_BAR; PG8_MMA(1, 0, At, B0); PG8_MMA(1, 1, At, B1); PG8_BAR; PG8_SCHED;
            PG8_LDB(B0, 1, 0); PG8_LDB(B1, 1, 1); PG8_SCHED; PG8_LDA(At, 1, 0); PG8_STAGE(PG8_SA(0, 1), a2 + hstep, voffA);
            PG8_WAIT_V(8); PG8_WAIT_L(0); PG8_BAR; PG8_MMA(0, 0, At, B0); PG8_MMA(0, 1, At, B1); PG8_BAR; PG8_SCHED;
            PG8_LDA(At, 1, 1); PG8_STAGE(PG8_SB(1, 0), b3, voffB); PG8_STAGE(PG8_SB(1, 1), b3 + hstep, voffB); PG8_STAGE(PG8_SA(1, 0), a3, voffA);
            PG8_WAIT_V(8); PG8_WAIT_L(0); PG8_BAR; PG8_MMA(1, 0, At, B0); PG8_MMA(1, 1, At, B1); PG8_BAR; PG8_SCHED;
            } else {
            PG8_LDB(B0, 0, 0); PG8_SCHED; PG8_LDA(At, 0, 0); PG8_STAGE(PG8_SA(1, 1), a1 + hstep, voffA);
            PG8_WAIT_L(8); PG8_BAR; PG8_WAIT_L(0); PG8_MMA(0, 0, At, B0); PG8_BAR; PG8_SCHED;
            PG8_LDB(B1, 0, 1); PG8_STAGE(PG8_SB(0, 0), b2, voffB);
            PG8_BAR; PG8_WAIT_L(0); PG8_MMA(0, 1, At, B1); PG8_BAR;
            PG8_LDA(At, 0, 1); PG8_STAGE(PG8_SA(0, 0), a2, voffA);
            PG8_BAR; PG8_WAIT_L(0); PG8_MMA(1, 0, At, B0); PG8_BAR; PG8_SCHED;
            PG8_STAGE(PG8_SB(0, 1), b2 + hstep, voffB);
            PG8_WAIT_V(6); PG8_BAR; PG8_MMA(1, 1, At, B1); PG8_BAR;
            PG8_LDB(B0, 1, 0); PG8_SCHED; PG8_LDA(At, 1, 0); PG8_STAGE(PG8_SA(0, 1), a2 + hstep, voffA);
            PG8_WAIT_L(8); PG8_BAR; PG8_WAIT_L(0); PG8_MMA(0, 0, At, B0); PG8_BAR; PG8_SCHED;
            PG8_LDB(B1, 1, 1); PG8_STAGE(PG8_SB(1, 0), b3, voffB);
            PG8_BAR; PG8_WAIT_L(0); PG8_MMA(0, 1, At, B1); PG8_BAR;
            PG8_LDA(At, 1, 1); PG8_STAGE(PG8_SA(1, 0), a3, voffA);
            PG8_BAR; PG8_WAIT_L(0); PG8_MMA(1, 0, At, B0); PG8_BAR; PG8_SCHED;
            PG8_STAGE(PG8_SB(1, 1), b3 + hstep, voffB);
            PG8_WAIT_V(6); PG8_BAR; PG8_MMA(1, 1, At, B1); PG8_BAR;
            }
        }
        if constexpr (ALIGN_EPI) { if (wr == 0) PG8_BAR; }
        if constexpr (Epi::WPF) { if (has_next) E.prefetch(lds, nxt, (ui + 1) & 1, wid, lane); E(acc, cur, wr, wc, fr, fq, lds, ui & 1); S.done(cur); }
        else if constexpr (!Epi::AFTER_DRAIN) { E(acc, cur, wr, wc, fr, fq); S.done(cur); }
        if (!has_next) break;
#pragma unroll
        for (int a = 0; a < 2; ++a)
#pragma unroll
            for (int b = 0; b < 2; ++b)
#pragma unroll
                for (int m = 0; m < 4; ++m)
#pragma unroll
                    for (int n = 0; n < 2; ++n) acc[a][b][m][n] = (f32x4){0.f, 0.f, 0.f, 0.f};
        cur = nxt; cA = nA; cB = nB; ++ui;
        if constexpr (ALIGN_EPI) { if (wr == 1) PG8_BAR; }
    }
    PG8_WAIT_V(0);
    if constexpr (!ALIGN_EPI) { if (wr == 0) PG8_BAR; }
    PG8_BAR;
    if constexpr (Epi::AFTER_DRAIN) { E.fused(acc, cur, wr, wc, fr, fq, lds, wid, lane); S.done(cur); }
#undef PG8_SA
#undef PG8_SB
#undef PG8_STAGE
#undef PG8_LDA
#undef PG8_LDB
#undef PG8_MMA
#undef PG8_WAIT_V
#undef PG8_WAIT_L
#undef PG8_BAR
#undef PG8_SCHED
}
}

constexpr int DM = 1024, NB = 16, SEQ = 2048, TR = NB * SEQ, NMETA = 16, NS = 128;
constexpr int XM = TR, XS = TR + NMETA, NVALID = TR + NMETA + NS, TM = 33024;
constexpr int LP = NMETA + SEQ;
constexpr int GH = 8, GDK = 128, GDV = 128, GQKV = 3072, GIN = 4112;
constexpr int QL = 384, KVL = 256, NOPE = 128, ROPE = 64, HD = 192, MH = 8;
constexpr int FF = 2816, FF2 = 5632;
constexpr int PAST = 8192, PAGE = 128, NPAGE = 64;
constexpr float EPS = 1e-6f;
constexpr float MLA_SCALE = 0.07216878364870322f;
static_assert(TM % 256 == 0 && TM >= NVALID, "row padding");

enum { I_XP = 0, I_XS, I_SDS, I_SDC, I_SFC, I_CKV, I_CKR, I_PT, I_META, I_ANPRE, I_ANPOST, I_AWIN, I_ACONV, I_ALOG, I_ADT, I_AONORM, I_AWOUT,
       I_KVNORM, I_KVWA, I_KVANORM, I_WUK, I_WUV, I_BNPRE, I_BNPOST, I_BWQA, I_BQANORM, I_BWQB, I_BWOUT, I_FNPRE, I_FNPOST, I_FWUP, I_FCONVW, I_FCONVB, I_FWDOWN, N_IN };
constexpr size_t O_YP = 0, O_YS = O_YP + (size_t)TR * DM, O_PDS = O_YS + (size_t)NS * DM, O_PDC = O_PDS + (size_t)NB * GH * GDK * GDV, O_PFC = O_PDC + (size_t)NB * 3 * GQKV,
                 O_PKV = O_PFC + (size_t)2 * NB * 2 * FF2, O_PKR = O_PKV + (size_t)NB * LP * KVL, O_SDS = O_PKR + (size_t)NB * LP * ROPE, O_SDC = O_SDS + (size_t)NS * GH * GDK * GDV,
                 O_SFC = O_SDC + (size_t)NS * 3 * GQKV, O_SKV = O_SFC + (size_t)2 * NS * 2 * FF2, O_SKR = O_SKV + (size_t)NS * KVL, O_END = O_SKR + (size_t)NS * ROPE;

constexpr size_t MiB = 1u << 20;
constexpr size_t WS_CTL = 0, CTL_ZERO_BYTES = 1 * MiB;
constexpr size_t WS_ROPE = 1 * MiB;
constexpr size_t WS_WIN = 2 * MiB, WS_WGOUT = 10 * MiB, WS_WUP0 = 12 * MiB, WS_WUP1 = 23 * MiB, WS_WDN0 = 34 * MiB, WS_WDN1 = 40 * MiB, WS_WKVQA = 46 * MiB,
                 WS_WQB = 48 * MiB, WS_WUKV = 50 * MiB, WS_WMOUT = 52 * MiB, WS_AB = 54 * MiB, WS_PART = 57 * MiB, WS_QLAT = 60 * MiB;
constexpr size_t WS_XRES = 64 * MiB, WS_XH = 193 * MiB, WS_TMP = 258 * MiB, WS_QKVZ = 387 * MiB, WS_GO = 645 * MiB, WS_UP = 710 * MiB, WS_RAWH = 710 * MiB, WS_RAWX = 760 * MiB, WS_ACT = 1065 * MiB,
                 WS_CKVQ = 1243 * MiB, WS_CB = 1340 * MiB, WS_KRB = 1357 * MiB, WS_QAN = 1362 * MiB, WS_Q = 1387 * MiB, WS_KNV = 1484 * MiB, WS_AO = 1613 * MiB,
                 WS_SREC = 1678 * MiB, WS_GU = 1904 * MiB, WS_GA = 1970 * MiB, WS_GRV = 2036 * MiB, WS_GRK = 2102 * MiB, WS_GEG = 2168 * MiB, WS_RAWQ = 2169 * MiB, WS_END = 2210 * MiB;
constexpr int CW_BAR = 4096, CW_QUEUE = 2048;
constexpr int NPOSTAB = LP + 1;

constexpr int RING_BYTES = 131072, LDS_BYTES = 147456, CTLLDS_OFF = LDS_BYTES - 2048, MISC_OFF = CTLLDS_OFF + 320, INTAB_OFF = CTLLDS_OFF + 1024;

#define LAS __attribute__((address_space(3)))
typedef unsigned short bf16;
typedef unsigned v4u __attribute__((ext_vector_type(4)));
typedef unsigned v2u __attribute__((ext_vector_type(2)));
typedef float f32x4 __attribute__((ext_vector_type(4)));
typedef float f32x16 __attribute__((ext_vector_type(16)));
typedef short bf16x8 __attribute__((ext_vector_type(8)));
typedef short s16x4 __attribute__((ext_vector_type(4)));
#define LDS_WAIT() asm volatile("s_waitcnt lgkmcnt(0)" ::: "memory")
#define VM_WAIT() asm volatile("s_waitcnt vmcnt(0)" ::: "memory")
__device__ __forceinline__ unsigned f2bf(float f) { unsigned u = __builtin_bit_cast(unsigned, f); return (u + 0x7fffu + ((u >> 16) & 1u)) >> 16; }
__device__ __forceinline__ unsigned pk2(float lo, float hi) { return f2bf(lo) | (f2bf(hi) << 16); }
__device__ __forceinline__ float bf2f(bf16 b) { return __builtin_bit_cast(float, (unsigned)b << 16); }
__device__ __forceinline__ float bflo(unsigned w) { return __builtin_bit_cast(float, w << 16); }
__device__ __forceinline__ float bfhi(unsigned w) { return __builtin_bit_cast(float, w & 0xffff0000u); }
#define DPPF(x, ctrl) __builtin_bit_cast(float, __builtin_amdgcn_update_dpp(0, __builtin_bit_cast(int, (x)), (ctrl), 0xF, 0xF, false))
__device__ __forceinline__ float swap16_sum(float v) { auto r = __builtin_amdgcn_permlane16_swap(__float_as_uint(v), __float_as_uint(v), false, false); return __uint_as_float(r[0]) + __uint_as_float(r[1]); }
__device__ __forceinline__ float swap32_sum(float v) { auto r = __builtin_amdgcn_permlane32_swap(__float_as_uint(v), __float_as_uint(v), false, false); return __uint_as_float(r[0]) + __uint_as_float(r[1]); }
__device__ __forceinline__ float wave_sum(float v) {
    v += DPPF(v, 0xB1); v += DPPF(v, 0x4E); v += DPPF(v, 0x141); v += DPPF(v, 0x140);
    return swap32_sum(swap16_sum(v));
}
__device__ __forceinline__ float siluf(float x) { return x * __builtin_amdgcn_rcpf(1.f + __expf(-x)); }

#define XB_TMO      128
#define XB_XCNT(j)  (256  + 64 * (j))
#define XB_XSUB(j)  (1280 + 64 * (j))
#define XB_XGEN(j)  (2304 + 64 * (j))
#define XB_TOP      3328
#define XB_TOPGEN   3392
#define XCD_BAR_WORDS 3456
#define XB_SPIN_CAP (1u << 18)
__device__ __forceinline__ unsigned xb_ld(unsigned* p)              { return __hip_atomic_load(p, __ATOMIC_RELAXED, __HIP_MEMORY_SCOPE_AGENT); }
__device__ __forceinline__ unsigned xb_add(unsigned* p, unsigned v) { return __hip_atomic_fetch_add(p, v, __ATOMIC_RELAXED, __HIP_MEMORY_SCOPE_AGENT); }
__device__ __forceinline__ unsigned xb_xcc_id() { return (unsigned)__builtin_amdgcn_s_getreg((3 << 11) | 20) & 0xFu; }
#define XB_SPIN(cond, bar) do { unsigned _sp = 0; while (cond) { __builtin_amdgcn_s_sleep(1); \
    if ((++_sp & 255u) == 0u) { if (xb_ld(&(bar)[XB_TMO])) break; if (_sp > XB_SPIN_CAP) { atomicAdd(&(bar)[XB_TMO], 1u); break; } } } } while (0)
struct XcdBarrier { unsigned* bar; unsigned x; volatile LAS unsigned* st; };
__device__ __forceinline__ XcdBarrier xcd_barrier_post(unsigned* bar, volatile LAS unsigned* st) {
    XcdBarrier b; b.bar = bar; b.x = xb_xcc_id(); b.st = st;
    if (threadIdx.x == 0) (void)xb_add(&bar[XB_XCNT(b.x)], 1u);
    return b;
}
__device__ __forceinline__ void xcd_barrier_complete(unsigned* bar, unsigned x, unsigned& nloc, unsigned& nx) {
    const unsigned G = gridDim.x * gridDim.y * gridDim.z;
    unsigned sum, cnt, mine, sp = 0u;
    for (;;) {
        sum = 0u; cnt = 0u; mine = 0u;
#pragma unroll
        for (unsigned j = 0; j < 16; ++j) { const unsigned c = xb_ld(&bar[XB_XCNT(j)]); sum += c; cnt += (c > 0u) ? 1u : 0u; mine = (j == x) ? c : mine; }
        if (sum == G) break;
        __builtin_amdgcn_s_sleep(1);
        if ((++sp & 255u) == 0u) { if (xb_ld(&bar[XB_TMO])) break; if (sp > XB_SPIN_CAP) { atomicAdd(&bar[XB_TMO], 1u); break; } }
    }
    nloc = mine > 0u ? mine : 1u; nx = cnt > 0u ? cnt : 1u;
}
__device__ __forceinline__ void xcd_barrier(const XcdBarrier& b) {
    asm volatile("s_waitcnt vmcnt(0)" ::: "memory");
    __syncthreads();
    if (threadIdx.x == 0) {
        unsigned* bar = b.bar;
        __builtin_amdgcn_s_waitcnt(0);
        unsigned nloc = b.st[0], nx = b.st[1];
        if (nloc == 0u) { xcd_barrier_complete(bar, b.x, nloc, nx); b.st[0] = nloc; b.st[1] = nx; }
        const unsigned old = xb_add(&bar[XB_XSUB(b.x)], 1u);
        const unsigned gen = old / nloc;
        if (old + 1u == (gen + 1u) * nloc) {
            __builtin_amdgcn_fence(__ATOMIC_RELEASE, "agent");
            asm volatile("s_waitcnt vmcnt(0)" ::: "memory");
            const unsigned og = xb_add(&bar[XB_TOP], 1u);
            const unsigned tg = og / nx;
            if (og + 1u == (tg + 1u) * nx) xb_add(&bar[XB_TOPGEN], 1u);
            else XB_SPIN(xb_ld(&bar[XB_TOPGEN]) == tg, bar);
            __builtin_amdgcn_fence(__ATOMIC_ACQUIRE, "agent");
            xb_add(&bar[XB_XGEN(b.x)], 1u);
            asm volatile("s_waitcnt vmcnt(0)" ::: "memory");
        } else {
            XB_SPIN(xb_ld(&bar[XB_XGEN(b.x)]) == gen, bar);
            __builtin_amdgcn_fence(__ATOMIC_ACQUIRE, "agent");
            asm volatile("s_waitcnt vmcnt(0)" ::: "memory");
        }
    }
    __syncthreads();
}

struct ConvJob { const float* src; const float* gain; bf16* dst; int K, N, ld, row_off, mode, pad; };
constexpr int NJOBS = 12;
struct Params {
    const float* in[N_IN];
    float* out; unsigned char* ws;
    ConvJob jobs[NJOBS];
    int ph_lo, ph_hi;
};
#define GAS __attribute__((address_space(1)))
struct InTab { const LAS unsigned* t;
    __device__ __forceinline__ const float* operator[](int i) const { const unsigned lo = __builtin_amdgcn_readfirstlane(t[2 * i]), hi = __builtin_amdgcn_readfirstlane(t[2 * i + 1]); return (const float*)(GAS const float*)(((unsigned long long)hi << 32) | lo); } };
struct Frame {
    LAS unsigned char* lds;
    int tid, lane, wave, G, bid;
    InTab in; GAS float* out; GAS unsigned char* ws;
};
__device__ __forceinline__ int prow(int b, int pos) { return pos < NMETA ? XM + pos : b * SEQ + (pos - NMETA); }

template <bool GAIN> __device__ __forceinline__ void p0_transpose_item(const ConvJob& J, LAS float* scr, int item, int lane) {
    const int nblk = J.N / 32, kb = item / nblk, nb = item % nblk, k0 = 64 * kb, n0 = 32 * nb;
    const int kr = lane >> 3, c4 = (lane & 7) * 4;
    f32x4 v[8]; float gn[8];
#pragma unroll
    for (int i = 0; i < 8; ++i) { const int kk = 8 * i + kr; v[i] = *(const f32x4*)(J.src + (size_t)(k0 + kk) * J.ld + n0 + c4); gn[i] = GAIN ? J.gain[k0 + kk] : 1.f; }
#pragma unroll
    for (int i = 0; i < 8; ++i) { const int kk = 8 * i + kr; LAS float* d = scr + kk * 33 + c4; d[0] = v[i].x * gn[i]; d[1] = v[i].y * gn[i]; d[2] = v[i].z * gn[i]; d[3] = v[i].w * gn[i]; }
    LDS_WAIT(); asm volatile("" ::: "memory");
    const int c = lane & 7;
#pragma unroll
    for (int j = 0; j < 4; ++j) { const int n = (lane >> 3) + 8 * j; const LAS float* s = scr + (8 * c) * 33 + n;
        v4u o; o.x = pk2(s[0 * 33], s[1 * 33]); o.y = pk2(s[2 * 33], s[3 * 33]); o.z = pk2(s[4 * 33], s[5 * 33]); o.w = pk2(s[6 * 33], s[7 * 33]);
        const int sc_ = n0 + n; int drow = J.row_off + sc_; if (J.mode == 1) { const int isv = sc_ >= FF ? 1 : 0, ch = sc_ - isv * FF; drow = 32 * (ch >> 4) + 16 * isv + (ch & 15); }
        *(v4u*)(J.dst + (size_t)drow * J.K + k0 + 8 * c) = o; }
    LDS_WAIT(); asm volatile("" ::: "memory");
}
__device__ __forceinline__ void p0_prologue(Frame& F, const Params& P) {
    const int gw = F.bid * 8 + F.wave, NGW = F.G * 8;
    {
        LAS float* scr = (LAS float*)(F.lds + F.wave * 16384);
        int base = 0;
#ifndef P0A
#define P0A 1
#define P0C 1
#endif
#pragma unroll 1
        for (int j_ = 0; j_ < NJOBS * P0A; ++j_) { const int j = j_ % NJOBS; if (j == 0) base = 0;
            const ConvJob J = P.jobs[j]; const int nit = (J.K / 64) * (J.N / 32);
            int first = (gw - base % NGW + NGW) % NGW;
            if (J.gain) { _Pragma("unroll 1") for (int it = first; it < nit; it += NGW) p0_transpose_item<true>(J, scr, it, F.lane); }
            else { _Pragma("unroll 1") for (int it = first; it < nit; it += NGW) p0_transpose_item<false>(J, scr, it, F.lane); }
            base += nit;
        }
        bf16* wz = (bf16*)(F.ws + WS_WKVQA) + (size_t)704 * DM;
        for (int i = F.bid * 512 + F.tid; i < 64 * DM / 8; i += F.G * 512) ((v4u*)wz)[i] = (v4u){0u, 0u, 0u, 0u};
    }
    {
        float* ctab = (float*)(F.ws + WS_ROPE); float* stab = ctab + NPOSTAB * 32;
        for (int idx = F.bid * 512 + F.tid; idx < NPOSTAB * 32; idx += F.G * 512) {
            const int pi = idx >> 5, i = idx & 31; const int pos = pi < LP ? pi : PAST;
            double inv = 1.0; for (int k = 0; k < i; ++k) inv *= 0.74989420933245582730;
            double c1 = 1.0, s1 = inv, tc = 1.0, ts = inv; const double x2 = inv * inv;
            for (int k = 1; k < 14; ++k) { tc *= -x2 / (double)((2 * k - 1) * (2 * k)); ts *= -x2 / (double)((2 * k) * (2 * k + 1)); c1 += tc; s1 += ts; }
            double rc = 1.0, rs = 0.0, bc = c1, bs = s1; int e = pos;
            for (int k = 0; k < 14; ++k) { if (e & 1) { const double t = rc * bc - rs * bs; rs = rc * bs + rs * bc; rc = t; } const double t2 = bc * bc - bs * bs; bs = 2.0 * bc * bs; bc = t2; e >>= 1; }
            ctab[idx] = (float)rc; stab[idx] = (float)rs;
        }
    }
    __syncthreads();
    asm volatile("" : "+s"(F.ws));
    LAS float* wab = (LAS float*)F.lds;
    { const float* win = F.in[I_AWIN]; const float* g = F.in[I_ANPRE];
      for (int idx = F.tid; idx < DM * 16; idx += 512) { const int k = idx >> 4, q = idx & 15, j = k >> 8, ln = (k >> 2) & 63, i = k & 3; wab[(((j * 4 + i) * 4 + (q >> 2)) * 64 + ln) * 4 + (q & 3)] = win[(size_t)k * GIN + 4096 + q] * g[k]; } }
    __syncthreads();
    float* XRES = (float*)(F.ws + WS_XRES); bf16* XH = (bf16*)(F.ws + WS_XH); float* AB = (float*)(F.ws + WS_AB);
#pragma unroll 1
    for (int rb_ = gw * 2; rb_ < TM * P0C; rb_ += NGW * 2) { const int rb = rb_ % TM;
        f32x4 v[2][4]; float msk[2];
#pragma unroll
        for (int u = 0; u < 2; ++u) { const int row = rb + u; const float* src = F.in[I_XP];
            if (row < TR) src = F.in[I_XP] + (size_t)row * DM; else if (row < XS) src = F.in[I_META] + (size_t)(row - XM) * DM; else if (row < NVALID) src = F.in[I_XS] + (size_t)(row - XS) * DM;
            msk[u] = row < NVALID ? 1.f : 0.f;
#pragma unroll
            for (int j = 0; j < 4; ++j) v[u][j] = ((const f32x4*)src)[64 * j + F.lane]; }
#pragma unroll
        for (int u = 0; u < 2; ++u) { const int row = rb + u; float ss = 0.f;
#pragma unroll
            for (int j = 0; j < 4; ++j) { v[u][j] = v[u][j] * msk[u]; ss += (v[u][j].x * v[u][j].x + v[u][j].y * v[u][j].y) + (v[u][j].z * v[u][j].z + v[u][j].w * v[u][j].w); }
            ss = wave_sum(ss); const float ms = ss * (1.f / DM) + EPS, rstd = rsqrtf(ms);
            unsigned long long* xh = (unsigned long long*)(XH + (size_t)row * DM);
            if (F.lane == 0) ((float*)(F.ws + WS_GEG + 65536))[row] = sqrtf(ms);
#pragma unroll
            for (int j = 0; j < 4; ++j) { v[u][j] = v[u][j] * rstd; xh[64 * j + F.lane] = (unsigned long long)pk2(v[u][j].x, v[u][j].y) | ((unsigned long long)pk2(v[u][j].z, v[u][j].w) << 32); }
            if (row >= NVALID) continue;
            float a[16];
#pragma unroll
            for (int q = 0; q < 16; ++q) a[q] = 0.f;
#pragma unroll
            for (int j = 0; j < 4; ++j)
#pragma unroll
                for (int i = 0; i < 4; ++i) { const float xv = v[u][j][i]; const LAS f32x4* wr = (const LAS f32x4*)wab + (j * 4 + i) * 256 + F.lane;
#pragma unroll
                    for (int q4 = 0; q4 < 4; ++q4) { const f32x4 w = wr[q4 * 64]; a[4 * q4 + 0] += xv * w.x; a[4 * q4 + 1] += xv * w.y; a[4 * q4 + 2] += xv * w.z; a[4 * q4 + 3] += xv * w.w; } }
#pragma unroll
            for (int i = 0; i < 8; ++i) { auto r_ = __builtin_amdgcn_permlane32_swap(__float_as_uint(a[i]), __float_as_uint(a[i + 8]), false, false); a[i] = __uint_as_float(r_[0]) + __uint_as_float(r_[1]); }
#pragma unroll
            for (int i = 0; i < 4; ++i) { auto r_ = __builtin_amdgcn_permlane16_swap(__float_as_uint(a[i]), __float_as_uint(a[i + 4]), false, false); a[i] = __uint_as_float(r_[0]) + __uint_as_float(r_[1]); }
            { const bool b3 = (F.lane & 8) != 0, b2 = (F.lane & 4) != 0;
#pragma unroll
              for (int i = 0; i < 2; ++i) { const float keep = b3 ? a[i + 2] : a[i], send = b3 ? a[i] : a[i + 2]; a[i] = keep + DPPF(send, 0x140); }
              { const float keep = b2 ? a[1] : a[0], send = b2 ? a[0] : a[1]; a[0] = keep + DPPF(send, 0x141); } }
            a[0] += DPPF(a[0], 0x4E); a[0] += DPPF(a[0], 0xB1);
            if ((F.lane & 3) == 0) { const int idx = ((F.lane >> 5) & 1) * 8 + ((F.lane >> 4) & 1) * 4 + ((F.lane >> 3) & 1) * 2 + ((F.lane >> 2) & 1); AB[(size_t)row * 16 + idx] = a[0]; }
        }
    }
}

__device__ __forceinline__ void gdn_item(Frame& F, int item) {
    const bool is_p = item < NB * GH;
    const int b = is_p ? item >> 3 : 0, h = item & 7, s = is_p ? 0 : (item - NB * GH) >> 3;
    const int dv = F.tid & 127, qd = __builtin_amdgcn_readfirstlane(F.tid >> 7);
    LAS float* qs = (LAS float*)F.lds; LAS float* ks = qs + 16 * 128; LAS float* vs = ks + 16 * 128; LAS float* red = vs + 16 * 128; LAS float* red2 = red + 512; LAS float* egs = red2 + 512; LAS float* bes = egs + 16;
    const bf16* QKVZ = (const bf16*)(F.ws + WS_QKVZ); const float* AB = (const float*)(F.ws + WS_AB); bf16* OB = (bf16*)(F.ws + WS_TMP);
    const float* cw = F.in[I_ACONV]; const float* sdc = F.in[I_SDC];
    float S[32];
    if (is_p) {
#pragma unroll
        for (int i = 0; i < 32; ++i) S[i] = 0.f;
    } else { const float* s0 = F.in[I_SDS] + ((size_t)(s * GH + h) * GDK + 32 * qd) * GDV + dv;
#pragma unroll
        for (int i = 0; i < 32; ++i) S[i] = s0[(size_t)i * GDV]; }
    const float Ah = __expf(F.in[I_ALOG][h]), dtb = F.in[I_ADT][h];
    const int nchunk = is_p ? LP / 16 : 1, ntok = is_p ? 16 : 1;
#pragma unroll 1
    for (int ch = 0; ch < nchunk; ++ch) {
        for (int idx = F.tid; idx < ntok * 384; idx += 512) {
            const int ti = idx / 384, c = idx - ti * 384, part = c >> 7, cc = c & 127, col = part * 1024 + h * 128 + cc;
            float acc = 0.f;
#pragma unroll
            for (int j = 0; j < 4; ++j) {
                float xv;
                if (is_p) { const int pos = ch * 16 + ti - 3 + j; xv = pos < 0 ? 0.f : bf2f(QKVZ[(size_t)prow(b, pos) * 4096 + col]); }
                else xv = j < 3 ? sdc[(size_t)(s * 3 + j) * GQKV + col] : bf2f(QKVZ[(size_t)(XS + s) * 4096 + col]);
                acc += cw[j * GQKV + col] * xv;
            }
            acc = siluf(acc);
            (part == 0 ? qs : part == 1 ? ks : vs)[ti * 128 + cc] = acc;
        }
        if (F.tid < ntok) { const int row = is_p ? prow(b, ch * 16 + F.tid) : XS + s; const float a = AB[(size_t)row * 16 + h], bb = AB[(size_t)row * 16 + 8 + h];
            const float x = a + dtb, sp = x > 20.f ? x : log1pf(__expf(x)); egs[F.tid] = __expf(-Ah * sp); bes[F.tid] = 1.f / (1.f + __expf(-bb)); }
        __syncthreads();
        for (int vv = F.wave; vv < 2 * ntok; vv += 8) { const int ti = vv >> 1, isk = vv & 1; LAS float* p = (isk ? ks : qs) + ti * 128; const float x0 = p[F.lane], x1 = p[F.lane + 64];
            const float ss = wave_sum(x0 * x0 + x1 * x1); const float r = rsqrtf(ss + EPS) * (isk ? 1.f : 0.08838834764831845f); p[F.lane] = x0 * r; p[F.lane + 64] = x1 * r; }
        __syncthreads();
#pragma unroll 1
        for (int ti = 0; ti < ntok; ++ti) {
            float kk[32]; float p = 0.f;
#pragma unroll
            for (int i = 0; i < 32; ++i) { kk[i] = ks[ti * 128 + 32 * qd + i]; p += kk[i] * S[i]; }
            red[qd * 128 + dv] = p; __syncthreads();
            const float kS = (red[dv] + red[128 + dv]) + (red[256 + dv] + red[384 + dv]);
            const float eg = egs[ti], be = bes[ti], u = be * (vs[ti * 128 + dv] - eg * kS);
            float op = 0.f;
#pragma unroll
            for (int i = 0; i < 32; ++i) { S[i] = eg * S[i] + kk[i] * u; op += qs[ti * 128 + 32 * qd + i] * S[i]; }
            red2[qd * 128 + dv] = op; __syncthreads();
            if (qd == 0) { const float o = (red2[dv] + red2[128 + dv]) + (red2[256 + dv] + red2[384 + dv]);
                const int row = is_p ? prow(b, ch * 16 + ti) : XS + s;
                if (!is_p || ch > 0 || b == 0) OB[(size_t)row * DM + h * 128 + dv] = (bf16)f2bf(o); }
        }
        __syncthreads();
    }
    GAS float* so = is_p ? F.out + O_PDS + ((size_t)(b * GH + h) * GDK + 32 * qd) * GDV + dv : F.out + O_SDS + ((size_t)(s * GH + h) * GDK + 32 * qd) * GDV + dv;
#pragma unroll
    for (int i = 0; i < 32; ++i) so[(size_t)i * GDV] = S[i];
}

__device__ __forceinline__ void p3_gate(Frame& F) {
    const int gw = F.bid * 8 + F.wave, NGW = F.G * 8;
    const bf16* OB = (const bf16*)(F.ws + WS_TMP); const bf16* QKVZ = (const bf16*)(F.ws + WS_QKVZ); bf16* GO = (bf16*)(F.ws + WS_GO);
    const float* on = F.in[I_AONORM];
    f32x4 g4[4];
#pragma unroll
    for (int j = 0; j < 4; ++j) g4[j] = ((const f32x4*)on)[((16 * F.lane) & 127) / 4 + j];
    for (int row = gw; row < NVALID; row += NGW) {
        const v4u* op = (const v4u*)(OB + (size_t)row * DM + 16 * F.lane); const v4u* zp = (const v4u*)(QKVZ + (size_t)row * 4096 + 3072 + 16 * F.lane);
        f32x4 o[4]; float ss = 0.f; const v4u o0 = op[0], o1 = op[1]; const unsigned ow[8] = {o0.x, o0.y, o0.z, o0.w, o1.x, o1.y, o1.z, o1.w};
#pragma unroll
        for (int j = 0; j < 4; ++j) { o[j] = (f32x4){bflo(ow[2 * j]), bfhi(ow[2 * j]), bflo(ow[2 * j + 1]), bfhi(ow[2 * j + 1])}; ss += (o[j].x * o[j].x + o[j].y * o[j].y) + (o[j].z * o[j].z + o[j].w * o[j].w); }
        ss += DPPF(ss, 0xB1); ss += DPPF(ss, 0x4E); ss += DPPF(ss, 0x141);
        const float rstd = rsqrtf(ss * (1.f / 128.f) + EPS);
        const v4u z0 = zp[0], z1 = zp[1]; const unsigned zw[8] = {z0.x, z0.y, z0.z, z0.w, z1.x, z1.y, z1.z, z1.w};
        unsigned w[8];
#pragma unroll
        for (int j = 0; j < 4; ++j) { const f32x4 y = o[j] * rstd * g4[j];
            w[2 * j] = pk2(y.x * siluf(bflo(zw[2 * j])), y.y * siluf(bfhi(zw[2 * j]))); w[2 * j + 1] = pk2(y.z * siluf(bflo(zw[2 * j + 1])), y.w * siluf(bfhi(zw[2 * j + 1]))); }
        v4u* gp = (v4u*)(GO + (size_t)row * DM + 16 * F.lane); gp[0] = (v4u){w[0], w[1], w[2], w[3]}; gp[1] = (v4u){w[4], w[5], w[6], w[7]};
    }
    const int gt = F.bid * 512 + F.tid, NGT = F.G * 512;
    { const float* RAWQ = (const float*)(F.ws + WS_RAWQ);
      for (int i = gt; i < NB * 3 * GQKV; i += NGT) { const int c = i % GQKV, j = (i / GQKV) % 3, b = i / (3 * GQKV); F.out[O_PDC + i] = RAWQ[((size_t)(b * 32 + 31) * 6 + 3 + j) * GQKV + c]; } }
    for (int i = gt; i < NS * 3 * GQKV; i += NGT) { const int c = i % GQKV, j = (i / GQKV) % 3, s = i / (3 * GQKV);
        F.out[O_SDC + i] = j < 2 ? F.in[I_SDC][(size_t)(s * 3 + j + 1) * GQKV + c] : bf2f(QKVZ[(size_t)(XS + s) * 4096 + c]); }
}

template <bool LAST, bool FIRST = false> __device__ __forceinline__ void p_postnorm(Frame& F, const float* gpost) {
    const int gw = F.bid * 8 + F.wave, NGW = F.G * 8;
    const bf16* TMPB = (const bf16*)(F.ws + WS_TMP); bf16* XH = (bf16*)(F.ws + WS_XH); float* RS = (float*)(F.ws + WS_GEG + 65536);
    f32x4 g[4];
#pragma unroll
    for (int j = 0; j < 4; ++j) g[j] = ((const f32x4*)gpost)[64 * j + F.lane];
    static_assert(NVALID % 2 == 0, "two rows per wave iteration");
#pragma unroll 1
    for (int rb = gw * 2; rb < NVALID; rb += NGW * 2) {
        f32x4 t[2][4], x[2][4];
#pragma unroll
        for (int u = 0; u < 2; ++u) { const v2u* tp = (const v2u*)(TMPB + (size_t)(rb + u) * DM); const v2u* xb = (const v2u*)(XH + (size_t)(rb + u) * DM); const float iv = RS[rb + u];
#pragma unroll
            for (int j = 0; j < 4; ++j) { const v2u w = tp[64 * j + F.lane]; t[u][j] = (f32x4){bflo(w.x), bfhi(w.x), bflo(w.y), bfhi(w.y)};
                { const v2u q = xb[64 * j + F.lane]; x[u][j] = (f32x4){bflo(q.x), bfhi(q.x), bflo(q.y), bfhi(q.y)} * iv; } } }
#pragma unroll
        for (int u = 0; u < 2; ++u) { const int row = rb + u; float ss = 0.f;
#pragma unroll
            for (int j = 0; j < 4; ++j) ss += (t[u][j].x * t[u][j].x + t[u][j].y * t[u][j].y) + (t[u][j].z * t[u][j].z + t[u][j].w * t[u][j].w);
            ss = wave_sum(ss); const float rstd = rsqrtf(ss * (1.f / DM) + EPS); float s2 = 0.f;
#pragma unroll
            for (int j = 0; j < 4; ++j) { x[u][j] = x[u][j] + t[u][j] * rstd * g[j]; s2 += (x[u][j].x * x[u][j].x + x[u][j].y * x[u][j].y) + (x[u][j].z * x[u][j].z + x[u][j].w * x[u][j].w); }
            if (LAST) {
                GAS float* yo = row < TR ? F.out + O_YP + (size_t)row * DM : (row >= XS ? F.out + O_YS + (size_t)(row - XS) * DM : nullptr);
                if (yo) {
#pragma unroll
                    for (int j = 0; j < 4; ++j) ((f32x4*)yo)[64 * j + F.lane] = x[u][j]; }
            } else {
                s2 = wave_sum(s2); const float m2 = s2 * (1.f / DM) + EPS, r2 = rsqrtf(m2);
                unsigned long long* xh = (unsigned long long*)(XH + (size_t)row * DM);
                if (F.lane == 0) RS[row] = sqrtf(m2);
#pragma unroll
                for (int j = 0; j < 4; ++j) { const f32x4 y = x[u][j] * r2; xh[64 * j + F.lane] = (unsigned long long)pk2(y.x, y.y) | ((unsigned long long)pk2(y.z, y.w) << 32); }
            }
        }
    }
}

__device__ __forceinline__ void ld8(const bf16* p, float (&o)[8]) { const v4u w = *(const v4u*)p; o[0] = bflo(w.x); o[1] = bfhi(w.x); o[2] = bflo(w.y); o[3] = bfhi(w.y); o[4] = bflo(w.z); o[5] = bfhi(w.z); o[6] = bflo(w.w); o[7] = bfhi(w.w); }
__device__ __forceinline__ void ld8f(const float* p, float (&o)[8]) { const f32x4 a = ((const f32x4*)p)[0], b = ((const f32x4*)p)[1]; o[0] = a.x; o[1] = a.y; o[2] = a.z; o[3] = a.w; o[4] = b.x; o[5] = b.y; o[6] = b.z; o[7] = b.w; }
__device__ __forceinline__ int ffperm(int ch, int isv) { return 32 * (ch >> 4) + 16 * isv + (ch & 15); }
__device__ __forceinline__ void p_ffn_fix(Frame& F, int layer) {
    bf16* ACT = (bf16*)(F.ws + WS_ACT); const float* RAWH = (const float*)(F.ws + WS_RAWH); const float* RAWX = (const float*)(F.ws + WS_RAWX);
    const float* cw = F.in[I_FCONVW] + (size_t)layer * 3 * FF2; const float* cb = F.in[I_FCONVB] + (size_t)layer * FF2; const float* sfc = F.in[I_SFC] + (size_t)layer * NS * 2 * FF2;
    const int gt = F.bid * 512 + F.tid, NGT = F.G * 512; constexpr int CG = FF / 8, NG = TR / 64;
#pragma unroll 1
    for (int i = gt; i < (NG * 2 + NMETA + NS) * CG; i += NGT) {
        const int task = i / CG, ch0 = (i - task * CG) * 8, cog = ffperm(ch0, 0), cov = cog + 16;
        const float* p2; const float* p1; const float* p0; float k1 = 1.f, k0 = 1.f; int row; bool smp = false; int sidx = 0;
        if (task < NG * 2) { const int g = task >> 1, j = task & 1; row = 64 * g + j; const bool bstart = ((64 * g) & (SEQ - 1)) == 0;
            const float* prev3 = bstart ? RAWX + (size_t)15 * FF2 : RAWH + ((size_t)(g - 1) * 4 + 3) * FF2; const float* prev2 = bstart ? RAWX + (size_t)14 * FF2 : RAWH + ((size_t)(g - 1) * 4 + 2) * FF2;
            const float* c0 = RAWH + ((size_t)g * 4) * FF2; const float* c1 = c0 + FF2;
            if (j == 0) { p2 = c0; p1 = prev3; p0 = prev2; } else { p2 = c1; p1 = c0; p0 = prev3; } }
        else { const int rr = task - NG * 2; row = XM + rr; smp = rr >= NMETA; sidx = smp ? rr - NMETA : 0; p2 = RAWX + (size_t)rr * FF2;
            p1 = (!smp && rr >= 1) ? p2 - FF2 : RAWX; p0 = (!smp && rr >= 2) ? p2 - 2 * FF2 : RAWX; k1 = (!smp && rr >= 1) ? 1.f : 0.f; k0 = (!smp && rr >= 2) ? 1.f : 0.f; }
        float x2g[8], x2v[8], x1g[8], x1v[8], x0g[8], x0v[8], s1g[8], s1v[8], s0g[8], s0v[8];
        ld8f(p2 + cog, x2g); ld8f(p2 + cov, x2v); ld8f(p1 + cog, x1g); ld8f(p1 + cov, x1v); ld8f(p0 + cog, x0g); ld8f(p0 + cov, x0v);
        const float ks = smp ? 1.f : 0.f;
        ld8f(sfc + (size_t)(sidx * 2 + 1) * FF2 + ch0, s1g); ld8f(sfc + (size_t)(sidx * 2 + 1) * FF2 + FF + ch0, s1v); ld8f(sfc + (size_t)(sidx * 2) * FF2 + ch0, s0g); ld8f(sfc + (size_t)(sidx * 2) * FF2 + FF + ch0, s0v);
        float w0g[8], w1g[8], w2g[8], w0v[8], w1v[8], w2v[8], bg[8], bv[8];
        ld8f(cw + ch0, w0g); ld8f(cw + FF2 + ch0, w1g); ld8f(cw + 2 * FF2 + ch0, w2g); ld8f(cw + FF + ch0, w0v); ld8f(cw + FF2 + FF + ch0, w1v); ld8f(cw + 2 * FF2 + FF + ch0, w2v); ld8f(cb + ch0, bg); ld8f(cb + FF + ch0, bv);
        float a[8];
#pragma unroll
        for (int k = 0; k < 8; ++k) { const float q0g = k0 * x0g[k] + ks * s0g[k], q0v = k0 * x0v[k] + ks * s0v[k], q1g = k1 * x1g[k] + ks * s1g[k], q1v = k1 * x1v[k] + ks * s1v[k];
            const float ug = w0g[k] * q0g + w1g[k] * q1g + w2g[k] * x2g[k] + bg[k], uv = w0v[k] * q0v + w1v[k] * q1v + w2v[k] * x2v[k] + bv[k]; a[k] = siluf(ug) * uv; }
        *(v4u*)(ACT + (size_t)row * FF + ch0) = (v4u){pk2(a[0], a[1]), pk2(a[2], a[3]), pk2(a[4], a[5]), pk2(a[6], a[7])};
    }
    GAS float* pfc = F.out + O_PFC + (size_t)layer * NB * 2 * FF2; GAS float* sfo = F.out + O_SFC + (size_t)layer * NS * 2 * FF2;
    for (int i = gt; i < NB * 2 * FF2; i += NGT) { const int c = i % FF2, j = (i / FF2) & 1, b = i / (2 * FF2); const int isv = c >= FF ? 1 : 0; pfc[i] = RAWH[((size_t)(b * 32 + 31) * 4 + 2 + j) * FF2 + ffperm(c - isv * FF, isv)]; }
    for (int i = gt; i < NS * 2 * FF2; i += NGT) { const int c = i % FF2, j = (i / FF2) & 1, s_ = i / (2 * FF2); const int isv = c >= FF ? 1 : 0;
        sfo[i] = j == 0 ? sfc[(size_t)(s_ * 2 + 1) * FF2 + c] : RAWX[(size_t)(NMETA + s_) * FF2 + ffperm(c - isv * FF, isv)]; }
}

__device__ __forceinline__ void p_kvq(Frame& F) {
    const int gw = F.bid * 8 + F.wave, NGW = F.G * 8;
    const bf16* CK = (const bf16*)(F.ws + WS_CKVQ); bf16* CB = (bf16*)(F.ws + WS_CB); bf16* KRB = (bf16*)(F.ws + WS_KRB); bf16* QAN = (bf16*)(F.ws + WS_QAN);
    const float* ctab = (const float*)(F.ws + WS_ROPE); const float* stab = ctab + NPOSTAB * 32;
    const f32x4 gk = ((const f32x4*)F.in[I_KVANORM])[F.lane];
    float gq[6];
#pragma unroll
    for (int j = 0; j < 6; ++j) gq[j] = F.in[I_BQANORM][F.lane + 64 * j];
    for (int row = gw; row < NVALID; row += NGW) {
        const bf16* cr = CK + (size_t)row * 768;
        const v2u lw = ((const v2u*)cr)[F.lane]; f32x4 lat = {bflo(lw.x), bfhi(lw.x), bflo(lw.y), bfhi(lw.y)}; float ss = wave_sum((lat.x * lat.x + lat.y * lat.y) + (lat.z * lat.z + lat.w * lat.w));
        lat = lat * rsqrtf(ss * (1.f / KVL) + EPS) * gk;
        const int posidx = row < TR ? NMETA + (row & (SEQ - 1)) : (row < XS ? row - XM : LP);
        const int i = F.lane & 31; const float x1 = bf2f(cr[256 + i]), x2 = bf2f(cr[288 + i]), cs = ctab[posidx * 32 + i], sn = stab[posidx * 32 + i];
        const float kr = F.lane < 32 ? x1 * cs - x2 * sn : x2 * cs + x1 * sn;
        ((v2u*)(CB + (size_t)row * KVL))[F.lane] = (v2u){pk2(lat.x, lat.y), pk2(lat.z, lat.w)};
        KRB[(size_t)row * ROPE + F.lane] = (bf16)f2bf(kr);
        if (row < TR) { const int b = row >> 11, t = row & (SEQ - 1); ((f32x4*)(F.out + O_PKV + ((size_t)b * LP + NMETA + t) * KVL))[F.lane] = lat; F.out[O_PKR + ((size_t)b * LP + NMETA + t) * ROPE + F.lane] = kr; }
        else if (row < XS) { const int m = row - XM;
            for (int b = 0; b < NB; ++b) { ((f32x4*)(F.out + O_PKV + ((size_t)b * LP + m) * KVL))[F.lane] = lat; F.out[O_PKR + ((size_t)b * LP + m) * ROPE + F.lane] = kr; } }
        else { const int s = row - XS; ((f32x4*)(F.out + O_SKV + (size_t)s * KVL))[F.lane] = lat; F.out[O_SKR + (size_t)s * ROPE + F.lane] = kr; }
        float qa[6]; float sq = 0.f;
#pragma unroll
        for (int j = 0; j < 6; ++j) { qa[j] = bf2f(cr[320 + F.lane + 64 * j]); sq += qa[j] * qa[j]; }
        sq = wave_sum(sq); const float rq = rsqrtf(sq * (1.f / QL) + EPS);
#pragma unroll
        for (int j = 0; j < 6; ++j) QAN[(size_t)row * QL + F.lane + 64 * j] = (bf16)f2bf(qa[j] * rq * gq[j]);
    }
}
__device__ __forceinline__ void p_qrope(Frame& F) {
    const int gw = F.bid * 8 + F.wave, NGW = F.G * 8;
    bf16* Q = (bf16*)(F.ws + WS_Q); const float* ctab = (const float*)(F.ws + WS_ROPE); const float* stab = ctab + NPOSTAB * 32;
    for (int row = gw; row < NVALID; row += NGW) {
        const int posidx = row < TR ? NMETA + (row & (SEQ - 1)) : (row < XS ? row - XM : LP);
#pragma unroll
        for (int j = 0; j < 4; ++j) { const int idx = F.lane + 64 * j, h = idx >> 5, i = idx & 31; bf16* q = Q + (size_t)row * 1536 + h * HD + NOPE + i;
            const float x1 = bf2f(q[0]), x2 = bf2f(q[32]), cs = ctab[posidx * 32 + i], sn = stab[posidx * 32 + i];
            q[0] = (bf16)f2bf(x1 * cs - x2 * sn); q[32] = (bf16)f2bf(x2 * cs + x1 * sn); }
    }
}

constexpr int SHM_K = 64 * HD * 2, SHM_V = 64 * 128 * 2;
constexpr int ATT_K = 0, ATT_V = 2 * SHM_K, ATT_WS = ATT_V + 3 * SHM_V, ATT_QPE = ATT_WS + 8 * 64 * 4;
static_assert(ATT_QPE + 8 * 4096 <= CTLLDS_OFF, "attention LDS");
#define KSWZ(row, colB) ((row) * 384 + ((colB) ^ ((((row) >> 1) & 7) << 4)))
__device__ __forceinline__ int v_st(int k, int c) { const int kk = (k & ~0xC) | ((k & 4) << 1) | ((k & 8) >> 1); return ((kk >> 3) * 4 + (c >> 5)) * 512 + ((kk & 7) * 32 + (c & 31)) * 2; }
__device__ __forceinline__ int v_rd_base(int lane) { return ((lane & 3) << 3) | (((lane >> 2) & 3) << 6) | (((lane >> 4) & 1) << 5) | (((lane >> 5) & 1) << 8); }
constexpr int v_rd_off(int d0, int ks, int half) { return d0 * 512 + ks * 4096 + half * 2048; }
__device__ __forceinline__ int crow(int r, int hi) { return (r & 3) + 8 * (r >> 2) + 4 * hi; }
__device__ __forceinline__ unsigned cvtpk(float lo, float hi) { return pg8::cvt_pk_bf16(lo, hi); }
__device__ __forceinline__ bf16x8 pack8f(const f32x4 a, const f32x4 b) { v4u w = {cvtpk(a.x, a.y), cvtpk(a.z, a.w), cvtpk(b.x, b.y), cvtpk(b.z, b.w)}; return *reinterpret_cast<bf16x8*>(&w); }
__device__ __forceinline__ f32x4 mfma16(bf16x8 a, bf16x8 b, f32x4 c) { return __builtin_amdgcn_mfma_f32_16x16x32_bf16(a, b, c, 0, 0, 0); }
constexpr float ATT_THR = 8.f;
__device__ __forceinline__ void partialSM(f32x16& p0, f32x16& p1, float& m_reg, float& mn, float& alpha) {
    float pmax = p0[0];
#pragma unroll
    for (int r = 1; r < 16; ++r) pmax = fmaxf(pmax, p0[r]);
#pragma unroll
    for (int r = 0; r < 16; ++r) pmax = fmaxf(pmax, p1[r]);
    { auto rr = __builtin_amdgcn_permlane32_swap(__float_as_uint(pmax), __float_as_uint(pmax), false, false);
      pmax = fmaxf(__uint_as_float(rr[0]), __uint_as_float(rr[1])); }
    constexpr float C2 = 1.4426950408889634f * MLA_SCALE;
    if (__builtin_expect(__all((pmax - m_reg) * MLA_SCALE <= ATT_THR), 1)) { mn = m_reg; alpha = 1.f; }
    else { mn = fmaxf(m_reg, pmax); alpha = __builtin_amdgcn_exp2f((m_reg - mn) * C2); m_reg = mn; }
    const float mnL = -mn * C2;
#pragma unroll
    for (int r = 0; r < 16; ++r) p0[r] = fmaf(p0[r], C2, mnL);
#pragma unroll
    for (int r = 0; r < 16; ++r) p1[r] = fmaf(p1[r], C2, mnL);
#pragma unroll
    for (int r = 0; r < 16; ++r) p0[r] = __builtin_amdgcn_exp2f(p0[r]);
}
__device__ __forceinline__ void finishSM(f32x16& p0, f32x16& p1, float alpha, float& l_reg, bf16x8& pa0, bf16x8& pa1, bf16x8& pa2, bf16x8& pa3) {
#pragma unroll
    for (int r = 0; r < 16; ++r) p1[r] = __builtin_amdgcn_exp2f(p1[r]);
    float ps = 0;
#pragma unroll
    for (int r = 0; r < 16; ++r) ps += p0[r];
#pragma unroll
    for (int r = 0; r < 16; ++r) ps += p1[r];
    { auto rr = __builtin_amdgcn_permlane32_swap(__float_as_uint(ps), __float_as_uint(ps), false, false);
      ps = __uint_as_float(rr[0]) + __uint_as_float(rr[1]); }
    l_reg = l_reg * alpha + ps;
#define PK4(P, B_, OUT) do { unsigned a0 = cvtpk(P[B_+0], P[B_+1]), a1 = cvtpk(P[B_+2], P[B_+3]);                          \
        unsigned b0 = cvtpk(P[B_+4], P[B_+5]), b1 = cvtpk(P[B_+6], P[B_+7]);                                             \
        auto r0 = __builtin_amdgcn_permlane32_swap(a0, b0, false, false); auto r1 = __builtin_amdgcn_permlane32_swap(a1, b1, false, false); \
        v4u w = {r0[0], r1[0], r0[1], r1[1]}; OUT = *reinterpret_cast<bf16x8*>(&w); } while (0)
    PK4(p0, 0, pa0); PK4(p0, 8, pa1); PK4(p1, 0, pa2); PK4(p1, 8, pa3);
#undef PK4
}
__device__ __forceinline__ void qkt192(f32x16& p0, f32x16& p1, const LAS char* Kb, int r32, int hi, const bf16x8* qr, const LAS char* qpe) {
    p0 = f32x16{}; p1 = f32x16{};
    const LAS char* kb[4];
#pragma unroll
    for (int dd = 0; dd < 4; ++dd) kb[dd] = Kb + KSWZ(r32, (dd * 16 + hi * 8) * 2);
#pragma unroll
    for (int d0 = 0; d0 < 12; ++d0) { const LAS char* a = kb[d0 & 3] + (d0 >> 2) * 128;
        const bf16x8 b0 = *(const LAS bf16x8*)a, b1 = *(const LAS bf16x8*)(a + 32 * 384);
        const bf16x8 qf = d0 < 8 ? qr[d0 & 7] : *(const LAS bf16x8*)(qpe + (d0 & 3) * 1024);
        p0 = __builtin_amdgcn_mfma_f32_32x32x16_bf16(b0, qf, p0, 0, 0, 0);
        p1 = __builtin_amdgcn_mfma_f32_32x32x16_bf16(b1, qf, p1, 0, 0, 0);
        if ((d0 & 3) == 3) __builtin_amdgcn_sched_barrier(0); }
}
__device__ __forceinline__ void pv_tile(f32x16* o, int vb0, bf16x8 pa0, bf16x8 pa1, bf16x8 pa2, bf16x8 pa3) {
#define TRRD(dst, off) asm volatile("ds_read_b64_tr_b16 %0, %1 offset:%2" : "=&v"(dst) : "v"(vb0), "i"(off) : "memory")
#define PV_D0(d0) do { s16x4 l0, l1, l2, l3, h0, h1, h2, h3; constexpr int b_ = v_rd_off(d0, 0, 0); \
        TRRD(l0, b_); TRRD(h0, b_ + 2048); TRRD(l1, b_ + 4096); TRRD(h1, b_ + 6144); TRRD(l2, b_ + 8192); TRRD(h2, b_ + 10240); TRRD(l3, b_ + 12288); TRRD(h3, b_ + 14336); \
        asm volatile("s_waitcnt lgkmcnt(0)" ::: "memory"); __builtin_amdgcn_sched_barrier(0); \
        o[d0] = __builtin_amdgcn_mfma_f32_32x32x16_bf16(pa0, (bf16x8){l0[0], l0[1], l0[2], l0[3], h0[0], h0[1], h0[2], h0[3]}, o[d0], 0, 0, 0);   \
        o[d0] = __builtin_amdgcn_mfma_f32_32x32x16_bf16(pa1, (bf16x8){l1[0], l1[1], l1[2], l1[3], h1[0], h1[1], h1[2], h1[3]}, o[d0], 0, 0, 0);   \
        o[d0] = __builtin_amdgcn_mfma_f32_32x32x16_bf16(pa2, (bf16x8){l2[0], l2[1], l2[2], l2[3], h2[0], h2[1], h2[2], h2[3]}, o[d0], 0, 0, 0);   \
        o[d0] = __builtin_amdgcn_mfma_f32_32x32x16_bf16(pa3, (bf16x8){l3[0], l3[1], l3[2], l3[3], h3[0], h3[1], h3[2], h3[3]}, o[d0], 0, 0, 0); } while (0)
    PV_D0(0); PV_D0(1); PV_D0(2); PV_D0(3);
#undef PV_D0
#undef TRRD
}
__device__ __forceinline__ void attn_qblock(Frame& F, int b, int h, int qb) {
    const int wid = F.wave, lane = F.lane, r32 = lane & 31, hi = lane >> 5;
    const bf16* Q = (const bf16*)(F.ws + WS_Q); const bf16* KNV = (const bf16*)(F.ws + WS_KNV); const bf16* KRB = (const bf16*)(F.ws + WS_KRB); bf16* AO = (bf16*)(F.ws + WS_AO);
    LAS char* K_lds = (LAS char*)F.lds + ATT_K; LAS char* V_lds = (LAS char*)F.lds + ATT_V;
    LAS float* wsf = (LAS float*)(F.lds + ATT_WS) + wid * 64; LAS float* li_l = wsf; LAS float* al_l = wsf + 32;
    bf16x8 qr[8]; LAS char* qpe = (LAS char*)F.lds + ATT_QPE + wid * 4096 + lane * 16;
    { const bf16* qp = Q + (size_t)(b * SEQ + qb * 256 + wid * 32 + r32) * 1536 + h * HD + hi * 8;
#pragma unroll
      for (int d0 = 0; d0 < 8; ++d0) qr[d0] = *(const bf16x8*)(qp + d0 * 16);
      const float* ctab = (const float*)(F.ws + WS_ROPE); const float* stab = ctab + NPOSTAB * 32; const int pidx = (NMETA + qb * 256 + wid * 32 + r32) * 32 + hi * 8;
#pragma unroll
      for (int pr = 0; pr < 2; ++pr) { const v4u wa = *(const v4u*)(qp + (8 + pr) * 16), wb = *(const v4u*)(qp + (10 + pr) * 16);
          const f32x4 c0 = *(const f32x4*)(ctab + pidx + 16 * pr), c1 = *(const f32x4*)(ctab + pidx + 16 * pr + 4), s0 = *(const f32x4*)(stab + pidx + 16 * pr), s1 = *(const f32x4*)(stab + pidx + 16 * pr + 4);
          const float xa[8] = {bflo(wa.x), bfhi(wa.x), bflo(wa.y), bfhi(wa.y), bflo(wa.z), bfhi(wa.z), bflo(wa.w), bfhi(wa.w)}, xb[8] = {bflo(wb.x), bfhi(wb.x), bflo(wb.y), bfhi(wb.y), bflo(wb.z), bfhi(wb.z), bflo(wb.w), bfhi(wb.w)};
          const float cs[8] = {c0.x, c0.y, c0.z, c0.w, c1.x, c1.y, c1.z, c1.w}, sn[8] = {s0.x, s0.y, s0.z, s0.w, s1.x, s1.y, s1.z, s1.w};
          float oa[8], ob[8];
#pragma unroll
          for (int e = 0; e < 8; ++e) { oa[e] = xa[e] * cs[e] - xb[e] * sn[e]; ob[e] = xb[e] * cs[e] + xa[e] * sn[e]; }
          const v4u va = {cvtpk(oa[0], oa[1]), cvtpk(oa[2], oa[3]), cvtpk(oa[4], oa[5]), cvtpk(oa[6], oa[7])}, vb = {cvtpk(ob[0], ob[1]), cvtpk(ob[2], ob[3]), cvtpk(ob[4], ob[5]), cvtpk(ob[6], ob[7])};
          *(LAS v4u*)(qpe + pr * 1024) = va; *(LAS v4u*)(qpe + (2 + pr) * 1024) = vb; } }
    const int NT = 1 + 4 * (qb + 1);
    unsigned k0o[3], k1o[3], v0o[2], v1o[2];
#pragma unroll
    for (int j = 0; j < 3; ++j) { const int off = 1024 * (wid * 3 + j) + 16 * lane, row = off / 384, cb = off - row * 384, colB = cb ^ (((row >> 1) & 7) << 4), col = colB >> 1; const bool isr = col >= 128;
        const unsigned rb = isr ? (unsigned)(ROPE * 2) : 4096u, cpart = isr ? (unsigned)(WS_KRB + (size_t)(col - 128) * 2) : (unsigned)(WS_KNV + (size_t)(h * 128 + col) * 2);
        k0o[j] = (unsigned)(XM + (row < 16 ? row : 15)) * rb + cpart; k1o[j] = ((unsigned)(b * SEQ + row) * rb + cpart) | (isr ? 1u : 0u); }
#pragma unroll
    for (int j = 0; j < 2; ++j) { const int off = 1024 * (wid * 2 + j) + 16 * lane, sub = off >> 9, within = off & 511, kk = (sub >> 2) * 8 + (within >> 6), k = (kk & ~0xC) | ((kk & 4) << 1) | ((kk & 8) >> 1);
        const unsigned cpart = (unsigned)(WS_KNV + (size_t)(1024 + h * 128 + (sub & 3) * 32 + ((within & 63) >> 1)) * 2);
        v0o[j] = (unsigned)(XM + (k < 16 ? k : 15)) * 4096u + cpart; v1o[j] = (unsigned)(b * SEQ + k) * 4096u + cpart; }
    const GAS unsigned char* wsb = F.ws;
#define KDMA0(bi) do { _Pragma("unroll") for (int j_ = 0; j_ < 3; ++j_) __builtin_amdgcn_global_load_lds((const unsigned*)(wsb + k0o[j_]), (LAS unsigned*)(K_lds + (bi) * SHM_K + (wid * 3 + j_) * 1024), 16, 0, 0); } while (0)
#define VDMA0(bi) do { _Pragma("unroll") for (int j_ = 0; j_ < 2; ++j_) __builtin_amdgcn_global_load_lds((const unsigned*)(wsb + v0o[j_]), (LAS unsigned*)(V_lds + (bi) * SHM_V + (wid * 2 + j_) * 1024), 16, 0, 0); } while (0)
#define KDMA(t, bi) do { _Pragma("unroll") for (int j_ = 0; j_ < 3; ++j_) { const unsigned o_ = (k1o[j_] & ~1u) + (unsigned)((t) - 1) * ((k1o[j_] & 1u) ? 64u * (unsigned)(ROPE * 2) : 64u * 4096u); \
            __builtin_amdgcn_global_load_lds((const unsigned*)(wsb + o_), (LAS unsigned*)(K_lds + (bi) * SHM_K + (wid * 3 + j_) * 1024), 16, 0, 0); } } while (0)
#define VDMA(t, bi) do { _Pragma("unroll") for (int j_ = 0; j_ < 2; ++j_) { const unsigned o_ = v1o[j_] + (unsigned)((t) - 1) * (64u * 4096u); \
            __builtin_amdgcn_global_load_lds((const unsigned*)(wsb + o_), (LAS unsigned*)(V_lds + (bi) * SHM_V + (wid * 2 + j_) * 1024), 16, 0, 0); } } while (0)
    const int vb0 = (int)(unsigned)(uintptr_t)V_lds + v_rd_base(lane);
    const int qlo = qb * 256 + wid * 32, qm = qlo + r32 - 4 * hi;
    KDMA0(0); VDMA0(0); KDMA(1, 1); VDMA(1, 1);
    float m_reg = -1e30f, l_reg = 0.f; f32x16 o[4] = {};
    const float NEG = -__builtin_inff();
    f32x16 pA0, pA1, pB0, pB1; float mnA, mnB, alA, alB; bf16x8 pa0, pa1, pa2, pa3;
#define RESC(a) do { if (__any((a) < 1.f)) { if (hi == 0) al_l[r32] = (a); LDS_WAIT(); \
        _Pragma("unroll") for (int d_ = 0; d_ < 4; ++d_) _Pragma("unroll") for (int r = 0; r < 16; ++r) o[d_][r] *= al_l[crow(r, hi)]; } } while (0)
#define MASKT(P0_, P1_, t_) do { const int kb_ = ((t_) - 1) * 64; if (kb_ + 63 > qlo) { const int dq = qm - kb_; \
        _Pragma("unroll") for (int r = 0; r < 16; ++r) { const int c = (r & 3) + 8 * (r >> 2); if (dq - c < 0) P0_[r] = NEG; if (dq - c - 32 < 0) P1_[r] = NEG; } } } while (0)
    asm volatile("s_waitcnt vmcnt(5)" ::: "memory"); asm volatile("s_waitcnt lgkmcnt(0)" ::: "memory"); __builtin_amdgcn_s_barrier(); asm volatile("" ::: "memory");
    qkt192(pA0, pA1, K_lds, r32, hi, qr, qpe);
#pragma unroll
    for (int r = 0; r < 16; ++r) { const int c = (r & 3) + 8 * (r >> 2) + 4 * hi; if (c >= NMETA) pA0[r] = NEG; pA1[r] = NEG; }
    partialSM(pA0, pA1, m_reg, mnA, alA);
    int vprev = 0, vcur = 1;
#define HALF_STEP(PX0, PX1, mnX, alX, PY0, PY1, alY, t_) do { \
        asm volatile("s_waitcnt vmcnt(2)" ::: "memory"); asm volatile("s_waitcnt lgkmcnt(0)" ::: "memory"); __builtin_amdgcn_s_barrier(); asm volatile("" ::: "memory");     \
        const int vnext_ = vcur == 2 ? 0 : vcur + 1; \
        if ((t_) + 1 < NT) { KDMA((t_) + 1, ((t_) + 1) & 1); VDMA((t_) + 1, vnext_); } \
        qkt192(PX0, PX1, K_lds + ((t_) & 1) * SHM_K, r32, hi, qr, qpe); \
        finishSM(PY0, PY1, alY, l_reg, pa0, pa1, pa2, pa3); __builtin_amdgcn_sched_barrier(0); \
        pv_tile(o, vb0 + vprev * SHM_V, pa0, pa1, pa2, pa3); \
        MASKT(PX0, PX1, t_); partialSM(PX0, PX1, m_reg, mnX, alX); \
        RESC(alX); \
        vprev = vcur; vcur = vnext_; } while (0)
#pragma unroll 1
    for (int t = 1; t + 1 < NT; t += 2) {
        HALF_STEP(pB0, pB1, mnB, alB, pA0, pA1, alA, t);
        HALF_STEP(pA0, pA1, mnA, alA, pB0, pB1, alB, t + 1);
    }
    asm volatile("s_waitcnt vmcnt(0)" ::: "memory"); asm volatile("s_waitcnt lgkmcnt(0)" ::: "memory"); __builtin_amdgcn_s_barrier(); asm volatile("" ::: "memory");
    finishSM(pA0, pA1, alA, l_reg, pa0, pa1, pa2, pa3); __builtin_amdgcn_sched_barrier(0);
    pv_tile(o, vb0 + vprev * SHM_V, pa0, pa1, pa2, pa3);
#undef HALF_STEP
#undef MASKT
#undef RESC
    { int ln = F.lane; asm volatile("" : "+v"(ln));
      const int r32e = ln & 31, hie = ln >> 5; LAS float* li_e = (LAS float*)(F.lds + ATT_WS) + wid * 64;
      if (hie == 0) li_e[r32e] = l_reg; LDS_WAIT();
      bf16* Ow = (bf16*)(F.ws + WS_AO) + (size_t)(b * SEQ + qb * 256 + wid * 32) * DM + h * 128;
#pragma unroll
      for (int r = 0; r < 16; ++r) { const int orow = crow(r, hie); const float rl = __builtin_amdgcn_rcpf(li_e[orow]);
#pragma unroll
          for (int d0 = 0; d0 < 4; ++d0) { const float v = o[d0][r] * rl; const float vn = DPPF(v, 0xB1);
              if ((r32e & 1) == 0) *(unsigned*)(Ow + (size_t)orow * DM + d0 * 32 + r32e) = cvtpk(v, vn); } } }
    __syncthreads();
#undef KDMA
#undef VDMA
#undef KDMA0
#undef VDMA0
}
__device__ __forceinline__ void attn_meta(Frame& F) {
    const bf16* Q = (const bf16*)(F.ws + WS_Q); const bf16* KNV = (const bf16*)(F.ws + WS_KNV); const bf16* KRB = (const bf16*)(F.ws + WS_KRB); bf16* AO = (bf16*)(F.ws + WS_AO);
    for (int it = F.wave; it < NMETA * MH; it += 8) {
        const int m = it >> 3, h = it & 7;
        const bf16* q = Q + (size_t)(XM + m) * 1536 + h * HD;
        const float q0 = bf2f(q[F.lane]), q1 = bf2f(q[64 + F.lane]); float q2;
        { const float* ctab = (const float*)(F.ws + WS_ROPE); const float* stab = ctab + NPOSTAB * 32; const int i = F.lane & 31; const float x = bf2f(q[128 + F.lane]), y = [&]{ auto r_ = __builtin_amdgcn_permlane32_swap(__float_as_uint(x), __float_as_uint(x), false, false); return F.lane < 32 ? __uint_as_float(r_[1]) : __uint_as_float(r_[0]); }(), cs = ctab[m * 32 + i], sn = stab[m * 32 + i];
          q2 = F.lane < 32 ? x * cs - y * sn : x * cs + y * sn; }
        float sc[NMETA]; float mx = -1e30f;
#pragma unroll
        for (int k = 0; k < NMETA; ++k) { const bf16* kn = KNV + (size_t)(XM + k) * 2048 + h * 128; const float d = wave_sum(q0 * bf2f(kn[F.lane]) + q1 * bf2f(kn[64 + F.lane]) + q2 * bf2f(KRB[(size_t)(XM + k) * ROPE + F.lane]));
            sc[k] = k <= m ? d * MLA_SCALE : -1e30f; mx = fmaxf(mx, sc[k]); }
        float l = 0.f, o0 = 0.f, o1 = 0.f;
#pragma unroll
        for (int k = 0; k < NMETA; ++k) { const float p = k <= m ? __expf(sc[k] - mx) : 0.f; l += p; const bf16* v = KNV + (size_t)(XM + k) * 2048 + 1024 + h * 128; o0 += p * bf2f(v[F.lane]); o1 += p * bf2f(v[64 + F.lane]); }
        AO[(size_t)(XM + m) * DM + h * 128 + F.lane] = (bf16)f2bf(o0 / l); AO[(size_t)(XM + m) * DM + h * 128 + 64 + F.lane] = (bf16)f2bf(o1 / l);
    }
}
__device__ __forceinline__ void attn_sample_item(Frame& F, int s) {
    const int tid = F.tid, lane = F.lane, wid = F.wave;
    const bf16* Q = (const bf16*)(F.ws + WS_Q) + (size_t)(XS + s) * 1536;
    LAS float* qn = (LAS float*)F.lds;
    LAS float* qlat = qn + 8 * 192;
    LAS float* qpe = qlat + 8 * 256;
    LAS float* xm = qpe + 8 * 64;
    LAS float* xl = xm + 64;
    LAS float* ssf = xl + 64;
    LAS int* ptl = (LAS int*)(ssf + 64);
    LAS float* xo = (LAS float*)(ptl + 64);
    LAS float* olat = xo + 8 * 8 * 256;
    for (int i = tid; i < 8 * 192; i += 512) qn[i] = bf2f(Q[i]);
    if (tid < NPAGE) ptl[tid] = ((const int*)F.in[I_PT])[s * NPAGE + tid];
    __syncthreads();
    { const float* wuk = F.in[I_WUK] + wid * 128 + lane; const float q0 = qn[wid * 192 + lane], q1 = qn[wid * 192 + 64 + lane];
#pragma unroll 1
      for (int rb = 0; rb < 256; rb += 64) {
          float a[64];
#pragma unroll
          for (int r = 0; r < 64; ++r) { const float* w = wuk + (size_t)(rb + r) * 1024; a[r] = q0 * w[0] + q1 * w[64]; }
#pragma unroll
          for (int i = 0; i < 32; ++i) { auto r_ = __builtin_amdgcn_permlane32_swap(__float_as_uint(a[i]), __float_as_uint(a[i + 32]), false, false); a[i] = __uint_as_float(r_[0]) + __uint_as_float(r_[1]); }
#pragma unroll
          for (int i = 0; i < 16; ++i) { auto r_ = __builtin_amdgcn_permlane16_swap(__float_as_uint(a[i]), __float_as_uint(a[i + 16]), false, false); a[i] = __uint_as_float(r_[0]) + __uint_as_float(r_[1]); }
#define SA_DPP(x, ctrl) __builtin_bit_cast(float, __builtin_amdgcn_update_dpp(0, __builtin_bit_cast(int, (x)), (ctrl), 0xF, 0xF, false))
          { const bool b3 = (lane & 8) != 0, b2 = (lane & 4) != 0, b1 = (lane & 2) != 0, b0 = (lane & 1) != 0;
#pragma unroll
            for (int i = 0; i < 8; ++i) { const float keep = b3 ? a[i + 8] : a[i], send = b3 ? a[i] : a[i + 8]; a[i] = keep + SA_DPP(send, 0x140); }
#pragma unroll
            for (int i = 0; i < 4; ++i) { const float keep = b2 ? a[i + 4] : a[i], send = b2 ? a[i] : a[i + 4]; a[i] = keep + SA_DPP(send, 0x141); }
#pragma unroll
            for (int i = 0; i < 2; ++i) { const float keep = b1 ? a[i + 2] : a[i], send = b1 ? a[i] : a[i + 2]; a[i] = keep + SA_DPP(send, 0x1B); }
            { const float keep = b0 ? a[1] : a[0], send = b0 ? a[0] : a[1]; a[0] = keep + SA_DPP(send, 0xB1); } }
          qlat[wid * 256 + rb + lane] = a[0];
      }
      { const float* ctab = (const float*)(F.ws + WS_ROPE); const float* stab = ctab + NPOSTAB * 32; const int i = lane & 31; const float x1 = qn[wid * 192 + 128 + i], x2 = qn[wid * 192 + 160 + i], cs = ctab[LP * 32 + i], sn = stab[LP * 32 + i];
        qpe[tid] = lane < 32 ? x1 * cs - x2 * sn : x2 * cs + x1 * sn; } }
    __syncthreads();
    const GAS float* cs = F.out + O_SKV + (size_t)s * KVL; const GAS float* krs = F.out + O_SKR + (size_t)s * ROPE;
    { const f32x4 qv = *(const LAS f32x4*)(qlat + wid * 256 + 4 * lane), cv = ((const f32x4*)cs)[lane];
      const float d = wave_sum((qv.x * cv.x + qv.y * cv.y) + (qv.z * cv.z + qv.w * cv.w) + qpe[wid * 64 + lane] * krs[lane]); if (lane == 0) ssf[wid] = d * MLA_SCALE; }
    const int c16 = lane & 15, g = lane >> 4;
    LAS bf16x8* qfl = (LAS bf16x8*)(olat + 8 * 256);
#pragma unroll
    for (int ks = 0; ks < 10; ++ks) { f32x4 a = {0.f, 0.f, 0.f, 0.f}, b = a;
        if (c16 < 8) { const LAS float* qq = ks < 8 ? qlat + c16 * 256 + 32 * ks + 8 * g : qpe + c16 * 64 + 32 * (ks - 8) + 8 * g; a = *(const LAS f32x4*)qq; b = *(const LAS f32x4*)(qq + 4); }
        if (wid == 0) qfl[ks * 64 + lane] = pack8f(a, b); }
    __syncthreads();
    float o[8][4]; float m_run = -1e30f, l_run = 0.f;
#pragma unroll
    for (int h = 0; h < 8; ++h) { o[h][0] = 0.f; o[h][1] = 0.f; o[h][2] = 0.f; o[h][3] = 0.f; }
    const float* ckv = F.in[I_CKV]; const float* ckr = F.in[I_CKR];
    LAS char* vt = (LAS char*)xo + wid * (16 * 528);
    const unsigned lo_t = (unsigned)(c16 * KVL + 8 * g) * 4u, lo_r = (unsigned)(c16 * ROPE + 8 * g) * 4u;
    const char* ckvb = (const char*)ckv; const char* ckrb = (const char*)ckr;
#define SA_LOADT(gi_) do { const unsigned page_ = (unsigned)__builtin_amdgcn_readfirstlane(ptl[wid * 8 + ((gi_) >> 3)]); const unsigned row_ = page_ * (unsigned)PAGE + (unsigned)(((gi_) & 7) * 16); \
        const unsigned ka_ = row_ * (unsigned)(KVL * 4) + lo_t, ra_ = row_ * (unsigned)(ROPE * 4) + lo_r; \
        _Pragma("unroll") for (int ks = 0; ks < 8; ++ks) { t[2 * ks] = *(const f32x4*)(ckvb + (ka_ + 128u * ks)); t[2 * ks + 1] = *(const f32x4*)(ckvb + (ka_ + 128u * ks + 16u)); } \
        t[16] = *(const f32x4*)(ckrb + ra_); t[17] = *(const f32x4*)(ckrb + (ra_ + 16u)); t[18] = *(const f32x4*)(ckrb + (ra_ + 128u)); t[19] = *(const f32x4*)(ckrb + (ra_ + 144u)); } while (0)
    f32x4 t[20];
    SA_LOADT(0);
#pragma unroll 1
    for (int gi = 0; gi < 64; ++gi) {
        bf16x8 kf[10];
#pragma unroll
        for (int ks = 0; ks < 10; ++ks) kf[ks] = pack8f(t[2 * ks], t[2 * ks + 1]);
        __builtin_amdgcn_sched_barrier(0);
        if (gi < 63) SA_LOADT(gi + 1);
        __builtin_amdgcn_sched_barrier(0);
        f32x4 acc = {0.f, 0.f, 0.f, 0.f};
#pragma unroll
        for (int ks = 0; ks < 10; ++ks) acc = mfma16(kf[ks], qfl[ks * 64 + lane], acc);
#pragma unroll
        for (int ks = 0; ks < 8; ++ks) *(LAS bf16x8*)(vt + c16 * 528 + (32 * ks + 8 * g) * 2) = kf[ks];
        float sc[4], mx;
#pragma unroll
        for (int r = 0; r < 4; ++r) sc[r] = acc[r] * MLA_SCALE;
        mx = fmaxf(fmaxf(sc[0], sc[1]), fmaxf(sc[2], sc[3]));
        { auto r_ = __builtin_amdgcn_permlane16_swap(__float_as_uint(mx), __float_as_uint(mx), false, false); mx = fmaxf(__uint_as_float(r_[0]), __uint_as_float(r_[1])); }
        { auto r_ = __builtin_amdgcn_permlane32_swap(__float_as_uint(mx), __float_as_uint(mx), false, false); mx = fmaxf(__uint_as_float(r_[0]), __uint_as_float(r_[1])); }
        const float mnew = fmaxf(m_run, mx), alpha = __expf(m_run - mnew); float pr[4], ps;
#pragma unroll
        for (int r = 0; r < 4; ++r) pr[r] = __expf(sc[r] - mnew);
        ps = (pr[0] + pr[1]) + (pr[2] + pr[3]);
        { auto r_ = __builtin_amdgcn_permlane16_swap(__float_as_uint(ps), __float_as_uint(ps), false, false); ps = __uint_as_float(r_[0]) + __uint_as_float(r_[1]); }
        { auto r_ = __builtin_amdgcn_permlane32_swap(__float_as_uint(ps), __float_as_uint(ps), false, false); ps = __uint_as_float(r_[0]) + __uint_as_float(r_[1]); }
        l_run = l_run * alpha + ps; m_run = mnew;
        LDS_WAIT();
        v2u cw_[16];
#pragma unroll
        for (int k = 0; k < 16; ++k) cw_[k] = *(const LAS v2u*)(vt + k * 528 + lane * 8);
#pragma unroll
        for (int h = 0; h < 8; ++h) { const float ah = __builtin_bit_cast(float, __builtin_amdgcn_readlane(__builtin_bit_cast(int, alpha), h));
            o[h][0] *= ah; o[h][1] *= ah; o[h][2] *= ah; o[h][3] *= ah;
#pragma unroll
            for (int k = 0; k < 16; ++k) { const float pk = __builtin_bit_cast(float, __builtin_amdgcn_readlane(__builtin_bit_cast(int, pr[k & 3]), (k >> 2) * 16 + h));
                o[h][0] += pk * bflo(cw_[k].x); o[h][1] += pk * bfhi(cw_[k].x); o[h][2] += pk * bflo(cw_[k].y); o[h][3] += pk * bfhi(cw_[k].y); } }
    }
#undef SA_LOADT
#undef SA_DPP
    __syncthreads();
    if (lane < 8) { xm[wid * 8 + lane] = m_run; xl[wid * 8 + lane] = l_run; }
#pragma unroll
    for (int h = 0; h < 8; ++h) *(LAS f32x4*)(xo + (size_t)(wid * 8 + h) * 256 + 4 * lane) = (f32x4){o[h][0], o[h][1], o[h][2], o[h][3]};
    __syncthreads();
    for (int e = tid; e < 8 * 256; e += 512) { const int h = e >> 8, r = e & 255; const float ms = ssf[h]; float M = ms;
#pragma unroll
        for (int w = 0; w < 8; ++w) M = fmaxf(M, xm[w * 8 + h]);
        const float es = __expf(ms - M); float acc = es * cs[r], L = es;
#pragma unroll
        for (int w = 0; w < 8; ++w) { const float e_ = __expf(xm[w * 8 + h] - M); acc += xo[(size_t)(w * 8 + h) * 256 + r] * e_; L += xl[w * 8 + h] * e_; }
        olat[e] = acc / L; }
    __syncthreads();
    const float* wuv = F.in[I_WUV]; bf16* AO = (bf16*)(F.ws + WS_AO) + (size_t)(XS + s) * DM;
    for (int e = tid; e < 8 * 128; e += 512) { const int h = e >> 7; const LAS float* ol = olat + h * 256; float acc = 0.f;
#pragma unroll 8
        for (int r = 0; r < 256; ++r) acc += ol[r] * wuv[(size_t)r * 1024 + e];
        AO[e] = (bf16)f2bf(acc); }
    __syncthreads();
}

constexpr int NCHR = NB * 32 * GH, NCH = NCHR + GH;
constexpr int TS = 132;
constexpr int SREC = 57344;
constexpr int SR_W = 0, SR_Q = 16384, SR_AT = 32768, SR_KT = 40960;

struct PrepRaw { v4u x[6]; f32x4 fx[4][2]; float ab_a, ab_b; };
struct PrepW { f32x4 w[4][2]; };
__device__ __forceinline__ void gdn_prep_load(Frame& F, int ch, PrepRaw& R) {
    if (ch >= NCHR) return;
    const int tid = F.tid, h = ch & 7, bc = ch >> 3, b = bc >> 5, c = bc & 31, row0 = b * SEQ + c * 64;
    const bf16* QKVZ = (const bf16*)(F.ws + WS_QKVZ);
#pragma unroll
    for (int k = 0; k < 6; ++k) { const int uu = tid + 512 * k, tok = uu / 48, cg = uu - tok * 48, col0 = cg * 8, gcol = (col0 >> 7) * 1024 + h * 128 + (col0 & 127);
        R.x[k] = *(const v4u*)(QKVZ + (size_t)(row0 + tok) * 4096 + gcol); }
    if (tid < 144) { const int tok = tid / 48, cg = tid - tok * 48, col0 = cg * 8, gcol = (col0 >> 7) * 1024 + h * 128 + (col0 & 127), grp = b * 32 + c; const float* RAWQ = (const float*)(F.ws + WS_RAWQ);
#pragma unroll
        for (int j = 0; j < 4; ++j) { const int r = tok - 3 + j;
            if (r >= 0 || c > 0) { const float* p = RAWQ + ((size_t)(r >= 0 ? grp : grp - 1) * 6 + (r >= 0 ? r : 6 + r)) * GQKV + gcol; R.fx[j][0] = *(const f32x4*)p; R.fx[j][1] = *(const f32x4*)(p + 4); }
            else { const v4u q = *(const v4u*)(QKVZ + (size_t)(XM + NMETA + r) * 4096 + gcol); R.fx[j][0] = (f32x4){bflo(q.x), bfhi(q.x), bflo(q.y), bfhi(q.y)}; R.fx[j][1] = (f32x4){bflo(q.z), bfhi(q.z), bflo(q.w), bfhi(q.w)}; } } }
    if (F.wave == 7) { const float* AB = (const float*)(F.ws + WS_AB); R.ab_a = AB[(size_t)(row0 + F.lane) * 16 + h]; R.ab_b = AB[(size_t)(row0 + F.lane) * 16 + 8 + h]; }
}
__device__ __forceinline__ void gdn_prep_item(Frame& F, int ch, PrepRaw& R, int next_ch, const float* cwbase, float Ah, float dtb, const PrepW& W) {
    asm volatile("" : "+v"(F.tid), "+v"(F.lane));
    const int tid = F.tid, lane = F.lane, wave = F.wave;
    const bool meta = ch >= NCHR; const int h = ch & 7, bc = ch >> 3, b = bc >> 5, c = bc & 31;
    const int row0 = meta ? XM : b * SEQ + c * 64;
    LAS float* qf = (LAS float*)F.lds; LAS float* kf = qf + 64 * TS; LAS float* vf = kf + 64 * TS; LAS float* gcs = vf + 64 * TS; LAS float* bes = gcs + 64;
    GAS unsigned char* srec = F.ws + WS_SREC + (size_t)ch * SREC;
    const bf16* QKVZ = (const bf16*)(F.ws + WS_QKVZ);
    if (!meta) {
#pragma unroll
        for (int k = 0; k < 6; ++k) { const int uu = tid + 512 * k, tok = uu / 48, cg = uu - tok * 48, col0 = cg * 8, part = col0 >> 7, cc = col0 & 127;
            if (k == 0 && tid < 144) continue;
            const v4u q = R.x[k]; LAS float* tile = (part == 0 ? qf : (part == 1 ? kf : vf)) + tok * TS + cc;
            *(LAS f32x4*)tile = (f32x4){bflo(q.x), bfhi(q.x), bflo(q.y), bfhi(q.y)}; *(LAS f32x4*)(tile + 4) = (f32x4){bflo(q.z), bfhi(q.z), bflo(q.w), bfhi(q.w)}; }
        if (tid < 144) { const int tok = tid / 48, cg = tid - tok * 48, col0 = cg * 8, part = col0 >> 7, cc = col0 & 127;
            float acc8[8];
#pragma unroll
            for (int e = 0; e < 8; ++e) acc8[e] = 0.f;
#pragma unroll
            for (int j = 0; j < 4; ++j) { const float wj[8] = {W.w[j][0].x, W.w[j][0].y, W.w[j][0].z, W.w[j][0].w, W.w[j][1].x, W.w[j][1].y, W.w[j][1].z, W.w[j][1].w};
                const float xr[8] = {R.fx[j][0].x, R.fx[j][0].y, R.fx[j][0].z, R.fx[j][0].w, R.fx[j][1].x, R.fx[j][1].y, R.fx[j][1].z, R.fx[j][1].w};
#pragma unroll
                for (int e = 0; e < 8; ++e) acc8[e] += wj[e] * xr[e]; }
            LAS float* tile = (part == 0 ? qf : (part == 1 ? kf : vf)) + tok * TS + cc;
            *(LAS f32x4*)tile = (f32x4){siluf(acc8[0]), siluf(acc8[1]), siluf(acc8[2]), siluf(acc8[3])}; *(LAS f32x4*)(tile + 4) = (f32x4){siluf(acc8[4]), siluf(acc8[5]), siluf(acc8[6]), siluf(acc8[7])}; }
    } else if (tid < 384) {
        const int cg = tid % 48, tg = tid / 48, col0 = cg * 8, part = col0 >> 7, cc = col0 & 127, gcol = part * 1024 + h * 128 + cc;
        const float* cw = cwbase + gcol;
        float w[4][8];
#pragma unroll
        for (int j = 0; j < 4; ++j) ld8f(cw + j * GQKV, w[j]);
        float x[11][8];
#pragma unroll
        for (int r = 0; r < 11; ++r) { const int tt = 8 * tg - 3 + r; const bool ok = tt >= 0 && tt < NMETA; const float m_ = ok ? 1.f : 0.f;
            ld8(QKVZ + (size_t)(ok ? XM + tt : XM) * 4096 + gcol, x[r]);
#pragma unroll
            for (int e = 0; e < 8; ++e) x[r][e] *= m_; }
        LAS float* tile = part == 0 ? qf : (part == 1 ? kf : vf);
#pragma unroll
        for (int t = 0; t < 8; ++t) { const int tok = 8 * tg + t; float o[8];
#pragma unroll
            for (int e = 0; e < 8; ++e) { const float a = (w[0][e] * x[t][e] + w[1][e] * x[t + 1][e]) + (w[2][e] * x[t + 2][e] + w[3][e] * x[t + 3][e]); o[e] = tok >= NMETA ? 0.f : siluf(a); }
            *(LAS f32x4*)(tile + tok * TS + cc) = (f32x4){o[0], o[1], o[2], o[3]}; *(LAS f32x4*)(tile + tok * TS + cc + 4) = (f32x4){o[4], o[5], o[6], o[7]}; }
    }
    const float ab_a = R.ab_a, ab_b = R.ab_b;
    asm volatile("" ::: "memory"); gdn_prep_load(F, next_ch, R);
    if (wave == 7) {
        const bool nul = meta && lane >= NMETA; float a = ab_a, bb = ab_b;
        if (meta) { const float* AB = (const float*)(F.ws + WS_AB); const int row = nul ? XM : row0 + lane; a = AB[(size_t)row * 16 + h]; bb = AB[(size_t)row * 16 + 8 + h]; }
        const float x = a + dtb, sp = x > 20.f ? x : log1pf(__expf(x)); float g = nul ? 0.f : -Ah * sp;
#pragma unroll
        for (int o = 1; o < 64; o <<= 1) { const float t = __shfl_up(g, o); if (lane >= o) g += t; }
        gcs[lane] = g; bes[lane] = nul ? 0.f : 1.f / (1.f + __expf(-bb));
    }
    __syncthreads();
#ifndef PR2
#define PR2 1
#define PR3 1
#define PR4 1
#endif
    _Pragma("unroll 1") for (int pr2 = 0; pr2 < PR2; ++pr2)
#pragma unroll 8
    for (int v = wave * 16; v < wave * 16 + 16; ++v) { const int tok = v >> 1, isk = v & 1; LAS float* p = (isk ? kf : qf) + tok * TS; const float x0 = p[lane], x1 = p[lane + 64];
        const float ss = wave_sum(x0 * x0 + x1 * x1); const float r = rsqrtf(ss + EPS) * (isk ? 1.f : 0.08838834764831845f); p[lane] = x0 * r; p[lane + 64] = x1 * r; }
    __syncthreads();
    const int r16 = lane & 15, g = lane >> 4;
#pragma unroll 2
    for (int jj = wave; jj < 32 * PR3; jj += 8) {
        const bool isA = (jj & 31) < 16; const int ta = (jj >> 2) & 3, tb = jj & 3;
        const bool live = isA ? (tb <= ta) : (tb >= ta);
        f32x4 acc = {0.f, 0.f, 0.f, 0.f};
        if (live) {
            const LAS float* pa = kf + (16 * ta + r16) * TS + 8 * g; const LAS float* pb = (isA ? kf : qf) + (16 * tb + r16) * TS + 8 * g;
#pragma unroll
            for (int ks = 0; ks < 4; ++ks) { const bf16x8 fa = pack8f(*(const LAS f32x4*)(pa + 32 * ks), *(const LAS f32x4*)(pa + 32 * ks + 4)), fb = pack8f(*(const LAS f32x4*)(pb + 32 * ks), *(const LAS f32x4*)(pb + 32 * ks + 4));
                acc = mfma16(fa, fb, acc); }
        }
        if (isA) { if (live) { float* GA = (float*)(F.ws + WS_GA) + (size_t)ch * 4096; const int j = 16 * tb + r16; const float gj = gcs[j];
#pragma unroll
                for (int r = 0; r < 4; ++r) { const int i = 16 * ta + 4 * g + r; GA[i * 64 + j] = i > j ? bes[i] * __expf(gcs[i] - gj) * acc[r] : 0.f; } } }
        else { const int i = 16 * tb + r16; const float gi = gcs[i]; float v[4];
#pragma unroll
            for (int r = 0; r < 4; ++r) { const int j = 16 * ta + 4 * g + r; v[r] = (live && i >= j) ? __expf(gi - gcs[j]) * acc[r] : 0.f; }
            *(v2u*)(srec + SR_AT + ((tb * 2 + (ta >> 1)) * 64 + lane) * 16 + 8 * (ta & 1)) = (v2u){cvtpk(v[0], v[1]), cvtpk(v[2], v[3])}; }
    }
    const float glast = gcs[63];
#pragma unroll 4
    for (int q_ = 0; q_ < 8 * PR4; ++q_) { const int q = q_ & 7;
        const int which = q >> 1, f = (q & 1) * 8 + wave; float v[8];
        if (which == 0) { const int t = f >> 2, ks = f & 3, tok = 16 * t + r16; const float sc = __expf(gcs[tok]); const LAS float* p = qf + tok * TS + 32 * ks + 4 * g;
            const f32x4 a = *(const LAS f32x4*)p, bq = *(const LAS f32x4*)(p + 16);
            *(bf16x8*)(srec + SR_Q + (f * 64 + lane) * 16) = pack8f(a * sc, bq * sc); }
        else if (which == 1) { const int mt = f >> 1, ks = f & 1, dk = 16 * mt + r16;
#pragma unroll
            for (int e = 0; e < 8; ++e) { const int tok = 32 * ks + 16 * (e >> 2) + 4 * g + (e & 3); v[e] = kf[tok * TS + dk] * __expf(glast - gcs[tok]); }
            *(bf16x8*)(srec + SR_KT + (f * 64 + lane) * 16) = pack8f((f32x4){v[0], v[1], v[2], v[3]}, (f32x4){v[4], v[5], v[6], v[7]}); }
        else { const int nt = f >> 1, ks = f & 1, col = 16 * nt + r16; const LAS float* tile = which == 2 ? vf : kf;
#pragma unroll
            for (int e = 0; e < 8; ++e) { const int tok = 32 * ks + 8 * g + e; v[e] = tile[tok * TS + col] * bes[tok] * (which == 2 ? 1.f : __expf(gcs[tok])); }
            *(bf16x8*)(F.ws + (which == 2 ? WS_GRV : WS_GRK) + (size_t)ch * 16384 + (f * 64 + lane) * 16) = pack8f((f32x4){v[0], v[1], v[2], v[3]}, (f32x4){v[4], v[5], v[6], v[7]}); }
    }
    if (tid == 0) ((float*)(F.ws + WS_GEG))[ch] = __expf(glast);
    __syncthreads();
}

template <bool META> __device__ __forceinline__ void gdn_solve_item(Frame& F, int ch) {
    const int lane = F.lane, r16 = lane & 15, g = lane >> 4;
    LAS float* As = (LAS float*)F.lds + F.wave * 4096;
    { const f32x4* ga = (const f32x4*)((const float*)(F.ws + WS_GA) + (size_t)ch * 4096); f32x4 gr[16];
#pragma unroll
      for (int it = 0; it < 16; ++it) { const int e = it * 64 + lane; gr[it] = ga[((e & 15) < ((e >> 8) + 1) * 4) ? e : lane]; }
#pragma unroll
      for (int it = 0; it < 16; ++it) ((LAS f32x4*)As)[it * 64 + lane] = gr[it]; }
    LDS_WAIT();
    float x[64];
    x[0] = (lane == 0) ? 1.f : 0.f;
#pragma unroll
    for (int i = NMETA; i < 64; ++i) x[i] = (lane == i) ? 1.f : 0.f;
#pragma unroll
    for (int i = 1; i < (META ? NMETA : 64); ++i) {
        f32x4 av[16];
#pragma unroll
        for (int j4 = 0; j4 < (i + 3) / 4; ++j4) av[j4] = *(const LAS f32x4*)(As + i * 64 + 4 * j4);
        __builtin_amdgcn_sched_barrier(0);
        float a0 = (lane == i) ? 1.f : 0.f, a1 = 0.f, a2 = 0.f, a3 = 0.f;
#pragma unroll
        for (int j4 = 0; j4 < (i + 3) / 4; ++j4) {
            if (4 * j4 + 0 < i) a0 -= av[j4].x * x[4 * j4 + 0]; if (4 * j4 + 1 < i) a1 -= av[j4].y * x[4 * j4 + 1]; if (4 * j4 + 2 < i) a2 -= av[j4].z * x[4 * j4 + 2]; if (4 * j4 + 3 < i) a3 -= av[j4].w * x[4 * j4 + 3]; }
        x[i] = (a0 + a1) + (a2 + a3);
        __builtin_amdgcn_sched_barrier(0);
    }
    LDS_WAIT();
#pragma unroll
    for (int i = 0; i < 64; ++i) As[i * 64 + lane] = x[i];
    LDS_WAIT();
    bf16x8 Tf[4][2];
#pragma unroll
    for (int t = 0; t < 4; ++t)
#pragma unroll
        for (int ks = 0; ks < 2; ++ks) { const LAS float* p = As + (16 * t + r16) * 64 + 32 * ks + 8 * g; Tf[t][ks] = pack8f(*(const LAS f32x4*)p, *(const LAS f32x4*)(p + 4)); }
    const GAS unsigned char* grv = F.ws + WS_GRV + (size_t)ch * 16384; const GAS unsigned char* grk = F.ws + WS_GRK + (size_t)ch * 16384;
    GAS unsigned char* gu = F.ws + WS_GU + (size_t)ch * 16384; GAS unsigned char* gw = F.ws + WS_SREC + (size_t)ch * SREC + SR_W;
#pragma unroll 4
    for (int nt = 0; nt < 8; ++nt) { const bf16x8 b0 = *(const bf16x8*)(grv + ((nt * 2) * 64 + lane) * 16), b1 = *(const bf16x8*)(grv + ((nt * 2 + 1) * 64 + lane) * 16);
#pragma unroll
        for (int t = 0; t < 4; ++t) { f32x4 acc = {0.f, 0.f, 0.f, 0.f}; acc = mfma16(Tf[t][0], b0, acc); acc = mfma16(Tf[t][1], b1, acc);
            *(v2u*)(gu + ((nt * 4 + t) * 64 + lane) * 8) = (v2u){cvtpk(acc[0], acc[1]), cvtpk(acc[2], acc[3])}; } }
#pragma unroll 4
    for (int mt = 0; mt < 8; ++mt) { const bf16x8 a0 = *(const bf16x8*)(grk + ((mt * 2) * 64 + lane) * 16), a1 = *(const bf16x8*)(grk + ((mt * 2 + 1) * 64 + lane) * 16);
#pragma unroll
        for (int t = 0; t < 4; ++t) { f32x4 acc = {0.f, 0.f, 0.f, 0.f}; acc = mfma16(a0, Tf[t][0], acc); acc = mfma16(a1, Tf[t][1], acc);
            *(v2u*)(gw + ((t * 4 + (mt >> 1)) * 64 + lane) * 16 + 8 * (mt & 1)) = (v2u){cvtpk(-acc[0], -acc[1]), cvtpk(-acc[2], -acc[3])}; } }
}

__device__ __forceinline__ void gdn_scan_item(Frame& F, int item) {
    const int lane = F.lane, wave = F.wave, g = lane >> 4, c16 = lane & 15;
    const int half = item & 1, h = (item >> 1) & 7, b = item >> 4;
    const bool comp = wave < 4; const int cs0 = half * 64 + (wave & 3) * 16, ntu = cs0 >> 4;
    bf16* OB = (bf16*)(F.ws + WS_TMP); const float* GEG = (const float*)(F.ws + WS_GEG);
    LAS unsigned char* lds = F.lds;
#define SCAN_CH(n) ((n) == 0 ? NCHR + h : (b * 32 + (n) - 1) * 8 + h)
#define SCAN_DMA(n) do { const GAS unsigned char* src_ = F.ws + WS_SREC + (size_t)SCAN_CH(n) * SREC + lane * 16; LAS unsigned char* dst_ = lds + ((n) & 1) * SREC; \
        _Pragma("unroll") for (int i_ = 0; i_ < 7; ++i_) { const int p_ = i_ * 8 + wave; __builtin_amdgcn_global_load_lds((const unsigned*)(src_ + p_ * 1024), (LAS unsigned*)(dst_ + p_ * 1024), 16, 0, 0); } } while (0)
#define SCAN_U(n, dst) do { const GAS unsigned char* gu_ = F.ws + WS_GU + (size_t)SCAN_CH(n) * 16384; _Pragma("unroll") for (int t_ = 0; t_ < 4; ++t_) dst[t_] = *(const v2u*)(gu_ + ((ntu * 4 + t_) * 64 + lane) * 8); } while (0)
    f32x4 S[8];
#pragma unroll
    for (int m = 0; m < 8; ++m) S[m] = (f32x4){0.f, 0.f, 0.f, 0.f};
    v2u un[4] = {};
    SCAN_DMA(0); if (comp) SCAN_U(0, un);
#pragma unroll 1
    for (int n = 0; n <= 32; ++n) {
        VM_WAIT(); __syncthreads();
        v2u uc[4];
#pragma unroll
        for (int t = 0; t < 4; ++t) uc[t] = un[t];
        if (n < 32) { SCAN_DMA(n + 1); if (comp) SCAN_U(n + 1, un); }
        if (comp) {
            const LAS unsigned char* buf = lds + (n & 1) * SREC + lane * 16;
            const float eg = GEG[SCAN_CH(n)];
            bf16x8 Sb[4];
#pragma unroll
            for (int ks = 0; ks < 4; ++ks) Sb[ks] = pack8f(S[2 * ks], S[2 * ks + 1]);
            f32x4 av[4], ao[4];
#pragma unroll
            for (int t = 0; t < 4; ++t) { av[t] = (f32x4){bflo(uc[t].x), bfhi(uc[t].x), bflo(uc[t].y), bfhi(uc[t].y)}; ao[t] = (f32x4){0.f, 0.f, 0.f, 0.f}; }
#pragma unroll
            for (int t = 0; t < 4; ++t)
#pragma unroll
                for (int ks = 0; ks < 4; ++ks) { av[t] = mfma16(*(const LAS bf16x8*)(buf + SR_W + (t * 4 + ks) * 1024), Sb[ks], av[t]); ao[t] = mfma16(*(const LAS bf16x8*)(buf + SR_Q + (t * 4 + ks) * 1024), Sb[ks], ao[t]); }
            bf16x8 vb[2];
#pragma unroll
            for (int k = 0; k < 2; ++k) vb[k] = pack8f(av[2 * k], av[2 * k + 1]);
#pragma unroll
            for (int t = 0; t < 4; ++t)
#pragma unroll
                for (int k = 0; k < 2; ++k) if (32 * k <= 16 * t + 15) ao[t] = mfma16(*(const LAS bf16x8*)(buf + SR_AT + (t * 2 + k) * 1024), vb[k], ao[t]);
            if (n == 0) { if (b == 0) {
#pragma unroll
                    for (int r = 0; r < 4; ++r) { const float v = ao[0][r], vn = DPPF(v, 0xB1); if ((c16 & 1) == 0) *(unsigned*)(OB + (size_t)(XM + 4 * g + r) * DM + h * 128 + cs0 + c16) = cvtpk(v, vn); } } }
            else { bf16* op = OB + (size_t)(b * SEQ + (n - 1) * 64 + 4 * g) * DM + h * 128 + cs0 + c16;
#pragma unroll
                for (int t = 0; t < 4; ++t)
#pragma unroll
                    for (int r = 0; r < 4; ++r) { const float v = ao[t][r], vn = DPPF(v, 0xB1); if ((c16 & 1) == 0) *(unsigned*)(op + (size_t)(16 * t + r) * DM) = cvtpk(v, vn); } }
#pragma unroll
            for (int m = 0; m < 8; ++m) { S[m] = S[m] * eg;
#pragma unroll
                for (int k = 0; k < 2; ++k) S[m] = mfma16(*(const LAS bf16x8*)(buf + SR_KT + (m * 2 + k) * 1024), vb[k], S[m]); }
        }
    }
    if (comp) { GAS float* so = F.out + O_PDS + ((size_t)(b * GH + h) * GDK + 4 * g) * GDV + cs0 + c16;
#pragma unroll
        for (int m = 0; m < 8; ++m)
#pragma unroll
            for (int r = 0; r < 4; ++r) so[(size_t)(16 * m + r) * GDV] = S[m][r]; }
    __syncthreads();
#undef SCAN_CH
#undef SCAN_DMA
#undef SCAN_U
}

template <bool OUT_BF16> __device__ __forceinline__ void mini_gemm(Frame& F, const bf16* A, const bf16* Bt, int N, int K, void* out, int ldo) {
    const int lane = F.lane, c16 = lane & 15, g = lane >> 4, gw = F.wave * F.G + F.bid, NGW = F.G * 8;
    const int nct = N / 16;
#pragma unroll 1
    for (int task = gw; task < nct * 3; task += NGW) {
        const int ct = task % nct, rg = task / nct;
        const bf16* b0 = Bt + (size_t)(16 * ct + c16) * K + 8 * g; const bf16* a0 = A + (size_t)(TR + 48 * rg + c16) * K + 8 * g;
        f32x4 acc[3];
#pragma unroll
        for (int rt = 0; rt < 3; ++rt) acc[rt] = (f32x4){0.f, 0.f, 0.f, 0.f};
#define MG_LOAD(BF, AF, kk) do { _Pragma("unroll") for (int q = 0; q < 4; ++q) { BF[q] = *(const bf16x8*)(b0 + (kk) + 32 * q); \
            _Pragma("unroll") for (int rt = 0; rt < 3; ++rt) AF[q][rt] = *(const bf16x8*)(a0 + (size_t)(16 * rt) * K + (kk) + 32 * q); } } while (0)
#define MG_MMA(BF, AF) do { _Pragma("unroll") for (int q = 0; q < 4; ++q) { _Pragma("unroll") for (int rt = 0; rt < 3; ++rt) acc[rt] = mfma16(BF[q], AF[q][rt], acc[rt]); } } while (0)
        bf16x8 bfA[4], afA[4][3], bfB[4], afB[4][3];
        MG_LOAD(bfA, afA, 0);
#pragma unroll 1
        for (int k = 0; k < K; k += 256) {
            const bool hasB = k + 128 < K, hasA2 = k + 256 < K;
            if (hasB) MG_LOAD(bfB, afB, k + 128);
            __builtin_amdgcn_sched_barrier(0);
            MG_MMA(bfA, afA);
            __builtin_amdgcn_sched_barrier(0);
            if (hasA2) MG_LOAD(bfA, afA, k + 256);
            __builtin_amdgcn_sched_barrier(0);
            if (hasB) MG_MMA(bfB, afB);
            __builtin_amdgcn_sched_barrier(0);
        }
#undef MG_LOAD
#undef MG_MMA
#pragma unroll
        for (int rt = 0; rt < 3; ++rt) { const size_t o = (size_t)(48 * rg + 16 * rt + c16) * ldo + 16 * ct + 4 * g;
            if (OUT_BF16) *(v2u*)((bf16*)out + o) = (v2u){cvtpk(acc[rt][0], acc[rt][1]), cvtpk(acc[rt][2], acc[rt][3])};
            else *(f32x4*)((float*)out + o) = acc[rt]; }
    }
}

template <bool OUT_BF16> __device__ __forceinline__ void mini_gemm_deep(Frame& F, const bf16* A, const bf16* Bt, int N, int K, void* out, int ldo) {
    const int lane = F.lane, c16 = lane & 15, g = lane >> 4, gw = F.wave * F.G + F.bid, NGW = F.G * 8;
    const int nct = N / 16, nb = K / 128;
#pragma unroll 1
    for (int task = gw; task < nct * 9; task += NGW) {
        const int ct = task % nct, rt9 = task / nct;
        const bf16* b0 = Bt + (size_t)(16 * ct + c16) * K + 8 * g; const bf16* a0 = A + (size_t)(TR + 16 * rt9 + c16) * K + 8 * g;
        f32x4 acc = {0.f, 0.f, 0.f, 0.f};
        bf16x8 bq[4][4], aq[4][4];
#define MD_LOAD(i, kk) do { _Pragma("unroll") for (int q = 0; q < 4; ++q) { bq[i][q] = *(const bf16x8*)(b0 + (kk) + 32 * q); aq[i][q] = *(const bf16x8*)(a0 + (kk) + 32 * q); } } while (0)
#pragma unroll
        for (int i = 0; i < 4; ++i) MD_LOAD(i, 128 * i);
#pragma unroll 1
        for (int kb = 0; kb < nb; kb += 4) {
#pragma unroll
            for (int i = 0; i < 4; ++i) {
                if (kb + i < nb) {
#pragma unroll
                    for (int q = 0; q < 4; ++q) acc = mfma16(bq[i][q], aq[i][q], acc);
                    __builtin_amdgcn_sched_barrier(0);
                    if (kb + i + 4 < nb) MD_LOAD(i, 128 * (kb + i + 4));
                    __builtin_amdgcn_sched_barrier(0);
                }
            }
        }
#undef MD_LOAD
        const size_t o = (size_t)(16 * rt9 + c16) * ldo + 16 * ct + 4 * g;
        if (OUT_BF16) *(v2u*)((bf16*)out + o) = (v2u){cvtpk(acc[0], acc[1]), cvtpk(acc[2], acc[3])};
        else *(f32x4*)((float*)out + o) = acc;
    }
}

constexpr int NPHASE = 24;
__global__ void __launch_bounds__(512, 2) mk_fwd(Params P) {
    extern __shared__ __attribute__((aligned(16))) unsigned char lds_raw[];
    Frame F;
    F.lds = (LAS unsigned char*)lds_raw; F.tid = threadIdx.x; F.lane = F.tid & 63; F.wave = __builtin_amdgcn_readfirstlane(F.tid >> 6);
    F.G = gridDim.x; F.bid = blockIdx.x; F.in.t = (const LAS unsigned*)(F.lds + INTAB_OFF); F.out = (GAS float*)P.out; F.ws = (GAS unsigned char*)P.ws;
    volatile LAS unsigned* MISC = (volatile LAS unsigned*)(F.lds + MISC_OFF);
    for (int u = F.tid; u < (LDS_BYTES - CTLLDS_OFF) / 4; u += 512) ((LAS unsigned*)(F.lds + CTLLDS_OFF))[u] = 0u;
    __syncthreads();
    if (F.tid == 0) { LAS unsigned long long* tab = (LAS unsigned long long*)(F.lds + INTAB_OFF);
#pragma unroll
        for (int i = 0; i < N_IN; ++i) tab[i] = (unsigned long long)P.in[i]; }
    __syncthreads();
    const int lo = P.ph_lo, hi = P.ph_hi;
    XcdBarrier bar; bar.bar = (unsigned*)(P.ws + WS_CTL) + CW_BAR; bar.x = 0; bar.st = nullptr;
    if (hi - lo > 1) bar = xcd_barrier_post((unsigned*)(P.ws + WS_CTL) + CW_BAR, MISC + 8);
#ifndef REP_MASK
#define REP_MASK 0
#endif
#define REPN(k) ((((REP_MASK) >> (k)) & 1) + 1)
#define REP1(k) _Pragma("unroll 1") for (int r1_ = 0; r1_ < (((REP_MASK) >> (k)) & 1) + 1; ++r1_)
#define REP(k) _Pragma("unroll") for (int r_ = 0; r_ < (((REP_MASK) >> (k)) & 1) + 1; ++r_)
#define IN(k) (lo <= (k) && (k) < hi)
#define SEAM(k) do { if (IN(k) && IN((k) + 1)) { XcdBarrier b_; b_.bar = (unsigned*)(F.ws + WS_CTL) + CW_BAR; b_.x = bar.x; b_.st = (volatile LAS unsigned*)(F.lds + MISC_OFF) + 8; xcd_barrier(b_); } asm volatile("" : "+v"(F.tid), "+v"(F.lane)); asm volatile("" : "+s"(F.ws), "+s"(F.out)); ws = F.ws; } while (0)
    GAS unsigned char* ws = F.ws;
#define XH ((bf16*)(ws + WS_XH))
#define TMP ((float*)(ws + WS_TMP))

    if (IN(0)) REP(0) { p0_prologue(F, P); } SEAM(0);
    if (IN(1)) { pg8::Gemm g{XH, (const bf16*)(ws + WS_WIN), TR, 4096, DM}; pg8::StaticOrder S; S.init(TR, 4096, F.G, F.bid, REPN(1)); pg8::EpiInConv E{(bf16*)(ws + WS_QKVZ), (float*)(ws + WS_RAWQ), F.in[I_ACONV]};
        _Pragma("unroll 1") for (int pass_ = 0; pass_ < 2; ++pass_) { asm volatile("" : "+v"(F.tid), "+v"(F.lane));
            if (pass_ == ((F.bid >> 3) & 1)) pg8::gemm_phase<pg8::EpiInConv, pg8::StaticOrder, true, true>(F.lds, g, S, E);
            else mini_gemm<true>(F, XH, (const bf16*)(ws + WS_WIN), 4096, DM, (bf16*)(ws + WS_QKVZ) + (size_t)TR * 4096, 4096); } } SEAM(1);
    if (IN(2)) {
        REP1(2) { PrepRaw R; gdn_prep_load(F, F.bid, R); const int h_ = F.bid & 7; const float* cwbase = F.in[I_ACONV]; const float Ah = __expf(F.in[I_ALOG][h_]), dtb = F.in[I_ADT][h_];
          PrepW W; { const int t_ = F.tid < 144 ? F.tid : 0, cg = t_ % 48, col0 = cg * 8, gcol = (col0 >> 7) * 1024 + h_ * 128 + (col0 & 127);
#pragma unroll
            for (int j = 0; j < 4; ++j) { W.w[j][0] = *(const f32x4*)(cwbase + j * GQKV + gcol); W.w[j][1] = *(const f32x4*)(cwbase + j * GQKV + gcol + 4); } }
#pragma unroll 1
          for (int ch = F.bid; ch < NCH; ch += F.G) gdn_prep_item(F, ch, R, ch + F.G < NCH ? ch + F.G : ch, cwbase, Ah, dtb, W); }
        REP1(25)
#pragma unroll 1
        for (int it = F.bid; it < NS * GH; it += F.G) gdn_item(F, NB * GH + it); } SEAM(2);
    if (IN(3)) REP(3) {
#pragma unroll 1
        for (int ch = F.bid * 8 + F.wave; ch < NCHR; ch += F.G * 8) gdn_solve_item<false>(F, ch);
        { const int mw = (F.G - 1 - F.bid) * 8 + F.wave; if (mw < GH) gdn_solve_item<true>(F, NCHR + mw); } } SEAM(3);
    if (IN(4)) REP(4) {
#pragma unroll 1
        for (int it_ = F.bid; it_ < NB * GH * 2; it_ += F.G) { const int it = (F.G == 256) ? ((((it_ & 7) + 8 * (it_ >> 4)) << 1) | ((it_ >> 3) & 1)) : it_; gdn_scan_item(F, it); } } SEAM(4);
    if (IN(5)) REP(5) { p3_gate(F); } SEAM(5);
    if (IN(6)) { pg8::Gemm g{(const bf16*)(ws + WS_GO), (const bf16*)(ws + WS_WGOUT), TR, DM, DM}; pg8::StaticOrder S; S.init(TR, DM, F.G, F.bid, REPN(6)); pg8::EpiBf16 E{(bf16*)TMP, DM};
        pg8::gemm_phase<pg8::EpiBf16, pg8::StaticOrder, true, true>(F.lds, g, S, E);
        mini_gemm_deep<true>(F, (const bf16*)(ws + WS_GO), (const bf16*)(ws + WS_WGOUT), DM, DM, (bf16*)TMP + (size_t)TR * DM, DM); } SEAM(6);
    if (IN(7)) { p_postnorm<false, true>(F, F.in[I_ANPOST]); } SEAM(7);
    if (IN(8)) { pg8::Gemm g{XH, (const bf16*)(ws + WS_WUP0), TR, FF2, DM}; pg8::StaticOrder S; S.init(TR, FF2, F.G, F.bid, REPN(8)); pg8::EpiFfnAct E{(bf16*)(ws + WS_ACT), (float*)(ws + WS_RAWH), (float*)(ws + WS_RAWX), F.in[I_FCONVW] + (size_t)0 * 3 * FF2, F.in[I_FCONVB] + (size_t)0 * FF2, TR / 256};
        _Pragma("unroll 1") for (int pass_ = 0; pass_ < 2; ++pass_) { asm volatile("" : "+v"(F.tid), "+v"(F.lane));
            if (pass_ == ((F.bid >> 3) & 1)) pg8::gemm_phase<pg8::EpiFfnAct, pg8::StaticOrder, true, true>(F.lds, g, S, E);
            else mini_gemm<false>(F, XH, (const bf16*)(ws + WS_WUP0), FF2, DM, (float*)(ws + WS_RAWX), FF2); } } SEAM(8);
    if (IN(9)) REP(9) { p_ffn_fix(F, 0); } SEAM(9);
    if (IN(10)) { pg8::Gemm g{(const bf16*)(ws + WS_ACT), (const bf16*)(ws + WS_WDN0), TR, DM, FF}; pg8::StaticOrder S; S.init(TR, DM, F.G, F.bid, REPN(10)); pg8::EpiBf16 E{(bf16*)TMP, DM};
        pg8::gemm_phase<pg8::EpiBf16, pg8::StaticOrder, true, true>(F.lds, g, S, E);
        mini_gemm_deep<true>(F, (const bf16*)(ws + WS_ACT), (const bf16*)(ws + WS_WDN0), DM, FF, (bf16*)TMP + (size_t)TR * DM, DM); } SEAM(10);
    if (IN(11)) { p_postnorm<false>(F, F.in[I_FNPOST]); } SEAM(11);
    if (IN(12)) { pg8::Gemm g{XH, (const bf16*)(ws + WS_WKVQA), TR, 768, DM}; pg8::StaticOrder S; S.init(TR, 768, F.G, F.bid, REPN(12)); pg8::EpiBf16 E{(bf16*)(ws + WS_CKVQ), 768};
        pg8::gemm_phase<pg8::EpiBf16, pg8::StaticOrder, true, true>(F.lds, g, S, E);
        mini_gemm_deep<true>(F, XH, (const bf16*)(ws + WS_WKVQA), 768, DM, (bf16*)(ws + WS_CKVQ) + (size_t)TR * 768, 768); } SEAM(12);
    if (IN(13)) REP(13) { p_kvq(F); } SEAM(13);
    if (IN(14)) {
        { pg8::Gemm g{(const bf16*)(ws + WS_QAN), (const bf16*)(ws + WS_WQB), TR, 1536, QL}; pg8::StaticOrder S; S.init(TR, 1536, F.G, F.bid, REPN(14)); pg8::EpiBf16 E{(bf16*)(ws + WS_Q), 1536};
          pg8::gemm_phase<pg8::EpiBf16, pg8::StaticOrder, true, true>(F.lds, g, S, E); }
        __syncthreads();
        { pg8::Gemm g{(const bf16*)(ws + WS_CB), (const bf16*)(ws + WS_WUKV), TR, 2048, KVL}; pg8::StaticOrder S; S.init(TR, 2048, F.G, F.bid, REPN(14)); pg8::EpiBf16 E{(bf16*)(ws + WS_KNV), 2048};
          pg8::gemm_phase<pg8::EpiBf16, pg8::StaticOrder, true, true>(F.lds, g, S, E); }
        mini_gemm<true>(F, (const bf16*)(ws + WS_QAN), (const bf16*)(ws + WS_WQB), 1536, QL, (bf16*)(ws + WS_Q) + (size_t)TR * 1536, 1536);
        mini_gemm<true>(F, (const bf16*)(ws + WS_CB), (const bf16*)(ws + WS_WUKV), 2048, KVL, (bf16*)(ws + WS_KNV) + (size_t)TR * 2048, 2048);
    } SEAM(14);
    if (IN(16)) {
        if (F.bid == 0) attn_meta(F);
        volatile LAS int* qslot = (volatile LAS int*)(F.lds + MISC_OFF) + 16; unsigned* qctr = (unsigned*)(F.ws + WS_CTL) + CW_QUEUE;
#pragma unroll 1
        for (;;) {
            __syncthreads();
            if (F.tid == 0) qslot[0] = (int)__hip_atomic_fetch_add(qctr, 1u, __ATOMIC_RELAXED, __HIP_MEMORY_SCOPE_AGENT);
            __syncthreads();
            const int item = __builtin_amdgcn_readfirstlane(qslot[0]);
            if (item >= NS + NB * MH * 4) break;
            asm volatile("" : "+v"(F.tid), "+v"(F.lane));
            if (item < NS) attn_sample_item(F, item);
            else { const int L = item - NS, bh = L >> 2, x = L & 3;
#pragma unroll 1
                for (int pass = 0; pass < 2; ++pass) attn_qblock(F, bh >> 3, bh & 7, pass ? 7 - x : x); }
        }
    } SEAM(16);
    if (IN(18)) { pg8::Gemm g{(const bf16*)(ws + WS_AO), (const bf16*)(ws + WS_WMOUT), TR, DM, DM}; pg8::StaticOrder S; S.init(TR, DM, F.G, F.bid, REPN(18)); pg8::EpiBf16 E{(bf16*)TMP, DM};
        pg8::gemm_phase<pg8::EpiBf16, pg8::StaticOrder, true, true>(F.lds, g, S, E);
        mini_gemm_deep<true>(F, (const bf16*)(ws + WS_AO), (const bf16*)(ws + WS_WMOUT), DM, DM, (bf16*)TMP + (size_t)TR * DM, DM); } SEAM(18);
    if (IN(19)) { p_postnorm<false>(F, F.in[I_BNPOST]); } SEAM(19);
    if (IN(20)) { pg8::Gemm g{XH, (const bf16*)(ws + WS_WUP1), TR, FF2, DM}; pg8::StaticOrder S; S.init(TR, FF2, F.G, F.bid, REPN(20)); pg8::EpiFfnAct E{(bf16*)(ws + WS_ACT), (float*)(ws + WS_RAWH), (float*)(ws + WS_RAWX), F.in[I_FCONVW] + (size_t)1 * 3 * FF2, F.in[I_FCONVB] + (size_t)1 * FF2, TR / 256};
        _Pragma("unroll 1") for (int pass_ = 0; pass_ < 2; ++pass_) { asm volatile("" : "+v"(F.tid), "+v"(F.lane));
            if (pass_ == ((F.bid >> 3) & 1)) pg8::gemm_phase<pg8::EpiFfnAct, pg8::StaticOrder, true, true>(F.lds, g, S, E);
            else mini_gemm<false>(F, XH, (const bf16*)(ws + WS_WUP1), FF2, DM, (float*)(ws + WS_RAWX), FF2); } } SEAM(20);
    if (IN(21)) REP(21) { p_ffn_fix(F, 1); } SEAM(21);
    if (IN(22)) { pg8::Gemm g{(const bf16*)(ws + WS_ACT), (const bf16*)(ws + WS_WDN1), TR, DM, FF}; pg8::StaticOrder S; S.init(TR, DM, F.G, F.bid, REPN(22)); pg8::EpiBf16 E{(bf16*)TMP, DM};
        pg8::gemm_phase<pg8::EpiBf16, pg8::StaticOrder, true, true>(F.lds, g, S, E);
        mini_gemm_deep<true>(F, (const bf16*)(ws + WS_ACT), (const bf16*)(ws + WS_WDN1), DM, FF, (bf16*)TMP + (size_t)TR * DM, DM); } SEAM(22);
    if (IN(23)) REP(23) { p_postnorm<true>(F, F.in[I_FNPOST] + DM); }
#undef XH
#undef TMP
#undef IN
#undef SEAM
}

#ifndef MK_PER_PHASE
#define MK_PER_PHASE 0
#endif
extern "C" void kernel_launch(void* const* d_in, const int* in_sizes, int n_in, void* d_out, int out_size, void* d_ws, size_t ws_size, hipStream_t stream) {
    static int grid = 0;
    if (grid == 0) {
        if (n_in != N_IN || (size_t)out_size != O_END || ws_size < WS_END) { fprintf(stderr, "kernel_launch: unexpected shapes: n_in %d out %d ws %zu (need %zu)\n", n_in, out_size, ws_size, (size_t)WS_END); grid = -1; return; }
        int dev = 0, cus = 0, per_cu = 0;
        if (hipGetDevice(&dev) != hipSuccess || hipDeviceGetAttribute(&cus, hipDeviceAttributeMultiprocessorCount, dev) != hipSuccess) { grid = -1; return; }
        if (hipFuncSetAttribute((const void*)mk_fwd, hipFuncAttributeMaxDynamicSharedMemorySize, LDS_BYTES) != hipSuccess) { fprintf(stderr, "kernel_launch: hipFuncSetAttribute failed\n"); grid = -1; return; }
        if (hipOccupancyMaxActiveBlocksPerMultiprocessor(&per_cu, (const void*)mk_fwd, 512, LDS_BYTES) != hipSuccess || per_cu < 1) fprintf(stderr, "kernel_launch: occupancy query says %d\n", per_cu);
        (void)hipGetLastError();
        grid = cus & ~7;
    }
    if (grid < 0) return;
    (void)hipMemsetAsync((char*)d_ws + WS_CTL, 0, CTL_ZERO_BYTES, stream);
    Params P{};
    for (int i = 0; i < N_IN; ++i) P.in[i] = (const float*)d_in[i];
    P.out = (float*)d_out; P.ws = (unsigned char*)d_ws;
    unsigned char* ws = (unsigned char*)d_ws;
    const float* const* in = P.in;
    P.jobs[0] = ConvJob{in[I_AWIN], in[I_ANPRE], (bf16*)(ws + WS_WIN), DM, 4096, GIN, 0, 0, 0};
    P.jobs[1] = ConvJob{in[I_AWOUT], nullptr, (bf16*)(ws + WS_WGOUT), DM, DM, DM, 0, 0, 0};
    P.jobs[2] = ConvJob{in[I_FWUP], in[I_FNPRE], (bf16*)(ws + WS_WUP0), DM, FF2, FF2, 0, 1, 0};
    P.jobs[3] = ConvJob{in[I_FWUP] + (size_t)DM * FF2, in[I_FNPRE] + DM, (bf16*)(ws + WS_WUP1), DM, FF2, FF2, 0, 1, 0};
    P.jobs[4] = ConvJob{in[I_FWDOWN], nullptr, (bf16*)(ws + WS_WDN0), FF, DM, DM, 0, 0, 0};
    P.jobs[5] = ConvJob{in[I_FWDOWN] + (size_t)FF * DM, nullptr, (bf16*)(ws + WS_WDN1), FF, DM, DM, 0, 0, 0};
    P.jobs[6] = ConvJob{in[I_KVWA], in[I_KVNORM], (bf16*)(ws + WS_WKVQA), DM, 320, 320, 0, 0, 0};
    P.jobs[7] = ConvJob{in[I_BWQA], in[I_BNPRE], (bf16*)(ws + WS_WKVQA), DM, QL, QL, 320, 0, 0};
    P.jobs[8] = ConvJob{in[I_BWQB], nullptr, (bf16*)(ws + WS_WQB), QL, 1536, 1536, 0, 0, 0};
    P.jobs[9] = ConvJob{in[I_WUK], nullptr, (bf16*)(ws + WS_WUKV), KVL, 1024, 1024, 0, 0, 0};
    P.jobs[10] = ConvJob{in[I_WUV], nullptr, (bf16*)(ws + WS_WUKV), KVL, 1024, 1024, 1024, 0, 0};
    P.jobs[11] = ConvJob{in[I_BWOUT], nullptr, (bf16*)(ws + WS_WMOUT), DM, DM, DM, 0, 0, 0};
#if MK_PER_PHASE
    for (int ph = 0; ph < NPHASE; ++ph) { P.ph_lo = ph; P.ph_hi = ph + 1; hipLaunchKernelGGL(mk_fwd, dim3(grid), dim3(512), LDS_BYTES, stream, P); }
#else
    P.ph_lo = 0; P.ph_hi = NPHASE; hipLaunchKernelGGL(mk_fwd, dim3(grid), dim3(512), LDS_BYTES, stream, P);
#endif
    const hipError_t le = hipPeekAtLastError();
    if (le != hipSuccess) fprintf(stderr, "kernel_launch: launch failed: %s\n", hipGetErrorName(le));
}
```

```cpp
#include <hip/hip_runtime.h>
#include <cstdio>
#include <cstdint>
namespace pg8 {
#define PG8_LAS __attribute__((address_space(3)))
typedef unsigned short bf16_t;
typedef short bf16x8 __attribute__((ext_vector_type(8)));
typedef float f32x4 __attribute__((ext_vector_type(4)));
typedef unsigned u32x4 __attribute__((ext_vector_type(4)));
constexpr int BM = 256, BK = 64, HALF = 128, HTB = HALF * BK * 2  , STAGE_BYTES = 8 * HTB, NXCD = 8, WGM = 8;

__host__ __device__ __forceinline__ int lds_byte(int r, int c) { const int st = (r >> 4) * 2 + (c >> 5), rr = r & 15, cc = c & 31, ob = rr * 64 + cc * 2; return st * 1024 + (ob ^ (((ob >> 9) & 1) << 5)); }
__host__ __device__ __forceinline__ void stage_rc(int b, int& R, int& C) { const int st = b / 1024, sb = b % 1024, swz = sb ^ (((sb >> 9) & 1) << 5); R = (st >> 1) * 16 + swz / 64; C = (st & 1) * 32 + (swz % 64) / 2; }
__host__ __device__ __forceinline__ int perm32(int rho) { const int n = rho >> 4, i = rho & 15; return 8 * (i >> 2) + 4 * n + (i & 3); }

struct Unit { int pm, pn; };
struct Gemm { const bf16_t* A; const bf16_t* Bt; int M, N, K; };

struct StaticOrder {
    int nM, nN, nwg, G, c, rep;
    __host__ __device__ void init(int M, int N, int G_, int c_, int rep_ = 1) { nM = M / BM; nN = N / BM; nwg = nM * nN; G = G_; c = c_; rep = rep_; }
    __host__ __device__ bool next(int i, Unit& u) const {
        const long L = (long)i * G + c; if (L >= (long)nwg * rep) return false;
        int wgid = (int)(L % nwg); { const int q = nwg / NXCD, r = nwg % NXCD, xcd = wgid % NXCD, off = wgid / NXCD; wgid = (xcd < r ? xcd * (q + 1) : r * (q + 1) + (xcd - r) * q) + off; }
        const int nig = WGM * nN, gid = wgid / nig, fm = gid * WGM, gsz = (nM - fm) < WGM ? (nM - fm) : WGM;
        u.pm = fm + ((wgid % nig) % gsz); u.pn = (wgid % nig) / gsz; return true;
    }
    __device__ __forceinline__ void a_ready(const Unit&) const {}
    __device__ __forceinline__ void done(const Unit&) const {}
};
typedef float cvt_f32x2 __attribute__((ext_vector_type(2)));
typedef __bf16 cvt_bf16x2 __attribute__((ext_vector_type(2)));
__device__ __forceinline__ unsigned cvt_pk_bf16(float lo, float hi) { const cvt_f32x2 v = {lo, hi}; return __builtin_bit_cast(unsigned, __builtin_convertvector(v, cvt_bf16x2)); }
typedef float f32x2 __attribute__((ext_vector_type(2)));
struct EpiF32 {
    static constexpr bool PERM = false, AFTER_DRAIN = false, WPF = false;
    float* C; int ldc;
    __device__ __forceinline__ void operator()(const f32x4 (&acc)[2][2][4][2], const Unit& u, int wr, int wc, int fr, int fq) const {
        const int row0 = u.pm * BM + wr * 64 + fr, col0 = u.pn * BM + wc * 32 + 4 * fq;
#pragma unroll
        for (int ai = 0; ai < 2; ++ai)
#pragma unroll
            for (int m = 0; m < 4; ++m) { float* rowp = C + (size_t)(row0 + ai * HALF + m * 16) * ldc + col0;
#pragma unroll
                for (int bj = 0; bj < 2; ++bj)
#pragma unroll
                    for (int n = 0; n < 2; ++n) *(f32x4*)(rowp + bj * HALF + n * 16) = acc[ai][bj][m][n]; }
    }
};
struct EpiBf16 {
    static constexpr bool PERM = true, AFTER_DRAIN = false, WPF = false;
    bf16_t* O; int ldc;
    __device__ __forceinline__ void operator()(const f32x4 (&acc)[2][2][4][2], const Unit& u, int wr, int wc, int fr, int fq) const {
        const int row0 = u.pm * BM + wr * 64 + fr, col0 = u.pn * BM + wc * 32 + 8 * fq;
#pragma unroll
        for (int ai = 0; ai < 2; ++ai)
#pragma unroll
            for (int m = 0; m < 4; ++m) { bf16_t* rowp = O + (size_t)(row0 + ai * HALF + m * 16) * ldc + col0;
#pragma unroll
                for (int bj = 0; bj < 2; ++bj) { const f32x4 v0 = acc[ai][bj][m][0], v1 = acc[ai][bj][m][1];
                    u32x4 w; w.x = cvt_pk_bf16(v0[0], v0[1]); w.y = cvt_pk_bf16(v0[2], v0[3]); w.z = cvt_pk_bf16(v1[0], v1[1]); w.w = cvt_pk_bf16(v1[2], v1[3]);
                    *(u32x4*)(rowp + bj * HALF) = w; } }
    }
};
struct EpiFfnAct {
    static constexpr bool PERM = false, AFTER_DRAIN = false, WPF = true;
    static constexpr int WSLOT_OFF = 131072;
    __device__ __forceinline__ void prefetch(PG8_LAS unsigned char* lds, const Unit& u, int par, int wid, int lane) const {
        constexpr int FFC = 2816, FF2C = 5632;
        if (wid < 4) { const int s_ = 2 * wid + (lane >> 5), isv = s_ & 1, tap = s_ >> 1; const float* src = (tap < 3 ? cw + tap * FF2C : cb) + isv * FFC + 128 * u.pn + (lane & 31) * 4;
            __builtin_amdgcn_global_load_lds((const unsigned*)src, (PG8_LAS unsigned*)(lds + WSLOT_OFF + par * 4096 + wid * 1024), 16, 0, 0); }
    }
    bf16_t* ACT; float* RAWH; float* RAWX; const float* cw; const float* cb; int nrealp;
    static __device__ __forceinline__ float shr_prev(float prev, float x, int) { return x; }
    template <int D> static __device__ __forceinline__ float rowprev(float prev, float x) {
        const int o = __builtin_amdgcn_update_dpp(0, __builtin_bit_cast(int, prev), 0x100 + (16 - D), 0xF, 0xF, true);
        return __builtin_bit_cast(float, __builtin_amdgcn_update_dpp(o, __builtin_bit_cast(int, x), 0x110 + D, 0xF, 0xF, false));
    }
    __device__ __forceinline__ void operator()(const f32x4 (&acc)[2][2][4][2], const Unit& u, int wr, int wc, int fr, int fq, PG8_LAS unsigned char* lds, int par) const {
        constexpr int FFC = 2816, FF2C = 5632;
        f32x4 w0g[2], w1g[2], w2g[2], w0v[2], w1v[2], w2v[2], bg[2], bv[2];
        const PG8_LAS float* ws_ = (const PG8_LAS float*)(lds + WSLOT_OFF + par * 4096);
#pragma unroll
        for (int bj = 0; bj < 2; ++bj) { const int cl = 16 * (4 * bj + wc) + 4 * fq;
            w0g[bj] = *(const PG8_LAS f32x4*)(ws_ + cl); w0v[bj] = *(const PG8_LAS f32x4*)(ws_ + 128 + cl); w1g[bj] = *(const PG8_LAS f32x4*)(ws_ + 256 + cl); w1v[bj] = *(const PG8_LAS f32x4*)(ws_ + 384 + cl);
            w2g[bj] = *(const PG8_LAS f32x4*)(ws_ + 512 + cl); w2v[bj] = *(const PG8_LAS f32x4*)(ws_ + 640 + cl); bg[bj] = *(const PG8_LAS f32x4*)(ws_ + 768 + cl); bv[bj] = *(const PG8_LAS f32x4*)(ws_ + 896 + cl); }
#pragma unroll
        for (int bj = 0; bj < 2; ++bj)
#pragma unroll
            for (int ai = 0; ai < 2; ++ai) {
                const int G = 8 * u.pn + 4 * bj + wc, ch0 = 16 * G + 4 * fq, co0 = 32 * G + 4 * fq;
                const int rowg = u.pm * BM + ai * HALF + wr * 64;
#pragma unroll
                for (int m = 0; m < 4; ++m) {
                    const f32x4 xg = acc[ai][bj][m][0], xv = acc[ai][bj][m][1];
                    const f32x4 pg = m > 0 ? acc[ai][bj][m > 0 ? m - 1 : 0][0] : (f32x4){0.f, 0.f, 0.f, 0.f}, pv = m > 0 ? acc[ai][bj][m > 0 ? m - 1 : 0][1] : (f32x4){0.f, 0.f, 0.f, 0.f};
                    f32x4 g1, g2, v1, v2;
#pragma unroll
                    for (int e = 0; e < 4; ++e) { g1[e] = rowprev<1>(pg[e], xg[e]); g2[e] = rowprev<2>(pg[e], xg[e]); v1[e] = rowprev<1>(pv[e], xv[e]); v2[e] = rowprev<2>(pv[e], xv[e]); }
                    const f32x4 ug = w0g[bj] * g2 + w1g[bj] * g1 + w2g[bj] * xg + bg[bj], uv = w0v[bj] * v2 + w1v[bj] * v1 + w2v[bj] * xv + bv[bj];
                    const f32x4 den = ug * (-1.4426950408889634f); f32x4 sg;
#pragma unroll
                    for (int e = 0; e < 4; ++e) sg[e] = __builtin_amdgcn_rcpf(1.f + __builtin_amdgcn_exp2f(den[e]));
                    const f32x4 a = ug * sg * uv;
                    typedef unsigned u32x2 __attribute__((ext_vector_type(2)));
                    *(u32x2*)(ACT + (size_t)(rowg + 16 * m + fr) * FFC + ch0) = (u32x2){cvt_pk_bf16(a[0], a[1]), cvt_pk_bf16(a[2], a[3])};
                    if (m == 0 && fr < 2) { float* rp = RAWH + ((size_t)(rowg >> 6) * 4 + fr) * FF2C + co0; *(f32x4*)rp = xg; *(f32x4*)(rp + 16) = xv; }
                    if (m == 3 && fr >= 14) { float* rp = RAWH + ((size_t)(rowg >> 6) * 4 + 2 + (fr - 14)) * FF2C + co0; *(f32x4*)rp = xg; *(f32x4*)(rp + 16) = xv; }
                }
            }
    }
};
struct EpiInConv {
    static constexpr bool PERM = true, AFTER_DRAIN = false, WPF = true;
    bf16_t* O; float* RAWQ; const float* cw;
    __device__ __forceinline__ void prefetch(PG8_LAS unsigned char* lds, const Unit& u, int par, int wid, int lane) const {
        if (wid < 4 && u.pn * BM < 3072) __builtin_amdgcn_global_load_lds((const unsigned*)(cw + wid * 3072 + u.pn * BM + lane * 4), (PG8_LAS unsigned*)(lds + EpiFfnAct::WSLOT_OFF + par * 4096 + wid * 1024), 16, 0, 0);
    }
    __device__ __forceinline__ void operator()(const f32x4 (&acc)[2][2][4][2], const Unit& u, int wr, int wc, int fr, int fq, PG8_LAS unsigned char* lds, int par) const {
        constexpr int LDO = 4096, NQKV = 3072;
        const bool conv = u.pn * BM < NQKV;
        const PG8_LAS float* ws_ = (const PG8_LAS float*)(lds + EpiFfnAct::WSLOT_OFF + par * 4096);
#pragma unroll
        for (int bj = 0; bj < 2; ++bj) {
            asm volatile("" ::: "memory");
            const int col0 = u.pn * BM + bj * HALF + wc * 32 + 8 * fq;
            f32x4 w[4][2];
#pragma unroll
            for (int j = 0; j < 4; ++j) { const int cl = bj * HALF + wc * 32 + 8 * fq; w[j][0] = *(const PG8_LAS f32x4*)(ws_ + j * 256 + cl); w[j][1] = *(const PG8_LAS f32x4*)(ws_ + j * 256 + cl + 4); }
#pragma unroll
            for (int ai = 0; ai < 2; ++ai) {
                const int rowg = u.pm * BM + ai * HALF + wr * 64;
#pragma unroll
                for (int m = 0; m < 4; ++m) {
                    f32x4 o[2];
#pragma unroll
                    for (int n = 0; n < 2; ++n) { const f32x4 x = acc[ai][bj][m][n]; const f32x4 pz = {0.f, 0.f, 0.f, 0.f}; const f32x4 p = m > 0 ? acc[ai][bj][m > 0 ? m - 1 : 0][n] : pz;
                        if (conv) { f32x4 x1, x2, x3;
#pragma unroll
                            for (int e = 0; e < 4; ++e) { x1[e] = EpiFfnAct::rowprev<1>(p[e], x[e]); x2[e] = EpiFfnAct::rowprev<2>(p[e], x[e]); x3[e] = EpiFfnAct::rowprev<3>(p[e], x[e]); }
                            const f32x4 a = (w[0][n] * x3 + w[1][n] * x2) + (w[2][n] * x1 + w[3][n] * x), den = a * (-1.4426950408889634f); f32x4 sg;
#pragma unroll
                            for (int e = 0; e < 4; ++e) sg[e] = __builtin_amdgcn_rcpf(1.f + __builtin_amdgcn_exp2f(den[e]));
                            o[n] = a * sg;
                        } else o[n] = x; }
                    u32x4 wv; wv.x = cvt_pk_bf16(o[0][0], o[0][1]); wv.y = cvt_pk_bf16(o[0][2], o[0][3]); wv.z = cvt_pk_bf16(o[1][0], o[1][1]); wv.w = cvt_pk_bf16(o[1][2], o[1][3]);
                    *(u32x4*)(O + (size_t)(rowg + 16 * m + fr) * LDO + col0) = wv;
                    if (conv) {
                        if (m == 0 && fr < 3) { float* rp = RAWQ + ((size_t)(rowg >> 6) * 6 + fr) * NQKV + col0; *(f32x4*)rp = acc[ai][bj][m][0]; *(f32x4*)(rp + 4) = acc[ai][bj][m][1]; }
                        if (m == 3 && fr >= 13) { float* rp = RAWQ + ((size_t)(rowg >> 6) * 6 + 3 + (fr - 13)) * NQKV + col0; *(f32x4*)rp = acc[ai][bj][m][0]; *(f32x4*)(rp + 4) = acc[ai][bj][m][1]; }
                    }
                }
            }
        }
    }
};
template <class Epi, class Sched, bool ALIGN_EPI = false, bool SP2 = false>
__device__ __forceinline__ void gemm_phase(PG8_LAS unsigned char* lds, const Gemm g, const Sched& S, const Epi& E) {
    int tid_ = threadIdx.x; asm volatile("" : "+v"(tid_));
    const int tid = tid_, wid = __builtin_amdgcn_readfirstlane(tid >> 6), lane = tid & 63, wr = wid >> 2, wc = wid & 3, fr = lane & 15, fq = lane >> 4;
    const int K = g.K, nt = K / BK;
    unsigned voffA[2], voffB[2];
#pragma unroll
    for (int i = 0; i < 2; ++i) { int R, C; stage_rc(tid * 16 + i * 8192, R, C); const int Rb = Epi::PERM ? ((R & ~31) + perm32(R & 31)) : R;
        voffA[i] = (unsigned)(R * K + C) * 2u; voffB[i] = (unsigned)(Rb * K + C) * 2u; }
    const size_t kstep = (size_t)(BK * 2);
    const size_t hstep = (size_t)HALF * K * 2;
    const size_t tstep = 2 * hstep;
    const unsigned ldsw = (unsigned)wid * 1024u;
    const int aoff = lds_byte(wr * 64 + fr, fq * 8), boff = lds_byte(wc * 32 + fr, fq * 8);
#define PG8_SA(b, h) (((b) * 2 + (h)) * HTB)
#define PG8_SB(b, h) ((4 + (b) * 2 + (h)) * HTB)
#define PG8_STAGE(bufoff, gbase, voff) do { _Pragma("unroll") for (int _i = 0; _i < 2; ++_i) \
        __builtin_amdgcn_global_load_lds((const unsigned*)((const char*)(gbase) + (voff)[_i]), (PG8_LAS unsigned*)(lds + (bufoff) + ldsw + _i * 8192), 16, 0, 0); } while (0)
#define PG8_LDA(dst, b, h) do { _Pragma("unroll") for (int m = 0; m < 4; ++m) _Pragma("unroll") for (int k = 0; k < 2; ++k) dst[m][k] = *(const PG8_LAS bf16x8*)(lds + PG8_SA(b, h) + aoff + m * 2048 + k * 1024); } while (0)
#define PG8_LDB(dst, b, h) do { _Pragma("unroll") for (int n = 0; n < 2; ++n) _Pragma("unroll") for (int k = 0; k < 2; ++k) dst[n][k] = *(const PG8_LAS bf16x8*)(lds + PG8_SB(b, h) + boff + n * 2048 + k * 1024); } while (0)
#define PG8_MMA(ai, bj, At, Bt) do { __builtin_amdgcn_s_setprio(1); _Pragma("unroll") for (int m = 0; m < 4; ++m) _Pragma("unroll") for (int n = 0; n < 2; ++n) _Pragma("unroll") for (int k = 0; k < 2; ++k) \
        acc[ai][bj][m][n] = __builtin_amdgcn_mfma_f32_16x16x32_bf16(Bt[n][k], At[m][k], acc[ai][bj][m][n], 0, 0, 0); __builtin_amdgcn_s_setprio(0); } while (0)
#define PG8_WAIT_V(n) asm volatile("s_waitcnt vmcnt(" #n ")" ::: "memory")
#define PG8_WAIT_L(n) asm volatile("s_waitcnt lgkmcnt(" #n ")" ::: "memory")
#define PG8_BAR __builtin_amdgcn_s_barrier()
#define PG8_SCHED __builtin_amdgcn_sched_barrier(0)
    Unit cur, nxt; int ui = 0;
    if (!S.next(0, cur)) return;
    f32x4 acc[2][2][4][2];
#pragma unroll
    for (int a = 0; a < 2; ++a)
#pragma unroll
        for (int b = 0; b < 2; ++b)
#pragma unroll
            for (int m = 0; m < 4; ++m)
#pragma unroll
                for (int n = 0; n < 2; ++n) acc[a][b][m][n] = (f32x4){0.f, 0.f, 0.f, 0.f};
    bf16x8 At[4][2], B0[2][2], B1[2][2];
    const char* cA = (const char*)g.A + (size_t)cur.pm * tstep; const char* cB = (const char*)g.Bt + (size_t)cur.pn * tstep;
    S.a_ready(cur);
    if constexpr (Epi::WPF) E.prefetch(lds, cur, 0, wid, lane);
    if constexpr (SP2) {
        PG8_STAGE(PG8_SB(0, 0), cB, voffB); PG8_STAGE(PG8_SB(0, 1), cB + hstep, voffB); PG8_STAGE(PG8_SA(0, 0), cA, voffA); PG8_STAGE(PG8_SA(0, 1), cA + hstep, voffA);
        PG8_STAGE(PG8_SB(1, 0), cB + kstep, voffB); PG8_STAGE(PG8_SA(1, 0), cA + kstep, voffA); PG8_STAGE(PG8_SB(1, 1), cB + hstep + kstep, voffB);
        PG8_WAIT_V(8); PG8_BAR;
        if (wr == 1) PG8_BAR;
    } else {
        PG8_STAGE(PG8_SB(0, 0), cB, voffB); PG8_STAGE(PG8_SA(0, 0), cA, voffA); PG8_STAGE(PG8_SB(0, 1), cB + hstep, voffB); PG8_STAGE(PG8_SA(0, 1), cA + hstep, voffA);
        if (wr == 1) PG8_BAR;
        PG8_WAIT_V(4); PG8_BAR;
        PG8_STAGE(PG8_SB(1, 0), cB + kstep, voffB); PG8_STAGE(PG8_SA(1, 0), cA + kstep, voffA); PG8_STAGE(PG8_SB(1, 1), cB + hstep + kstep, voffB);
        PG8_WAIT_V(6); PG8_BAR;
    }
    for (;;) {
        const bool has_next = S.next(ui + 1, nxt);
        const char* nA = has_next ? (const char*)g.A + (size_t)nxt.pm * tstep : cA; const char* nB = has_next ? (const char*)g.Bt + (size_t)nxt.pn * tstep : cB;
        for (int t = 0; t < nt; t += 2) {
            const bool last = (t == nt - 2);
            const char* a1 = cA + (size_t)(t + 1) * kstep;
            const char* a2 = last ? nA : cA + (size_t)(t + 2) * kstep; const char* b2 = last ? nB : cB + (size_t)(t + 2) * kstep;
            const char* a3 = a2 + kstep; const char* b3 = b2 + kstep;
            if (last && has_next) S.a_ready(nxt);
            if constexpr (SP2) {
            PG8_LDB(B0, 0, 0); PG8_LDB(B1, 0, 1); PG8_SCHED; PG8_LDA(At, 0, 0); PG8_STAGE(PG8_SA(1, 1), a1 + hstep, voffA);
            PG8_WAIT_V(8); PG8_WAIT_L(0); PG8_BAR; PG8_MMA(0, 0, At, B0); PG8_MMA(0, 1, At, B1); PG8_BAR; PG8_SCHED;
            PG8_LDA(At, 0, 1); PG8_STAGE(PG8_SB(0, 0), b2, voffB); PG8_STAGE(PG8_SB(0, 1), b2 + hstep, voffB); PG8_STAGE(PG8_SA(0, 0), a2, voffA);
            PG8_WAIT_V(8); PG8_WAIT_L(0); PG8_BAR; PG8_MMA(1, 0, At, B0); PG8_MMA(1, 1, At, B1); PG8_BAR; PG8_SCHED;
            PG8_LDB(B0, 1, 0); PG8_LDB(B1, 1, 1); PG8_SCHED; PG8_LDA(At, 1, 0); PG8_STAGE(PG8_SA(0, 1), a2 + hstep, voffA);
            PG8_WAIT_V(8); PG8_WAIT_L(0); PG8_BAR; PG8_MMA(0, 0, At, B0); PG8_MMA(0, 1, At, B1); PG8_BAR; PG8_SCHED;
            PG8_LDA(At, 1, 1); PG8_STAGE(PG8_SB(1, 0), b3, voffB); PG8_STAGE(PG8_SB(1, 1), b3 + hstep, voffB); PG8_STAGE(PG8_SA(1, 0), a3, voffA);
            PG8_WAIT_V(8); PG8_WAIT_L(0); PG8_BAR; PG8_MMA(1, 0, At, B0); PG8_MMA(1, 1, At, B1); PG8_BAR; PG8_SCHED;
            } else {
            PG8_LDB(B0, 0, 0); PG8_SCHED; PG8_LDA(At, 0, 0); PG8_STAGE(PG8_SA(1, 1), a1 + hstep, voffA);
            PG8_WAIT_L(8); PG8_BAR; PG8_WAIT_L(0); PG8_MMA(0, 0, At, B0); PG8_BAR; PG8_SCHED;
            PG8_LDB(B1, 0, 1); PG8_STAGE(PG8_SB(0, 0), b2, voffB);
            PG8_BAR; PG8_WAIT_L(0); PG8_MMA(0, 1, At, B1); PG8_BAR;
            PG8_LDA(At, 0, 1); PG8_STAGE(PG8_SA(0, 0), a2, voffA);
            PG8_BAR; PG8_WAIT_L(0); PG8_MMA(1, 0, At, B0); PG8_BAR; PG8_SCHED;
            PG8_STAGE(PG8_SB(0, 1), b2 + hstep, voffB);
            PG8_WAIT_V(6); PG8_BAR; PG8_MMA(1, 1, At, B1); PG8_BAR;
            PG8_LDB(B0, 1, 0); PG8_SCHED; PG8_LDA(At, 1, 0); PG8_STAGE(PG8_SA(0, 1), a2 + hstep, voffA);
            PG8_WAIT_L(8); PG8_BAR; PG8_WAIT_L(0); PG8_MMA(0, 0, At, B0); PG8_BAR; PG8_SCHED;
            PG8_LDB(B1, 1, 1); PG8_STAGE(PG8_SB(1, 0), b3, voffB);
            PG8_BAR; PG8_WAIT_L(0); PG8_MMA(0, 1, At, B1); PG8_BAR;
            PG8_LDA(At, 1, 1); PG8_STAGE(PG8_SA(1, 0), a3, voffA);
            PG8_BAR; PG8_WAIT_L(0); PG8_MMA(1, 0, At, B0); PG8_BAR; PG8_SCHED;
            PG8_STAGE(PG8_SB(1, 1), b3 + hstep, voffB);
            PG8_WAIT_V(6); PG8_BAR; PG8_MMA(1, 1, At, B1); PG8_BAR;
            }
        }
        if constexpr (ALIGN_EPI) { if (wr == 0) PG8_BAR; }
        if constexpr (Epi::WPF) { if (has_next) E.prefetch(lds, nxt, (ui + 1) & 1, wid, lane); E(acc, cur, wr, wc, fr, fq, lds, ui & 1); S.done(cur); }
        else if constexpr (!Epi::AFTER_DRAIN) { E(acc, cur, wr, wc, fr, fq); S.done(cur); }
        if (!has_next) break;
#pragma unroll
        for (int a = 0; a < 2; ++a)
#pragma unroll
            for (int b = 0; b < 2; ++b)
#pragma unroll
                for (int m = 0; m < 4; ++m)
#pragma unroll
                    for (int n = 0; n < 2; ++n) acc[a][b][m][n] = (f32x4){0.f, 0.f, 0.f, 0.f};
        cur = nxt; cA = nA; cB = nB; ++ui;
        if constexpr (ALIGN_EPI) { if (wr == 1) PG8_BAR; }
    }
    PG8_WAIT_V(0);
    if constexpr (!ALIGN_EPI) { if (wr == 0) PG8_BAR; }
    PG8_BAR;
    if constexpr (Epi::AFTER_DRAIN) { E.fused(acc, cur, wr, wc, fr, fq, lds, wid, lane); S.done(cur); }
#undef PG8_SA
#undef PG8_SB
#undef PG8_STAGE
#undef PG8_LDA
#undef PG8_LDB
#undef PG8_MMA
#undef PG8_WAIT_V
#undef PG8_WAIT_L
#undef PG8_BAR
#undef PG8_SCHED
}
}

constexpr int DM = 1024, NB = 16, SEQ = 2048, TR = NB * SEQ, NMETA = 16, NS = 128;
constexpr int XM = TR, XS = TR + NMETA, NVALID = TR + NMETA + NS, TM = 33024;
constexpr int LP = NMETA + SEQ;
constexpr int GH = 8, GDK = 128, GDV = 128, GQKV = 3072, GIN = 4112;
constexpr int QL = 384, KVL = 256, NOPE = 128, ROPE = 64, HD = 192, MH = 8;
constexpr int FF = 2816, FF2 = 5632;
constexpr int PAST = 8192, PAGE = 128, NPAGE = 64;
constexpr float EPS = 1e-6f;
constexpr float MLA_SCALE = 0.07216878364870322f;
static_assert(TM % 256 == 0 && TM >= NVALID, "row padding");

enum { I_XP = 0, I_XS, I_SDS, I_SDC, I_SFC, I_CKV, I_CKR, I_PT, I_META, I_ANPRE, I_ANPOST, I_AWIN, I_ACONV, I_ALOG, I_ADT, I_AONORM, I_AWOUT,
       I_KVNORM, I_KVWA, I_KVANORM, I_WUK, I_WUV, I_BNPRE, I_BNPOST, I_BWQA, I_BQANORM, I_BWQB, I_BWOUT, I_FNPRE, I_FNPOST, I_FWUP, I_FCONVW, I_FCONVB, I_FWDOWN, N_IN };
constexpr size_t O_YP = 0, O_YS = O_YP + (size_t)TR * DM, O_PDS = O_YS + (size_t)NS * DM, O_PDC = O_PDS + (size_t)NB * GH * GDK * GDV, O_PFC = O_PDC + (size_t)NB * 3 * GQKV,
                 O_PKV = O_PFC + (size_t)2 * NB * 2 * FF2, O_PKR = O_PKV + (size_t)NB * LP * KVL, O_SDS = O_PKR + (size_t)NB * LP * ROPE, O_SDC = O_SDS + (size_t)NS * GH * GDK * GDV,
                 O_SFC = O_SDC + (size_t)NS * 3 * GQKV, O_SKV = O_SFC + (size_t)2 * NS * 2 * FF2, O_SKR = O_SKV + (size_t)NS * KVL, O_END = O_SKR + (size_t)NS * ROPE;

constexpr size_t MiB = 1u << 20;
constexpr size_t WS_CTL = 0, CTL_ZERO_BYTES = 1 * MiB;
constexpr size_t WS_ROPE = 1 * MiB;
constexpr size_t WS_WIN = 2 * MiB, WS_WGOUT = 10 * MiB, WS_WUP0 = 12 * MiB, WS_WUP1 = 23 * MiB, WS_WDN0 = 34 * MiB, WS_WDN1 = 40 * MiB, WS_WKVQA = 46 * MiB,
                 WS_WQB = 48 * MiB, WS_WUKV = 50 * MiB, WS_WMOUT = 52 * MiB, WS_AB = 54 * MiB, WS_PART = 57 * MiB, WS_QLAT = 60 * MiB;
constexpr size_t WS_XRES = 64 * MiB, WS_XH = 193 * MiB, WS_TMP = 258 * MiB, WS_QKVZ = 387 * MiB, WS_GO = 645 * MiB, WS_UP = 710 * MiB, WS_RAWH = 710 * MiB, WS_RAWX = 760 * MiB, WS_ACT = 1065 * MiB,
                 WS_CKVQ = 1243 * MiB, WS_CB = 1340 * MiB, WS_KRB = 1357 * MiB, WS_QAN = 1362 * MiB, WS_Q = 1387 * MiB, WS_KNV = 1484 * MiB, WS_AO = 1613 * MiB,
                 WS_SREC = 1678 * MiB, WS_GU = 1904 * MiB, WS_GA = 1970 * MiB, WS_GRV = 2036 * MiB, WS_GRK = 2102 * MiB, WS_GEG = 2168 * MiB, WS_RAWQ = 2169 * MiB, WS_END = 2210 * MiB;
constexpr int CW_BAR = 4096, CW_QUEUE = 2048;
constexpr int NPOSTAB = LP + 1;

constexpr int RING_BYTES = 131072, LDS_BYTES = 147456, CTLLDS_OFF = LDS_BYTES - 2048, MISC_OFF = CTLLDS_OFF + 320, INTAB_OFF = CTLLDS_OFF + 1024;

#define LAS __attribute__((address_space(3)))
typedef unsigned short bf16;
typedef unsigned v4u __attribute__((ext_vector_type(4)));
typedef unsigned v2u __attribute__((ext_vector_type(2)));
typedef float f32x4 __attribute__((ext_vector_type(4)));
typedef float f32x16 __attribute__((ext_vector_type(16)));
typedef short bf16x8 __attribute__((ext_vector_type(8)));
typedef short s16x4 __attribute__((ext_vector_type(4)));
#define LDS_WAIT() asm volatile("s_waitcnt lgkmcnt(0)" ::: "memory")
#define VM_WAIT() asm volatile("s_waitcnt vmcnt(0)" ::: "memory")
__device__ __forceinline__ unsigned f2bf(float f) { unsigned u = __builtin_bit_cast(unsigned, f); return (u + 0x7fffu + ((u >> 16) & 1u)) >> 16; }
__device__ __forceinline__ unsigned pk2(float lo, float hi) { return f2bf(lo) | (f2bf(hi) << 16); }
__device__ __forceinline__ float bf2f(bf16 b) { return __builtin_bit_cast(float, (unsigned)b << 16); }
__device__ __forceinline__ float bflo(unsigned w) { return __builtin_bit_cast(float, w << 16); }
__device__ __forceinline__ float bfhi(unsigned w) { return __builtin_bit_cast(float, w & 0xffff0000u); }
#define DPPF(x, ctrl) __builtin_bit_cast(float, __builtin_amdgcn_update_dpp(0, __builtin_bit_cast(int, (x)), (ctrl), 0xF, 0xF, false))
__device__ __forceinline__ float swap16_sum(float v) { auto r = __builtin_amdgcn_permlane16_swap(__float_as_uint(v), __float_as_uint(v), false, false); return __uint_as_float(r[0]) + __uint_as_float(r[1]); }
__device__ __forceinline__ float swap32_sum(float v) { auto r = __builtin_amdgcn_permlane32_swap(__float_as_uint(v), __float_as_uint(v), false, false); return __uint_as_float(r[0]) + __uint_as_float(r[1]); }
__device__ __forceinline__ float wave_sum(float v) {
    v += DPPF(v, 0xB1); v += DPPF(v, 0x4E); v += DPPF(v, 0x141); v += DPPF(v, 0x140);
    return swap32_sum(swap16_sum(v));
}
__device__ __forceinline__ float siluf(float x) { return x * __builtin_amdgcn_rcpf(1.f + __expf(-x)); }

#define XB_TMO      128
#define XB_XCNT(j)  (256  + 64 * (j))
#define XB_XSUB(j)  (1280 + 64 * (j))
#define XB_XGEN(j)  (2304 + 64 * (j))
#define XB_TOP      3328
#define XB_TOPGEN   3392
#define XCD_BAR_WORDS 3456
#define XB_SPIN_CAP (1u << 18)
__device__ __forceinline__ unsigned xb_ld(unsigned* p)              { return __hip_atomic_load(p, __ATOMIC_RELAXED, __HIP_MEMORY_SCOPE_AGENT); }
__device__ __forceinline__ unsigned xb_add(unsigned* p, unsigned v) { return __hip_atomic_fetch_add(p, v, __ATOMIC_RELAXED, __HIP_MEMORY_SCOPE_AGENT); }
__device__ __forceinline__ unsigned xb_xcc_id() { return (unsigned)__builtin_amdgcn_s_getreg((3 << 11) | 20) & 0xFu; }
#define XB_SPIN(cond, bar) do { unsigned _sp = 0; while (cond) { __builtin_amdgcn_s_sleep(1); \
    if ((++_sp & 255u) == 0u) { if (xb_ld(&(bar)[XB_TMO])) break; if (_sp > XB_SPIN_CAP) { atomicAdd(&(bar)[XB_TMO], 1u); break; } } } } while (0)
struct XcdBarrier { unsigned* bar; unsigned x; volatile LAS unsigned* st; };
__device__ __forceinline__ XcdBarrier xcd_barrier_post(unsigned* bar, volatile LAS unsigned* st) {
    XcdBarrier b; b.bar = bar; b.x = xb_xcc_id(); b.st = st;
    if (threadIdx.x == 0) (void)xb_add(&bar[XB_XCNT(b.x)], 1u);
    return b;
}
__device__ __forceinline__ void xcd_barrier_complete(unsigned* bar, unsigned x, unsigned& nloc, unsigned& nx) {
    const unsigned G = gridDim.x * gridDim.y * gridDim.z;
    unsigned sum, cnt, mine, sp = 0u;
    for (;;) {
        sum = 0u; cnt = 0u; mine = 0u;
#pragma unroll
        for (unsigned j = 0; j < 16; ++j) { const unsigned c = xb_ld(&bar[XB_XCNT(j)]); sum += c; cnt += (c > 0u) ? 1u : 0u; mine = (j == x) ? c : mine; }
        if (sum == G) break;
        __builtin_amdgcn_s_sleep(1);
        if ((++sp & 255u) == 0u) { if (xb_ld(&bar[XB_TMO])) break; if (sp > XB_SPIN_CAP) { atomicAdd(&bar[XB_TMO], 1u); break; } }
    }
    nloc = mine > 0u ? mine : 1u; nx = cnt > 0u ? cnt : 1u;
}
__device__ __forceinline__ void xcd_barrier(const XcdBarrier& b) {
    asm volatile("s_waitcnt vmcnt(0)" ::: "memory");
    __syncthreads();
    if (threadIdx.x == 0) {
        unsigned* bar = b.bar;
        __builtin_amdgcn_s_waitcnt(0);
        unsigned nloc = b.st[0], nx = b.st[1];
        if (nloc == 0u) { xcd_barrier_complete(bar, b.x, nloc, nx); b.st[0] = nloc; b.st[1] = nx; }
        const unsigned old = xb_add(&bar[XB_XSUB(b.x)], 1u);
        const unsigned gen = old / nloc;
        if (old + 1u == (gen + 1u) * nloc) {
            __builtin_amdgcn_fence(__ATOMIC_RELEASE, "agent");
            asm volatile("s_waitcnt vmcnt(0)" ::: "memory");
            const unsigned og = xb_add(&bar[XB_TOP], 1u);
            const unsigned tg = og / nx;
            if (og + 1u == (tg + 1u) * nx) xb_add(&bar[XB_TOPGEN], 1u);
            else XB_SPIN(xb_ld(&bar[XB_TOPGEN]) == tg, bar);
            __builtin_amdgcn_fence(__ATOMIC_ACQUIRE, "agent");
            xb_add(&bar[XB_XGEN(b.x)], 1u);
            asm volatile("s_waitcnt vmcnt(0)" ::: "memory");
        } else {
            XB_SPIN(xb_ld(&bar[XB_XGEN(b.x)]) == gen, bar);
            __builtin_amdgcn_fence(__ATOMIC_ACQUIRE, "agent");
            asm volatile("s_waitcnt vmcnt(0)" ::: "memory");
        }
    }
    __syncthreads();
}

struct ConvJob { const float* src; const float* gain; bf16* dst; int K, N, ld, row_off, mode, pad; };
constexpr int NJOBS = 12;
struct Params {
    const float* in[N_IN];
    float* out; unsigned char* ws;
    ConvJob jobs[NJOBS];
    int ph_lo, ph_hi;
};
#define GAS __attribute__((address_space(1)))
struct InTab { const LAS unsigned* t;
    __device__ __forceinline__ const float* operator[](int i) const { const unsigned lo = __builtin_amdgcn_readfirstlane(t[2 * i]), hi = __builtin_amdgcn_readfirstlane(t[2 * i + 1]); return (const float*)(GAS const float*)(((unsigned long long)hi << 32) | lo); } };
struct Frame {
    LAS unsigned char* lds;
    int tid, lane, wave, G, bid;
    InTab in; GAS float* out; GAS unsigned char* ws;
};
__device__ __forceinline__ int prow(int b, int pos) { return pos < NMETA ? XM + pos : b * SEQ + (pos - NMETA); }

template <bool GAIN> __device__ __forceinline__ void p0_transpose_item(const ConvJob& J, LAS float* scr, int item, int lane) {
    const int nblk = J.N / 32, kb = item / nblk, nb = item % nblk, k0 = 64 * kb, n0 = 32 * nb;
    const int kr = lane >> 3, c4 = (lane & 7) * 4;
    f32x4 v[8]; float gn[8];
#pragma unroll
    for (int i = 0; i < 8; ++i) { const int kk = 8 * i + kr; v[i] = *(const f32x4*)(J.src + (size_t)(k0 + kk) * J.ld + n0 + c4); gn[i] = GAIN ? J.gain[k0 + kk] : 1.f; }
#pragma unroll
    for (int i = 0; i < 8; ++i) { const int kk = 8 * i + kr; LAS float* d = scr + kk * 33 + c4; d[0] = v[i].x * gn[i]; d[1] = v[i].y * gn[i]; d[2] = v[i].z * gn[i]; d[3] = v[i].w * gn[i]; }
    LDS_WAIT(); asm volatile("" ::: "memory");
    const int c = lane & 7;
#pragma unroll
    for (int j = 0; j < 4; ++j) { const int n = (lane >> 3) + 8 * j; const LAS float* s = scr + (8 * c) * 33 + n;
        v4u o; o.x = pk2(s[0 * 33], s[1 * 33]); o.y = pk2(s[2 * 33], s[3 * 33]); o.z = pk2(s[4 * 33], s[5 * 33]); o.w = pk2(s[6 * 33], s[7 * 33]);
        const int sc_ = n0 + n; int drow = J.row_off + sc_; if (J.mode == 1) { const int isv = sc_ >= FF ? 1 : 0, ch = sc_ - isv * FF; drow = 32 * (ch >> 4) + 16 * isv + (ch & 15); }
        *(v4u*)(J.dst + (size_t)drow * J.K + k0 + 8 * c) = o; }
    LDS_WAIT(); asm volatile("" ::: "memory");
}
__device__ __forceinline__ void p0_prologue(Frame& F, const Params& P) {
    const int gw = F.bid * 8 + F.wave, NGW = F.G * 8;
    {
        LAS float* scr = (LAS float*)(F.lds + F.wave * 16384);
        int base = 0;
#ifndef P0A
#define P0A 1
#define P0C 1
#endif
#pragma unroll 1
        for (int j_ = 0; j_ < NJOBS * P0A; ++j_) { const int j = j_ % NJOBS; if (j == 0) base = 0;
            const ConvJob J = P.jobs[j]; const int nit = (J.K / 64) * (J.N / 32);
            int first = (gw - base % NGW + NGW) % NGW;
            if (J.gain) { _Pragma("unroll 1") for (int it = first; it < nit; it += NGW) p0_transpose_item<true>(J, scr, it, F.lane); }
            else { _Pragma("unroll 1") for (int it = first; it < nit; it += NGW) p0_transpose_item<false>(J, scr, it, F.lane); }
            base += nit;
        }
        bf16* wz = (bf16*)(F.ws + WS_WKVQA) + (size_t)704 * DM;
        for (int i = F.bid * 512 + F.tid; i < 64 * DM / 8; i += F.G * 512) ((v4u*)wz)[i] = (v4u){0u, 0u, 0u, 0u};
    }
    {
        float* ctab = (float*)(F.ws + WS_ROPE); float* stab = ctab + NPOSTAB * 32;
        for (int idx = F.bid * 512 + F.tid; idx < NPOSTAB * 32; idx += F.G * 512) {
            const int pi = idx >> 5, i = idx & 31; const int pos = pi < LP ? pi : PAST;
            double inv = 1.0; for (int k = 0; k < i; ++k) inv *= 0.74989420933245582730;
            double c1 = 1.0, s1 = inv, tc = 1.0, ts = inv; const double x2 = inv * inv;
            for (int k = 1; k < 14; ++k) { tc *= -x2 / (double)((2 * k - 1) * (2 * k)); ts *= -x2 / (double)((2 * k) * (2 * k + 1)); c1 += tc; s1 += ts; }
            double rc = 1.0, rs = 0.0, bc = c1, bs = s1; int e = pos;
            for (int k = 0; k < 14; ++k) { if (e & 1) { const double t = rc * bc - rs * bs; rs = rc * bs + rs * bc; rc = t; } const double t2 = bc * bc - bs * bs; bs = 2.0 * bc * bs; bc = t2; e >>= 1; }
            ctab[idx] = (float)rc; stab[idx] = (float)rs;
        }
    }
    __syncthreads();
    asm volatile("" : "+s"(F.ws));
    LAS float* wab = (LAS float*)F.lds;
    { const float* win = F.in[I_AWIN]; const float* g = F.in[I_ANPRE];
      for (int idx = F.tid; idx < DM * 16; idx += 512) { const int k = idx >> 4, q = idx & 15, j = k >> 8, ln = (k >> 2) & 63, i = k & 3; wab[(((j * 4 + i) * 4 + (q >> 2)) * 64 + ln) * 4 + (q & 3)] = win[(size_t)k * GIN + 4096 + q] * g[k]; } }
    __syncthreads();
    float* XRES = (float*)(F.ws + WS_XRES); bf16* XH = (bf16*)(F.ws + WS_XH); float* AB = (float*)(F.ws + WS_AB);
#pragma unroll 1
    for (int rb_ = gw * 2; rb_ < TM * P0C; rb_ += NGW * 2) { const int rb = rb_ % TM;
        f32x4 v[2][4]; float msk[2];
#pragma unroll
        for (int u = 0; u < 2; ++u) { const int row = rb + u; const float* src = F.in[I_XP];
            if (row < TR) src = F.in[I_XP] + (size_t)row * DM; else if (row < XS) src = F.in[I_META] + (size_t)(row - XM) * DM; else if (row < NVALID) src = F.in[I_XS] + (size_t)(row - XS) * DM;
            msk[u] = row < NVALID ? 1.f : 0.f;
#pragma unroll
            for (int j = 0; j < 4; ++j) v[u][j] = ((const f32x4*)src)[64 * j + F.lane]; }
#pragma unroll
        for (int u = 0; u < 2; ++u) { const int row = rb + u; float ss = 0.f;
#pragma unroll
            for (int j = 0; j < 4; ++j) { v[u][j] = v[u][j] * msk[u]; ss += (v[u][j].x * v[u][j].x + v[u][j].y * v[u][j].y) + (v[u][j].z * v[u][j].z + v[u][j].w * v[u][j].w); }
            ss = wave_sum(ss); const float ms = ss * (1.f / DM) + EPS, rstd = rsqrtf(ms);
            unsigned long long* xh = (unsigned long long*)(XH + (size_t)row * DM);
            if (F.lane == 0) ((float*)(F.ws + WS_GEG + 65536))[row] = sqrtf(ms);
#pragma unroll
            for (int j = 0; j < 4; ++j) { v[u][j] = v[u][j] * rstd; xh[64 * j + F.lane] = (unsigned long long)pk2(v[u][j].x, v[u][j].y) | ((unsigned long long)pk2(v[u][j].z, v[u][j].w) << 32); }
            if (row >= NVALID) continue;
            float a[16];
#pragma unroll
            for (int q = 0; q < 16; ++q) a[q] = 0.f;
#pragma unroll
            for (int j = 0; j < 4; ++j)
#pragma unroll
                for (int i = 0; i < 4; ++i) { const float xv = v[u][j][i]; const LAS f32x4* wr = (const LAS f32x4*)wab + (j * 4 + i) * 256 + F.lane;
#pragma unroll
                    for (int q4 = 0; q4 < 4; ++q4) { const f32x4 w = wr[q4 * 64]; a[4 * q4 + 0] += xv * w.x; a[4 * q4 + 1] += xv * w.y; a[4 * q4 + 2] += xv * w.z; a[4 * q4 + 3] += xv * w.w; } }
#pragma unroll
            for (int i = 0; i < 8; ++i) { auto r_ = __builtin_amdgcn_permlane32_swap(__float_as_uint(a[i]), __float_as_uint(a[i + 8]), false, false); a[i] = __uint_as_float(r_[0]) + __uint_as_float(r_[1]); }
#pragma unroll
            for (int i = 0; i < 4; ++i) { auto r_ = __builtin_amdgcn_permlane16_swap(__float_as_uint(a[i]), __float_as_uint(a[i + 4]), false, false); a[i] = __uint_as_float(r_[0]) + __uint_as_float(r_[1]); }
            { const bool b3 = (F.lane & 8) != 0, b2 = (F.lane & 4) != 0;
#pragma unroll
              for (int i = 0; i < 2; ++i) { const float keep = b3 ? a[i + 2] : a[i], send = b3 ? a[i] : a[i + 2]; a[i] = keep + DPPF(send, 0x140); }
              { const float keep = b2 ? a[1] : a[0], send = b2 ? a[0] : a[1]; a[0] = keep + DPPF(send, 0x141); } }
            a[0] += DPPF(a[0], 0x4E); a[0] += DPPF(a[0], 0xB1);
            if ((F.lane & 3) == 0) { const int idx = ((F.lane >> 5) & 1) * 8 + ((F.lane >> 4) & 1) * 4 + ((F.lane >> 3) & 1) * 2 + ((F.lane >> 2) & 1); AB[(size_t)row * 16 + idx] = a[0]; }
        }
    }
}

__device__ __forceinline__ void gdn_item(Frame& F, int item) {
    const bool is_p = item < NB * GH;
    const int b = is_p ? item >> 3 : 0, h = item & 7, s = is_p ? 0 : (item - NB * GH) >> 3;
    const int dv = F.tid & 127, qd = __builtin_amdgcn_readfirstlane(F.tid >> 7);
    LAS float* qs = (LAS float*)F.lds; LAS float* ks = qs + 16 * 128; LAS float* vs = ks + 16 * 128; LAS float* red = vs + 16 * 128; LAS float* red2 = red + 512; LAS float* egs = red2 + 512; LAS float* bes = egs + 16;
    const bf16* QKVZ = (const bf16*)(F.ws + WS_QKVZ); const float* AB = (const float*)(F.ws + WS_AB); bf16* OB = (bf16*)(F.ws + WS_TMP);
    const float* cw = F.in[I_ACONV]; const float* sdc = F.in[I_SDC];
    float S[32];
    if (is_p) {
#pragma unroll
        for (int i = 0; i < 32; ++i) S[i] = 0.f;
    } else { const float* s0 = F.in[I_SDS] + ((size_t)(s * GH + h) * GDK + 32 * qd) * GDV + dv;
#pragma unroll
        for (int i = 0; i < 32; ++i) S[i] = s0[(size_t)i * GDV]; }
    const float Ah = __expf(F.in[I_ALOG][h]), dtb = F.in[I_ADT][h];
    const int nchunk = is_p ? LP / 16 : 1, ntok = is_p ? 16 : 1;
#pragma unroll 1
    for (int ch = 0; ch < nchunk; ++ch) {
        for (int idx = F.tid; idx < ntok * 384; idx += 512) {
            const int ti = idx / 384, c = idx - ti * 384, part = c >> 7, cc = c & 127, col = part * 1024 + h * 128 + cc;
            float acc = 0.f;
#pragma unroll
            for (int j = 0; j < 4; ++j) {
                float xv;
                if (is_p) { const int pos = ch * 16 + ti - 3 + j; xv = pos < 0 ? 0.f : bf2f(QKVZ[(size_t)prow(b, pos) * 4096 + col]); }
                else xv = j < 3 ? sdc[(size_t)(s * 3 + j) * GQKV + col] : bf2f(QKVZ[(size_t)(XS + s) * 4096 + col]);
                acc += cw[j * GQKV + col] * xv;
            }
            acc = siluf(acc);
            (part == 0 ? qs : part == 1 ? ks : vs)[ti * 128 + cc] = acc;
        }
        if (F.tid < ntok) { const int row = is_p ? prow(b, ch * 16 + F.tid) : XS + s; const float a = AB[(size_t)row * 16 + h], bb = AB[(size_t)row * 16 + 8 + h];
            const float x = a + dtb, sp = x > 20.f ? x : log1pf(__expf(x)); egs[F.tid] = __expf(-Ah * sp); bes[F.tid] = 1.f / (1.f + __expf(-bb)); }
        __syncthreads();
        for (int vv = F.wave; vv < 2 * ntok; vv += 8) { const int ti = vv >> 1, isk = vv & 1; LAS float* p = (isk ? ks : qs) + ti * 128; const float x0 = p[F.lane], x1 = p[F.lane + 64];
            const float ss = wave_sum(x0 * x0 + x1 * x1); const float r = rsqrtf(ss + EPS) * (isk ? 1.f : 0.08838834764831845f); p[F.lane] = x0 * r; p[F.lane + 64] = x1 * r; }
        __syncthreads();
#pragma unroll 1
        for (int ti = 0; ti < ntok; ++ti) {
            float kk[32]; float p = 0.f;
#pragma unroll
            for (int i = 0; i < 32; ++i) { kk[i] = ks[ti * 128 + 32 * qd + i]; p += kk[i] * S[i]; }
            red[qd * 128 + dv] = p; __syncthreads();
            const float kS = (red[dv] + red[128 + dv]) + (red[256 + dv] + red[384 + dv]);
            const float eg = egs[ti], be = bes[ti], u = be * (vs[ti * 128 + dv] - eg * kS);
            float op = 0.f;
#pragma unroll
            for (int i = 0; i < 32; ++i) { S[i] = eg * S[i] + kk[i] * u; op += qs[ti * 128 + 32 * qd + i] * S[i]; }
            red2[qd * 128 + dv] = op; __syncthreads();
            if (qd == 0) { const float o = (red2[dv] + red2[128 + dv]) + (red2[256 + dv] + red2[384 + dv]);
                const int row = is_p ? prow(b, ch * 16 + ti) : XS + s;
                if (!is_p || ch > 0 || b == 0) OB[(size_t)row * DM + h * 128 + dv] = (bf16)f2bf(o); }
        }
        __syncthreads();
    }
    GAS float* so = is_p ? F.out + O_PDS + ((size_t)(b * GH + h) * GDK + 32 * qd) * GDV + dv : F.out + O_SDS + ((size_t)(s * GH + h) * GDK + 32 * qd) * GDV + dv;
#pragma unroll
    for (int i = 0; i < 32; ++i) so[(size_t)i * GDV] = S[i];
}

__device__ __forceinline__ void p3_gate(Frame& F) {
    const int gw = F.bid * 8 + F.wave, NGW = F.G * 8;
    const bf16* OB = (const bf16*)(F.ws + WS_TMP); const bf16* QKVZ = (const bf16*)(F.ws + WS_QKVZ); bf16* GO = (bf16*)(F.ws + WS_GO);
    const float* on = F.in[I_AONORM];
    f32x4 g4[4];
#pragma unroll
    for (int j = 0; j < 4; ++j) g4[j] = ((const f32x4*)on)[((16 * F.lane) & 127) / 4 + j];
    for (int row = gw; row < NVALID; row += NGW) {
        const v4u* op = (const v4u*)(OB + (size_t)row * DM + 16 * F.lane); const v4u* zp = (const v4u*)(QKVZ + (size_t)row * 4096 + 3072 + 16 * F.lane);
        f32x4 o[4]; float ss = 0.f; const v4u o0 = op[0], o1 = op[1]; const unsigned ow[8] = {o0.x, o0.y, o0.z, o0.w, o1.x, o1.y, o1.z, o1.w};
#pragma unroll
        for (int j = 0; j < 4; ++j) { o[j] = (f32x4){bflo(ow[2 * j]), bfhi(ow[2 * j]), bflo(ow[2 * j + 1]), bfhi(ow[2 * j + 1])}; ss += (o[j].x * o[j].x + o[j].y * o[j].y) + (o[j].z * o[j].z + o[j].w * o[j].w); }
        ss += DPPF(ss, 0xB1); ss += DPPF(ss, 0x4E); ss += DPPF(ss, 0x141);
        const float rstd = rsqrtf(ss * (1.f / 128.f) + EPS);
        const v4u z0 = zp[0], z1 = zp[1]; const unsigned zw[8] = {z0.x, z0.y, z0.z, z0.w, z1.x, z1.y, z1.z, z1.w};
        unsigned w[8];
#pragma unroll
        for (int j = 0; j < 4; ++j) { const f32x4 y = o[j] * rstd * g4[j];
            w[2 * j] = pk2(y.x * siluf(bflo(zw[2 * j])), y.y * siluf(bfhi(zw[2 * j]))); w[2 * j + 1] = pk2(y.z * siluf(bflo(zw[2 * j + 1])), y.w * siluf(bfhi(zw[2 * j + 1]))); }
        v4u* gp = (v4u*)(GO + (size_t)row * DM + 16 * F.lane); gp[0] = (v4u){w[0], w[1], w[2], w[3]}; gp[1] = (v4u){w[4], w[5], w[6], w[7]};
    }
    const int gt = F.bid * 512 + F.tid, NGT = F.G * 512;
    { const float* RAWQ = (const float*)(F.ws + WS_RAWQ);
      for (int i = gt; i < NB * 3 * GQKV; i += NGT) { const int c = i % GQKV, j = (i / GQKV) % 3, b = i / (3 * GQKV); F.out[O_PDC + i] = RAWQ[((size_t)(b * 32 + 31) * 6 + 3 + j) * GQKV + c]; } }
    for (int i = gt; i < NS * 3 * GQKV; i += NGT) { const int c = i % GQKV, j = (i / GQKV) % 3, s = i / (3 * GQKV);
        F.out[O_SDC + i] = j < 2 ? F.in[I_SDC][(size_t)(s * 3 + j + 1) * GQKV + c] : bf2f(QKVZ[(size_t)(XS + s) * 4096 + c]); }
}

template <bool LAST, bool FIRST = false> __device__ __forceinline__ void p_postnorm(Frame& F, const float* gpost) {
    const int gw = F.bid * 8 + F.wave, NGW = F.G * 8;
    const bf16* TMPB = (const bf16*)(F.ws + WS_TMP); bf16* XH = (bf16*)(F.ws + WS_XH); float* RS = (float*)(F.ws + WS_GEG + 65536);
    f32x4 g[4];
#pragma unroll
    for (int j = 0; j < 4; ++j) g[j] = ((const f32x4*)gpost)[64 * j + F.lane];
    static_assert(NVALID % 2 == 0, "two rows per wave iteration");
#pragma unroll 1
    for (int rb = gw * 2; rb < NVALID; rb += NGW * 2) {
        f32x4 t[2][4], x[2][4];
#pragma unroll
        for (int u = 0; u < 2; ++u) { const v2u* tp = (const v2u*)(TMPB + (size_t)(rb + u) * DM); const v2u* xb = (const v2u*)(XH + (size_t)(rb + u) * DM); const float iv = RS[rb + u];
#pragma unroll
            for (int j = 0; j < 4; ++j) { const v2u w = tp[64 * j + F.lane]; t[u][j] = (f32x4){bflo(w.x), bfhi(w.x), bflo(w.y), bfhi(w.y)};
                { const v2u q = xb[64 * j + F.lane]; x[u][j] = (f32x4){bflo(q.x), bfhi(q.x), bflo(q.y), bfhi(q.y)} * iv; } } }
#pragma unroll
        for (int u = 0; u < 2; ++u) { const int row = rb + u; float ss = 0.f;
#pragma unroll
            for (int j = 0; j < 4; ++j) ss += (t[u][j].x * t[u][j].x + t[u][j].y * t[u][j].y) + (t[u][j].z * t[u][j].z + t[u][j].w * t[u][j].w);
            ss = wave_sum(ss); const float rstd = rsqrtf(ss * (1.f / DM) + EPS); float s2 = 0.f;
#pragma unroll
            for (int j = 0; j < 4; ++j) { x[u][j] = x[u][j] + t[u][j] * rstd * g[j]; s2 += (x[u][j].x * x[u][j].x + x[u][j].y * x[u][j].y) + (x[u][j].z * x[u][j].z + x[u][j].w * x[u][j].w); }
            if (LAST) {
                GAS float* yo = row < TR ? F.out + O_YP + (size_t)row * DM : (row >= XS ? F.out + O_YS + (size_t)(row - XS) * DM : nullptr);
                if (yo) {
#pragma unroll
                    for (int j = 0; j < 4; ++j) ((f32x4*)yo)[64 * j + F.lane] = x[u][j]; }
            } else {
                s2 = wave_sum(s2); const float m2 = s2 * (1.f / DM) + EPS, r2 = rsqrtf(m2);
                unsigned long long* xh = (unsigned long long*)(XH + (size_t)row * DM);
                if (F.lane == 0) RS[row] = sqrtf(m2);
#pragma unroll
                for (int j = 0; j < 4; ++j) { const f32x4 y = x[u][j] * r2; xh[64 * j + F.lane] = (unsigned long long)pk2(y.x, y.y) | ((unsigned long long)pk2(y.z, y.w) << 32); }
            }
        }
    }
}

__device__ __forceinline__ void ld8(const bf16* p, float (&o)[8]) { const v4u w = *(const v4u*)p; o[0] = bflo(w.x); o[1] = bfhi(w.x); o[2] = bflo(w.y); o[3] = bfhi(w.y); o[4] = bflo(w.z); o[5] = bfhi(w.z); o[6] = bflo(w.w); o[7] = bfhi(w.w); }
__device__ __forceinline__ void ld8f(const float* p, float (&o)[8]) { const f32x4 a = ((const f32x4*)p)[0], b = ((const f32x4*)p)[1]; o[0] = a.x; o[1] = a.y; o[2] = a.z; o[3] = a.w; o[4] = b.x; o[5] = b.y; o[6] = b.z; o[7] = b.w; }
__device__ __forceinline__ int ffperm(int ch, int isv) { return 32 * (ch >> 4) + 16 * isv + (ch & 15); }
__device__ __forceinline__ void p_ffn_fix(Frame& F, int layer) {
    bf16* ACT = (bf16*)(F.ws + WS_ACT); const float* RAWH = (const float*)(F.ws + WS_RAWH); const float* RAWX = (const float*)(F.ws + WS_RAWX);
    const float* cw = F.in[I_FCONVW] + (size_t)layer * 3 * FF2; const float* cb = F.in[I_FCONVB] + (size_t)layer * FF2; const float* sfc = F.in[I_SFC] + (size_t)layer * NS * 2 * FF2;
    const int gt = F.bid * 512 + F.tid, NGT = F.G * 512; constexpr int CG = FF / 8, NG = TR / 64;
#pragma unroll 1
    for (int i = gt; i < (NG * 2 + NMETA + NS) * CG; i += NGT) {
        const int task = i / CG, ch0 = (i - task * CG) * 8, cog = ffperm(ch0, 0), cov = cog + 16;
        const float* p2; const float* p1; const float* p0; float k1 = 1.f, k0 = 1.f; int row; bool smp = false; int sidx = 0;
        if (task < NG * 2) { const int g = task >> 1, j = task & 1; row = 64 * g + j; const bool bstart = ((64 * g) & (SEQ - 1)) == 0;
            const float* prev3 = bstart ? RAWX + (size_t)15 * FF2 : RAWH + ((size_t)(g - 1) * 4 + 3) * FF2; const float* prev2 = bstart ? RAWX + (size_t)14 * FF2 : RAWH + ((size_t)(g - 1) * 4 + 2) * FF2;
            const float* c0 = RAWH + ((size_t)g * 4) * FF2; const float* c1 = c0 + FF2;
            if (j == 0) { p2 = c0; p1 = prev3; p0 = prev2; } else { p2 = c1; p1 = c0; p0 = prev3; } }
        else { const int rr = task - NG * 2; row = XM + rr; smp = rr >= NMETA; sidx = smp ? rr - NMETA : 0; p2 = RAWX + (size_t)rr * FF2;
            p1 = (!smp && rr >= 1) ? p2 - FF2 : RAWX; p0 = (!smp && rr >= 2) ? p2 - 2 * FF2 : RAWX; k1 = (!smp && rr >= 1) ? 1.f : 0.f; k0 = (!smp && rr >= 2) ? 1.f : 0.f; }
        float x2g[8], x2v[8], x1g[8], x1v[8], x0g[8], x0v[8], s1g[8], s1v[8], s0g[8], s0v[8];
        ld8f(p2 + cog, x2g); ld8f(p2 + cov, x2v); ld8f(p1 + cog, x1g); ld8f(p1 + cov, x1v); ld8f(p0 + cog, x0g); ld8f(p0 + cov, x0v);
        const float ks = smp ? 1.f : 0.f;
        ld8f(sfc + (size_t)(sidx * 2 + 1) * FF2 + ch0, s1g); ld8f(sfc + (size_t)(sidx * 2 + 1) * FF2 + FF + ch0, s1v); ld8f(sfc + (size_t)(sidx * 2) * FF2 + ch0, s0g); ld8f(sfc + (size_t)(sidx * 2) * FF2 + FF + ch0, s0v);
        float w0g[8], w1g[8], w2g[8], w0v[8], w1v[8], w2v[8], bg[8], bv[8];
        ld8f(cw + ch0, w0g); ld8f(cw + FF2 + ch0, w1g); ld8f(cw + 2 * FF2 + ch0, w2g); ld8f(cw + FF + ch0, w0v); ld8f(cw + FF2 + FF + ch0, w1v); ld8f(cw + 2 * FF2 + FF + ch0, w2v); ld8f(cb + ch0, bg); ld8f(cb + FF + ch0, bv);
        float a[8];
#pragma unroll
        for (int k = 0; k < 8; ++k) { const float q0g = k0 * x0g[k] + ks * s0g[k], q0v = k0 * x0v[k] + ks * s0v[k], q1g = k1 * x1g[k] + ks * s1g[k], q1v = k1 * x1v[k] + ks * s1v[k];
            const float ug = w0g[k] * q0g + w1g[k] * q1g + w2g[k] * x2g[k] + bg[k], uv = w0v[k] * q0v + w1v[k] * q1v + w2v[k] * x2v[k] + bv[k]; a[k] = siluf(ug) * uv; }
        *(v4u*)(ACT + (size_t)row * FF + ch0) = (v4u){pk2(a[0], a[1]), pk2(a[2], a[3]), pk2(a[4], a[5]), pk2(a[6], a[7])};
    }
    GAS float* pfc = F.out + O_PFC + (size_t)layer * NB * 2 * FF2; GAS float* sfo = F.out + O_SFC + (size_t)layer * NS * 2 * FF2;
    for (int i = gt; i < NB * 2 * FF2; i += NGT) { const int c = i % FF2, j = (i / FF2) & 1, b = i / (2 * FF2); const int isv = c >= FF ? 1 : 0; pfc[i] = RAWH[((size_t)(b * 32 + 31) * 4 + 2 + j) * FF2 + ffperm(c - isv * FF, isv)]; }
    for (int i = gt; i < NS * 2 * FF2; i += NGT) { const int c = i % FF2, j = (i / FF2) & 1, s_ = i / (2 * FF2); const int isv = c >= FF ? 1 : 0;
        sfo[i] = j == 0 ? sfc[(size_t)(s_ * 2 + 1) * FF2 + c] : RAWX[(size_t)(NMETA + s_) * FF2 + ffperm(c - isv * FF, isv)]; }
}

__device__ __forceinline__ void p_kvq(Frame& F) {
    const int gw = F.bid * 8 + F.wave, NGW = F.G * 8;
    const bf16* CK = (const bf16*)(F.ws + WS_CKVQ); bf16* CB = (bf16*)(F.ws + WS_CB); bf16* KRB = (bf16*)(F.ws + WS_KRB); bf16* QAN = (bf16*)(F.ws + WS_QAN);
    const float* ctab = (const float*)(F.ws + WS_ROPE); const float* stab = ctab + NPOSTAB * 32;
    const f32x4 gk = ((const f32x4*)F.in[I_KVANORM])[F.lane];
    float gq[6];
#pragma unroll
    for (int j = 0; j < 6; ++j) gq[j] = F.in[I_BQANORM][F.lane + 64 * j];
    for (int row = gw; row < NVALID; row += NGW) {
        const bf16* cr = CK + (size_t)row * 768;
        const v2u lw = ((const v2u*)cr)[F.lane]; f32x4 lat = {bflo(lw.x), bfhi(lw.x), bflo(lw.y), bfhi(lw.y)}; float ss = wave_sum((lat.x * lat.x + lat.y * lat.y) + (lat.z * lat.z + lat.w * lat.w));
        lat = lat * rsqrtf(ss * (1.f / KVL) + EPS) * gk;
        const int posidx = row < TR ? NMETA + (row & (SEQ - 1)) : (row < XS ? row - XM : LP);
        const int i = F.lane & 31; const float x1 = bf2f(cr[256 + i]), x2 = bf2f(cr[288 + i]), cs = ctab[posidx * 32 + i], sn = stab[posidx * 32 + i];
        const float kr = F.lane < 32 ? x1 * cs - x2 * sn : x2 * cs + x1 * sn;
        ((v2u*)(CB + (size_t)row * KVL))[F.lane] = (v2u){pk2(lat.x, lat.y), pk2(lat.z, lat.w)};
        KRB[(size_t)row * ROPE + F.lane] = (bf16)f2bf(kr);
        if (row < TR) { const int b = row >> 11, t = row & (SEQ - 1); ((f32x4*)(F.out + O_PKV + ((size_t)b * LP + NMETA + t) * KVL))[F.lane] = lat; F.out[O_PKR + ((size_t)b * LP + NMETA + t) * ROPE + F.lane] = kr; }
        else if (row < XS) { const int m = row - XM;
            for (int b = 0; b < NB; ++b) { ((f32x4*)(F.out + O_PKV + ((size_t)b * LP + m) * KVL))[F.lane] = lat; F.out[O_PKR + ((size_t)b * LP + m) * ROPE + F.lane] = kr; } }
        else { const int s = row - XS; ((f32x4*)(F.out + O_SKV + (size_t)s * KVL))[F.lane] = lat; F.out[O_SKR + (size_t)s * ROPE + F.lane] = kr; }
        float qa[6]; float sq = 0.f;
#pragma unroll
        for (int j = 0; j < 6; ++j) { qa[j] = bf2f(cr[320 + F.lane + 64 * j]); sq += qa[j] * qa[j]; }
        sq = wave_sum(sq); const float rq = rsqrtf(sq * (1.f / QL) + EPS);
#pragma unroll
        for (int j = 0; j < 6; ++j) QAN[(size_t)row * QL + F.lane + 64 * j] = (bf16)f2bf(qa[j] * rq * gq[j]);
    }
}
__device__ __forceinline__ void p_qrope(Frame& F) {
    const int gw = F.bid * 8 + F.wave, NGW = F.G * 8;
    bf16* Q = (bf16*)(F.ws + WS_Q); const float* ctab = (const float*)(F.ws + WS_ROPE); const float* stab = ctab + NPOSTAB * 32;
    for (int row = gw; row < NVALID; row += NGW) {
        const int posidx = row < TR ? NMETA + (row & (SEQ - 1)) : (row < XS ? row - XM : LP);
#pragma unroll
        for (int j = 0; j < 4; ++j) { const int idx = F.lane + 64 * j, h = idx >> 5, i = idx & 31; bf16* q = Q + (size_t)row * 1536 + h * HD + NOPE + i;
            const float x1 = bf2f(q[0]), x2 = bf2f(q[32]), cs = ctab[posidx * 32 + i], sn = stab[posidx * 32 + i];
            q[0] = (bf16)f2bf(x1 * cs - x2 * sn); q[32] = (bf16)f2bf(x2 * cs + x1 * sn); }
    }
}

constexpr int SHM_K = 64 * HD * 2, SHM_V = 64 * 128 * 2;
constexpr int ATT_K = 0, ATT_V = 2 * SHM_K, ATT_WS = ATT_V + 3 * SHM_V, ATT_QPE = ATT_WS + 8 * 64 * 4;
static_assert(ATT_QPE + 8 * 4096 <= CTLLDS_OFF, "attention LDS");
#define KSWZ(row, colB) ((row) * 384 + ((colB) ^ ((((row) >> 1) & 7) << 4)))
__device__ __forceinline__ int v_st(int k, int c) { const int kk = (k & ~0xC) | ((k & 4) << 1) | ((k & 8) >> 1); return ((kk >> 3) * 4 + (c >> 5)) * 512 + ((kk & 7) * 32 + (c & 31)) * 2; }
__device__ __forceinline__ int v_rd_base(int lane) { return ((lane & 3) << 3) | (((lane >> 2) & 3) << 6) | (((lane >> 4) & 1) << 5) | (((lane >> 5) & 1) << 8); }
constexpr int v_rd_off(int d0, int ks, int half) { return d0 * 512 + ks * 4096 + half * 2048; }
__device__ __forceinline__ int crow(int r, int hi) { return (r & 3) + 8 * (r >> 2) + 4 * hi; }
__device__ __forceinline__ unsigned cvtpk(float lo, float hi) { return pg8::cvt_pk_bf16(lo, hi); }
__device__ __forceinline__ bf16x8 pack8f(const f32x4 a, const f32x4 b) { v4u w = {cvtpk(a.x, a.y), cvtpk(a.z, a.w), cvtpk(b.x, b.y), cvtpk(b.z, b.w)}; return *reinterpret_cast<bf16x8*>(&w); }
__device__ __forceinline__ f32x4 mfma16(bf16x8 a, bf16x8 b, f32x4 c) { return __builtin_amdgcn_mfma_f32_16x16x32_bf16(a, b, c, 0, 0, 0); }
constexpr float ATT_THR = 8.f;
__device__ __forceinline__ void partialSM(f32x16& p0, f32x16& p1, float& m_reg, float& mn, float& alpha) {
    float pmax = p0[0];
#pragma unroll
    for (int r = 1; r < 16; ++r) pmax = fmaxf(pmax, p0[r]);
#pragma unroll
    for (int r = 0; r < 16; ++r) pmax = fmaxf(pmax, p1[r]);
    { auto rr = __builtin_amdgcn_permlane32_swap(__float_as_uint(pmax), __float_as_uint(pmax), false, false);
      pmax = fmaxf(__uint_as_float(rr[0]), __uint_as_float(rr[1])); }
    constexpr float C2 = 1.4426950408889634f * MLA_SCALE;
    if (__builtin_expect(__all((pmax - m_reg) * MLA_SCALE <= ATT_THR), 1)) { mn = m_reg; alpha = 1.f; }
    else { mn = fmaxf(m_reg, pmax); alpha = __builtin_amdgcn_exp2f((m_reg - mn) * C2); m_reg = mn; }
    const float mnL = -mn * C2;
#pragma unroll
    for (int r = 0; r < 16; ++r) p0[r] = fmaf(p0[r], C2, mnL);
#pragma unroll
    for (int r = 0; r < 16; ++r) p1[r] = fmaf(p1[r], C2, mnL);
#pragma unroll
    for (int r = 0; r < 16; ++r) p0[r] = __builtin_amdgcn_exp2f(p0[r]);
}
__device__ __forceinline__ void finishSM(f32x16& p0, f32x16& p1, float alpha, float& l_reg, bf16x8& pa0, bf16x8& pa1, bf16x8& pa2, bf16x8& pa3) {
#pragma unroll
    for (int r = 0; r < 16; ++r) p1[r] = __builtin_amdgcn_exp2f(p1[r]);
    float ps = 0;
#pragma unroll
    for (int r = 0; r < 16; ++r) ps += p0[r];
#pragma unroll
    for (int r = 0; r < 16; ++r) ps += p1[r];
    { auto rr = __builtin_amdgcn_permlane32_swap(__float_as_uint(ps), __float_as_uint(ps), false, false);
      ps = __uint_as_float(rr[0]) + __uint_as_float(rr[1]); }
    l_reg = l_reg * alpha + ps;
#define PK4(P, B_, OUT) do { unsigned a0 = cvtpk(P[B_+0], P[B_+1]), a1 = cvtpk(P[B_+2], P[B_+3]);                          \
        unsigned b0 = cvtpk(P[B_+4], P[B_+5]), b1 = cvtpk(P[B_+6], P[B_+7]);                                             \
        auto r0 = __builtin_amdgcn_permlane32_swap(a0, b0, false, false); auto r1 = __builtin_amdgcn_permlane32_swap(a1, b1, false, false); \
        v4u w = {r0[0], r1[0], r0[1], r1[1]}; OUT = *reinterpret_cast<bf16x8*>(&w); } while (0)
    PK4(p0, 0, pa0); PK4(p0, 8, pa1); PK4(p1, 0, pa2); PK4(p1, 8, pa3);
#undef PK4
}
__device__ __forceinline__ void qkt192(f32x16& p0, f32x16& p1, const LAS char* Kb, int r32, int hi, const bf16x8* qr, const LAS char* qpe) {
    p0 = f32x16{}; p1 = f32x16{};
    const LAS char* kb[4];
#pragma unroll
    for (int dd = 0; dd < 4; ++dd) kb[dd] = Kb + KSWZ(r32, (dd * 16 + hi * 8) * 2);
#pragma unroll
    for (int d0 = 0; d0 < 12; ++d0) { const LAS char* a = kb[d0 & 3] + (d0 >> 2) * 128;
        const bf16x8 b0 = *(const LAS bf16x8*)a, b1 = *(const LAS bf16x8*)(a + 32 * 384);
        const bf16x8 qf = d0 < 8 ? qr[d0 & 7] : *(const LAS bf16x8*)(qpe + (d0 & 3) * 1024);
        p0 = __builtin_amdgcn_mfma_f32_32x32x16_bf16(b0, qf, p0, 0, 0, 0);
        p1 = __builtin_amdgcn_mfma_f32_32x32x16_bf16(b1, qf, p1, 0, 0, 0);
        if ((d0 & 3) == 3) __builtin_amdgcn_sched_barrier(0); }
}
__device__ __forceinline__ void pv_tile(f32x16* o, int vb0, bf16x8 pa0, bf16x8 pa1, bf16x8 pa2, bf16x8 pa3) {
#define TRRD(dst, off) asm volatile("ds_read_b64_tr_b16 %0, %1 offset:%2" : "=&v"(dst) : "v"(vb0), "i"(off) : "memory")
#define PV_D0(d0) do { s16x4 l0, l1, l2, l3, h0, h1, h2, h3; constexpr int b_ = v_rd_off(d0, 0, 0); \
        TRRD(l0, b_); TRRD(h0, b_ + 2048); TRRD(l1, b_ + 4096); TRRD(h1, b_ + 6144); TRRD(l2, b_ + 8192); TRRD(h2, b_ + 10240); TRRD(l3, b_ + 12288); TRRD(h3, b_ + 14336); \
        asm volatile("s_waitcnt lgkmcnt(0)" ::: "memory"); __builtin_amdgcn_sched_barrier(0); \
        o[d0] = __builtin_amdgcn_mfma_f32_32x32x16_bf16(pa0, (bf16x8){l0[0], l0[1], l0[2], l0[3], h0[0], h0[1], h0[2], h0[3]}, o[d0], 0, 0, 0);   \
        o[d0] = __builtin_amdgcn_mfma_f32_32x32x16_bf16(pa1, (bf16x8){l1[0], l1[1], l1[2], l1[3], h1[0], h1[1], h1[2], h1[3]}, o[d0], 0, 0, 0);   \
        o[d0] = __builtin_amdgcn_mfma_f32_32x32x16_bf16(pa2, (bf16x8){l2[0], l2[1], l2[2], l2[3], h2[0], h2[1], h2[2], h2[3]}, o[d0], 0, 0, 0);   \
        o[d0] = __builtin_amdgcn_mfma_f32_32x32x16_bf16(pa3, (bf16x8){l3[0], l3[1], l3[2], l3[3], h3[0], h3[1], h3[2], h3[3]}, o[d0], 0, 0, 0); } while (0)
    PV_D0(0); PV_D0(1); PV_D0(2); PV_D0(3);
#undef PV_D0
#undef TRRD
}
__device__ __forceinline__ void attn_qblock(Frame& F, int b, int h, int qb) {
    const int wid = F.wave, lane = F.lane, r32 = lane & 31, hi = lane >> 5;
    const bf16* Q = (const bf16*)(F.ws + WS_Q); const bf16* KNV = (const bf16*)(F.ws + WS_KNV); const bf16* KRB = (const bf16*)(F.ws + WS_KRB); bf16* AO = (bf16*)(F.ws + WS_AO);
    LAS char* K_lds = (LAS char*)F.lds + ATT_K; LAS char* V_lds = (LAS char*)F.lds + ATT_V;
    LAS float* wsf = (LAS float*)(F.lds + ATT_WS) + wid * 64; LAS float* li_l = wsf; LAS float* al_l = wsf + 32;
    bf16x8 qr[8]; LAS char* qpe = (LAS char*)F.lds + ATT_QPE + wid * 4096 + lane * 16;
    { const bf16* qp = Q + (size_t)(b * SEQ + qb * 256 + wid * 32 + r32) * 1536 + h * HD + hi * 8;
#pragma unroll
      for (int d0 = 0; d0 < 8; ++d0) qr[d0] = *(const bf16x8*)(qp + d0 * 16);
      const float* ctab = (const float*)(F.ws + WS_ROPE); const float* stab = ctab + NPOSTAB * 32; const int pidx = (NMETA + qb * 256 + wid * 32 + r32) * 32 + hi * 8;
#pragma unroll
      for (int pr = 0; pr < 2; ++pr) { const v4u wa = *(const v4u*)(qp + (8 + pr) * 16), wb = *(const v4u*)(qp + (10 + pr) * 16);
          const f32x4 c0 = *(const f32x4*)(ctab + pidx + 16 * pr), c1 = *(const f32x4*)(ctab + pidx + 16 * pr + 4), s0 = *(const f32x4*)(stab + pidx + 16 * pr), s1 = *(const f32x4*)(stab + pidx + 16 * pr + 4);
          const float xa[8] = {bflo(wa.x), bfhi(wa.x), bflo(wa.y), bfhi(wa.y), bflo(wa.z), bfhi(wa.z), bflo(wa.w), bfhi(wa.w)}, xb[8] = {bflo(wb.x), bfhi(wb.x), bflo(wb.y), bfhi(wb.y), bflo(wb.z), bfhi(wb.z), bflo(wb.w), bfhi(wb.w)};
          const float cs[8] = {c0.x, c0.y, c0.z, c0.w, c1.x, c1.y, c1.z, c1.w}, sn[8] = {s0.x, s0.y, s0.z, s0.w, s1.x, s1.y, s1.z, s1.w};
          float oa[8], ob[8];
#pragma unroll
          for (int e = 0; e < 8; ++e) { oa[e] = xa[e] * cs[e] - xb[e] * sn[e]; ob[e] = xb[e] * cs[e] + xa[e] * sn[e]; }
          const v4u va = {cvtpk(oa[0], oa[1]), cvtpk(oa[2], oa[3]), cvtpk(oa[4], oa[5]), cvtpk(oa[6], oa[7])}, vb = {cvtpk(ob[0], ob[1]), cvtpk(ob[2], ob[3]), cvtpk(ob[4], ob[5]), cvtpk(ob[6], ob[7])};
          *(LAS v4u*)(qpe + pr * 1024) = va; *(LAS v4u*)(qpe + (2 + pr) * 1024) = vb; } }
    const int NT = 1 + 4 * (qb + 1);
    unsigned k0o[3], k1o[3], v0o[2], v1o[2];
#pragma unroll
    for (int j = 0; j < 3; ++j) { const int off = 1024 * (wid * 3 + j) + 16 * lane, row = off / 384, cb = off - row * 384, colB = cb ^ (((row >> 1) & 7) << 4), col = colB >> 1; const bool isr = col >= 128;
        const unsigned rb = isr ? (unsigned)(ROPE * 2) : 4096u, cpart = isr ? (unsigned)(WS_KRB + (size_t)(col - 128) * 2) : (unsigned)(WS_KNV + (size_t)(h * 128 + col) * 2);
        k0o[j] = (unsigned)(XM + (row < 16 ? row : 15)) * rb + cpart; k1o[j] = ((unsigned)(b * SEQ + row) * rb + cpart) | (isr ? 1u : 0u); }
#pragma unroll
    for (int j = 0; j < 2; ++j) { const int off = 1024 * (wid * 2 + j) + 16 * lane, sub = off >> 9, within = off & 511, kk = (sub >> 2) * 8 + (within >> 6), k = (kk & ~0xC) | ((kk & 4) << 1) | ((kk & 8) >> 1);
        const unsigned cpart = (unsigned)(WS_KNV + (size_t)(1024 + h * 128 + (sub & 3) * 32 + ((within & 63) >> 1)) * 2);
        v0o[j] = (unsigned)(XM + (k < 16 ? k : 15)) * 4096u + cpart; v1o[j] = (unsigned)(b * SEQ + k) * 4096u + cpart; }
    const GAS unsigned char* wsb = F.ws;
#define KDMA0(bi) do { _Pragma("unroll") for (int j_ = 0; j_ < 3; ++j_) __builtin_amdgcn_global_load_lds((const unsigned*)(wsb + k0o[j_]), (LAS unsigned*)(K_lds + (bi) * SHM_K + (wid * 3 + j_) * 1024), 16, 0, 0); } while (0)
#define VDMA0(bi) do { _Pragma("unroll") for (int j_ = 0; j_ < 2; ++j_) __builtin_amdgcn_global_load_lds((const unsigned*)(wsb + v0o[j_]), (LAS unsigned*)(V_lds + (bi) * SHM_V + (wid * 2 + j_) * 1024), 16, 0, 0); } while (0)
#define KDMA(t, bi) do { _Pragma("unroll") for (int j_ = 0; j_ < 3; ++j_) { const unsigned o_ = (k1o[j_] & ~1u) + (unsigned)((t) - 1) * ((k1o[j_] & 1u) ? 64u * (unsigned)(ROPE * 2) : 64u * 4096u); \
            __builtin_amdgcn_global_load_lds((const unsigned*)(wsb + o_), (LAS unsigned*)(K_lds + (bi) * SHM_K + (wid * 3 + j_) * 1024), 16, 0, 0); } } while (0)
#define VDMA(t, bi) do { _Pragma("unroll") for (int j_ = 0; j_ < 2; ++j_) { const unsigned o_ = v1o[j_] + (unsigned)((t) - 1) * (64u * 4096u); \
            __builtin_amdgcn_global_load_lds((const unsigned*)(wsb + o_), (LAS unsigned*)(V_lds + (bi) * SHM_V + (wid * 2 + j_) * 1024), 16, 0, 0); } } while (0)
    const int vb0 = (int)(unsigned)(uintptr_t)V_lds + v_rd_base(lane);
    const int qlo = qb * 256 + wid * 32, qm = qlo + r32 - 4 * hi;
    KDMA0(0); VDMA0(0); KDMA(1, 1); VDMA(1, 1);
    float m_reg = -1e30f, l_reg = 0.f; f32x16 o[4] = {};
    const float NEG = -__builtin_inff();
    f32x16 pA0, pA1, pB0, pB1; float mnA, mnB, alA, alB; bf16x8 pa0, pa1, pa2, pa3;
#define RESC(a) do { if (__any((a) < 1.f)) { if (hi == 0) al_l[r32] = (a); LDS_WAIT(); \
        _Pragma("unroll") for (int d_ = 0; d_ < 4; ++d_) _Pragma("unroll") for (int r = 0; r < 16; ++r) o[d_][r] *= al_l[crow(r, hi)]; } } while (0)
#define MASKT(P0_, P1_, t_) do { const int kb_ = ((t_) - 1) * 64; if (kb_ + 63 > qlo) { const int dq = qm - kb_; \
        _Pragma("unroll") for (int r = 0; r < 16; ++r) { const int c = (r & 3) + 8 * (r >> 2); if (dq - c < 0) P0_[r] = NEG; if (dq - c - 32 < 0) P1_[r] = NEG; } } } while (0)
    asm volatile("s_waitcnt vmcnt(5)" ::: "memory"); asm volatile("s_waitcnt lgkmcnt(0)" ::: "memory"); __builtin_amdgcn_s_barrier(); asm volatile("" ::: "memory");
    qkt192(pA0, pA1, K_lds, r32, hi, qr, qpe);
#pragma unroll
    for (int r = 0; r < 16; ++r) { const int c = (r & 3) + 8 * (r >> 2) + 4 * hi; if (c >= NMETA) pA0[r] = NEG; pA1[r] = NEG; }
    partialSM(pA0, pA1, m_reg, mnA, alA);
    int vprev = 0, vcur = 1;
#define HALF_STEP(PX0, PX1, mnX, alX, PY0, PY1, alY, t_) do { \
        asm volatile("s_waitcnt vmcnt(2)" ::: "memory"); asm volatile("s_waitcnt lgkmcnt(0)" ::: "memory"); __builtin_amdgcn_s_barrier(); asm volatile("" ::: "memory");     \
        const int vnext_ = vcur == 2 ? 0 : vcur + 1; \
        if ((t_) + 1 < NT) { KDMA((t_) + 1, ((t_) + 1) & 1); VDMA((t_) + 1, vnext_); } \
        qkt192(PX0, PX1, K_lds + ((t_) & 1) * SHM_K, r32, hi, qr, qpe); \
        finishSM(PY0, PY1, alY, l_reg, pa0, pa1, pa2, pa3); __builtin_amdgcn_sched_barrier(0); \
        pv_tile(o, vb0 + vprev * SHM_V, pa0, pa1, pa2, pa3); \
        MASKT(PX0, PX1, t_); partialSM(PX0, PX1, m_reg, mnX, alX); \
        RESC(alX); \
        vprev = vcur; vcur = vnext_; } while (0)
#pragma unroll 1
    for (int t = 1; t + 1 < NT; t += 2) {
        HALF_STEP(pB0, pB1, mnB, alB, pA0, pA1, alA, t);
        HALF_STEP(pA0, pA1, mnA, alA, pB0, pB1, alB, t + 1);
    }
    asm volatile("s_waitcnt vmcnt(0)" ::: "memory"); asm volatile("s_waitcnt lgkmcnt(0)" ::: "memory"); __builtin_amdgcn_s_barrier(); asm volatile("" ::: "memory");
    finishSM(pA0, pA1, alA, l_reg, pa0, pa1, pa2, pa3); __builtin_amdgcn_sched_barrier(0);
    pv_tile(o, vb0 + vprev * SHM_V, pa0, pa1, pa2, pa3);
#undef HALF_STEP
#undef MASKT
#undef RESC
    { int ln = F.lane; asm volatile("" : "+v"(ln));
      const int r32e = ln & 31, hie = ln >> 5; LAS float* li_e = (LAS float*)(F.lds + ATT_WS) + wid * 64;
      if (hie == 0) li_e[r32e] = l_reg; LDS_WAIT();
      bf16* Ow = (bf16*)(F.ws + WS_AO) + (size_t)(b * SEQ + qb * 256 + wid * 32) * DM + h * 128;
#pragma unroll
      for (int r = 0; r < 16; ++r) { const int orow = crow(r, hie); const float rl = __builtin_amdgcn_rcpf(li_e[orow]);
#pragma unroll
          for (int d0 = 0; d0 < 4; ++d0) { const float v = o[d0][r] * rl; const float vn = DPPF(v, 0xB1);
              if ((r32e & 1) == 0) *(unsigned*)(Ow + (size_t)orow * DM + d0 * 32 + r32e) = cvtpk(v, vn); } } }
    __syncthreads();
#undef KDMA
#undef VDMA
#undef KDMA0
#undef VDMA0
}
__device__ __forceinline__ void attn_meta(Frame& F) {
    const bf16* Q = (const bf16*)(F.ws + WS_Q); const bf16* KNV = (const bf16*)(F.ws + WS_KNV); const bf16* KRB = (const bf16*)(F.ws + WS_KRB); bf16* AO = (bf16*)(F.ws + WS_AO);
    for (int it = F.wave; it < NMETA * MH; it += 8) {
        const int m = it >> 3, h = it & 7;
        const bf16* q = Q + (size_t)(XM + m) * 1536 + h * HD;
        const float q0 = bf2f(q[F.lane]), q1 = bf2f(q[64 + F.lane]); float q2;
        { const float* ctab = (const float*)(F.ws + WS_ROPE); const float* stab = ctab + NPOSTAB * 32; const int i = F.lane & 31; const float x = bf2f(q[128 + F.lane]), y = [&]{ auto r_ = __builtin_amdgcn_permlane32_swap(__float_as_uint(x), __float_as_uint(x), false, false); return F.lane < 32 ? __uint_as_float(r_[1]) : __uint_as_float(r_[0]); }(), cs = ctab[m * 32 + i], sn = stab[m * 32 + i];
          q2 = F.lane < 32 ? x * cs - y * sn : x * cs + y * sn; }
        float sc[NMETA]; float mx = -1e30f;
#pragma unroll
        for (int k = 0; k < NMETA; ++k) { const bf16* kn = KNV + (size_t)(XM + k) * 2048 + h * 128; const float d = wave_sum(q0 * bf2f(kn[F.lane]) + q1 * bf2f(kn[64 + F.lane]) + q2 * bf2f(KRB[(size_t)(XM + k) * ROPE + F.lane]));
            sc[k] = k <= m ? d * MLA_SCALE : -1e30f; mx = fmaxf(mx, sc[k]); }
        float l = 0.f, o0 = 0.f, o1 = 0.f;
#pragma unroll
        for (int k = 0; k < NMETA; ++k) { const float p = k <= m ? __expf(sc[k] - mx) : 0.f; l += p; const bf16* v = KNV + (size_t)(XM + k) * 2048 + 1024 + h * 128; o0 += p * bf2f(v[F.lane]); o1 += p * bf2f(v[64 + F.lane]); }
        AO[(size_t)(XM + m) * DM + h * 128 + F.lane] = (bf16)f2bf(o0 / l); AO[(size_t)(XM + m) * DM + h * 128 + 64 + F.lane] = (bf16)f2bf(o1 / l);
    }
}
__device__ __forceinline__ void attn_sample_item(Frame& F, int s) {
    const int tid = F.tid, lane = F.lane, wid = F.wave;
    const bf16* Q = (const bf16*)(F.ws + WS_Q) + (size_t)(XS + s) * 1536;
    LAS float* qn = (LAS float*)F.lds;
    LAS float* qlat = qn + 8 * 192;
    LAS float* qpe = qlat + 8 * 256;
    LAS float* xm = qpe + 8 * 64;
    LAS float* xl = xm + 64;
    LAS float* ssf = xl + 64;
    LAS int* ptl = (LAS int*)(ssf + 64);
    LAS float* xo = (LAS float*)(ptl + 64);
    LAS float* olat = xo + 8 * 8 * 256;
    for (int i = tid; i < 8 * 192; i += 512) qn[i] = bf2f(Q[i]);
    if (tid < NPAGE) ptl[tid] = ((const int*)F.in[I_PT])[s * NPAGE + tid];
    __syncthreads();
    { const float* wuk = F.in[I_WUK] + wid * 128 + lane; const float q0 = qn[wid * 192 + lane], q1 = qn[wid * 192 + 64 + lane];
#pragma unroll 1
      for (int rb = 0; rb < 256; rb += 64) {
          float a[64];
#pragma unroll
          for (int r = 0; r < 64; ++r) { const float* w = wuk + (size_t)(rb + r) * 1024; a[r] = q0 * w[0] + q1 * w[64]; }
#pragma unroll
          for (int i = 0; i < 32; ++i) { auto r_ = __builtin_amdgcn_permlane32_swap(__float_as_uint(a[i]), __float_as_uint(a[i + 32]), false, false); a[i] = __uint_as_float(r_[0]) + __uint_as_float(r_[1]); }
#pragma unroll
          for (int i = 0; i < 16; ++i) { auto r_ = __builtin_amdgcn_permlane16_swap(__float_as_uint(a[i]), __float_as_uint(a[i + 16]), false, false); a[i] = __uint_as_float(r_[0]) + __uint_as_float(r_[1]); }
#define SA_DPP(x, ctrl) __builtin_bit_cast(float, __builtin_amdgcn_update_dpp(0, __builtin_bit_cast(int, (x)), (ctrl), 0xF, 0xF, false))
          { const bool b3 = (lane & 8) != 0, b2 = (lane & 4) != 0, b1 = (lane & 2) != 0, b0 = (lane & 1) != 0;
#pragma unroll
            for (int i = 0; i < 8; ++i) { const float keep = b3 ? a[i + 8] : a[i], send = b3 ? a[i] : a[i + 8]; a[i] = keep + SA_DPP(send, 0x140); }
#pragma unroll
            for (int i = 0; i < 4; ++i) { const float keep = b2 ? a[i + 4] : a[i], send = b2 ? a[i] : a[i + 4]; a[i] = keep + SA_DPP(send, 0x141); }
#pragma unroll
            for (int i = 0; i < 2; ++i) { const float keep = b1 ? a[i + 2] : a[i], send = b1 ? a[i] : a[i + 2]; a[i] = keep + SA_DPP(send, 0x1B); }
            { const float keep = b0 ? a[1] : a[0], send = b0 ? a[0] : a[1]; a[0] = keep + SA_DPP(send, 0xB1); } }
          qlat[wid * 256 + rb + lane] = a[0];
      }
      { const float* ctab = (const float*)(F.ws + WS_ROPE); const float* stab = ctab + NPOSTAB * 32; const int i = lane & 31; const float x1 = qn[wid * 192 + 128 + i], x2 = qn[wid * 192 + 160 + i], cs = ctab[LP * 32 + i], sn = stab[LP * 32 + i];
        qpe[tid] = lane < 32 ? x1 * cs - x2 * sn : x2 * cs + x1 * sn; } }
    __syncthreads();
    const GAS float* cs = F.out + O_SKV + (size_t)s * KVL; const GAS float* krs = F.out + O_SKR + (size_t)s * ROPE;
    { const f32x4 qv = *(const LAS f32x4*)(qlat + wid * 256 + 4 * lane), cv = ((const f32x4*)cs)[lane];
      const float d = wave_sum((qv.x * cv.x + qv.y * cv.y) + (qv.z * cv.z + qv.w * cv.w) + qpe[wid * 64 + lane] * krs[lane]); if (lane == 0) ssf[wid] = d * MLA_SCALE; }
    const int c16 = lane & 15, g = lane >> 4;
    LAS bf16x8* qfl = (LAS bf16x8*)(olat + 8 * 256);
#pragma unroll
    for (int ks = 0; ks < 10; ++ks) { f32x4 a = {0.f, 0.f, 0.f, 0.f}, b = a;
        if (c16 < 8) { const LAS float* qq = ks < 8 ? qlat + c16 * 256 + 32 * ks + 8 * g : qpe + c16 * 64 + 32 * (ks - 8) + 8 * g; a = *(const LAS f32x4*)qq; b = *(const LAS f32x4*)(qq + 4); }
        if (wid == 0) qfl[ks * 64 + lane] = pack8f(a, b); }
    __syncthreads();
    f32x4 O[16]; float m_run = -1e30f, l_run = 0.f;
#pragma unroll
    for (int mt = 0; mt < 16; ++mt) O[mt] = (f32x4){0.f, 0.f, 0.f, 0.f};
    const float* ckv = F.in[I_CKV]; const float* ckr = F.in[I_CKR];
    LAS char* vt = (LAS char*)xo + wid * 9216;
    const unsigned lo_t = (unsigned)(c16 * KVL + 8 * g) * 4u, lo_r = (unsigned)(c16 * ROPE + 8 * g) * 4u;
    const char* ckvb = (const char*)ckv; const char* ckrb = (const char*)ckr;
#define SA_LOADT(gi_) do { const unsigned page_ = (unsigned)__builtin_amdgcn_readfirstlane(ptl[wid * 8 + ((gi_) >> 3)]); const unsigned row_ = page_ * (unsigned)PAGE + (unsigned)(((gi_) & 7) * 16); \
        const unsigned ka_ = row_ * (unsigned)(KVL * 4) + lo_t, ra_ = row_ * (unsigned)(ROPE * 4) + lo_r; \
        _Pragma("unroll") for (int ks = 0; ks < 8; ++ks) { t[2 * ks] = *(const f32x4*)(ckvb + (ka_ + 128u * ks)); t[2 * ks + 1] = *(const f32x4*)(ckvb + (ka_ + 128u * ks + 16u)); } \
        t[16] = *(const f32x4*)(ckrb + ra_); t[17] = *(const f32x4*)(ckrb + (ra_ + 16u)); t[18] = *(const f32x4*)(ckrb + (ra_ + 128u)); t[19] = *(const f32x4*)(ckrb + (ra_ + 144u)); } while (0)
    f32x4 t[20];
    SA_LOADT(0);
#pragma unroll 1
    for (int gi = 0; gi < 64; ++gi) {
        bf16x8 kf[10];
#pragma unroll
        for (int ks = 0; ks < 10; ++ks) kf[ks] = pack8f(t[2 * ks], t[2 * ks + 1]);
        __builtin_amdgcn_sched_barrier(0);
        if (gi < 63) SA_LOADT(gi + 1);
        __builtin_amdgcn_sched_barrier(0);
        f32x4 acc = {0.f, 0.f, 0.f, 0.f};
#pragma unroll
        for (int ks = 0; ks < 10; ++ks) acc = mfma16(kf[ks], qfl[ks * 64 + lane], acc);
#pragma unroll
        for (int ks = 0; ks < 8; ++ks) { const v4u kw = __builtin_bit_cast(v4u, kf[ks]); const unsigned kk[4] = {kw.x, kw.y, kw.z, kw.w};
#pragma unroll
            for (int e = 0; e < 8; ++e) *(LAS bf16*)(vt + (32 * ks + 8 * g + e) * 36 + 2 * c16) = (bf16)((e & 1) ? (kk[e >> 1] >> 16) : (kk[e >> 1] & 0xffffu)); }
        float sc[4], mx;
#pragma unroll
        for (int r = 0; r < 4; ++r) sc[r] = acc[r] * MLA_SCALE;
        mx = fmaxf(fmaxf(sc[0], sc[1]), fmaxf(sc[2], sc[3]));
        { auto r_ = __builtin_amdgcn_permlane16_swap(__float_as_uint(mx), __float_as_uint(mx), false, false); mx = fmaxf(__uint_as_float(r_[0]), __uint_as_float(r_[1])); }
        { auto r_ = __builtin_amdgcn_permlane32_swap(__float_as_uint(mx), __float_as_uint(mx), false, false); mx = fmaxf(__uint_as_float(r_[0]), __uint_as_float(r_[1])); }
        const float mnew = fmaxf(m_run, mx), alpha = __expf(m_run - mnew); float pr[4], ps;
#pragma unroll
        for (int r = 0; r < 4; ++r) pr[r] = __expf(sc[r] - mnew);
        ps = (pr[0] + pr[1]) + (pr[2] + pr[3]);
        { auto r_ = __builtin_amdgcn_permlane16_swap(__float_as_uint(ps), __float_as_uint(ps), false, false); ps = __uint_as_float(r_[0]) + __uint_as_float(r_[1]); }
        { auto r_ = __builtin_amdgcn_permlane32_swap(__float_as_uint(ps), __float_as_uint(ps), false, false); ps = __uint_as_float(r_[0]) + __uint_as_float(r_[1]); }
        l_run = l_run * alpha + ps; m_run = mnew;
        LDS_WAIT();
        { typedef short bf16x4 __attribute__((ext_vector_type(4)));
          const v2u pw = {cvtpk(pr[0], pr[1]), cvtpk(pr[2], pr[3])}; const bf16x4 pb = __builtin_bit_cast(bf16x4, pw);
#pragma unroll
          for (int mt = 0; mt < 16; ++mt) { const LAS unsigned* ap = (const LAS unsigned*)(vt + (16 * mt + c16) * 36 + 8 * g); const v2u aw = {ap[0], ap[1]};
              O[mt] = __builtin_amdgcn_mfma_f32_16x16x16bf16_1k(__builtin_bit_cast(bf16x4, aw), pb, O[mt] * alpha, 0, 0, 0); } }
    }
#undef SA_LOADT
#undef SA_DPP
    __syncthreads();
    if (lane < 8) { xm[wid * 8 + lane] = m_run; xl[wid * 8 + lane] = l_run; }
    if (c16 < 8) {
#pragma unroll
        for (int mt = 0; mt < 16; ++mt) *(LAS f32x4*)(xo + (size_t)(wid * 8 + c16) * 256 + 16 * mt + 4 * g) = O[mt]; }
    __syncthreads();
    for (int e = tid; e < 8 * 256; e += 512) { const int h = e >> 8, r = e & 255; const float ms = ssf[h]; float M = ms;
#pragma unroll
        for (int w = 0; w < 8; ++w) M = fmaxf(M, xm[w * 8 + h]);
        const float es = __expf(ms - M); float acc = es * cs[r], L = es;
#pragma unroll
        for (int w = 0; w < 8; ++w) { const float e_ = __expf(xm[w * 8 + h] - M); acc += xo[(size_t)(w * 8 + h) * 256 + r] * e_; L += xl[w * 8 + h] * e_; }
        olat[e] = acc / L; }
    __syncthreads();
    const float* wuv = F.in[I_WUV]; bf16* AO = (bf16*)(F.ws + WS_AO) + (size_t)(XS + s) * DM;
    for (int e = tid; e < 8 * 128; e += 512) { const int h = e >> 7; const LAS float* ol = olat + h * 256; float acc = 0.f;
#pragma unroll 8
        for (int r = 0; r < 256; ++r) acc += ol[r] * wuv[(size_t)r * 1024 + e];
        AO[e] = (bf16)f2bf(acc); }
    __syncthreads();
}

constexpr int NCHR = NB * 32 * GH, NCH = NCHR + GH;
constexpr int TS = 132;
constexpr int SREC = 57344;
constexpr int SR_W = 0, SR_Q = 16384, SR_AT = 32768, SR_KT = 40960;

struct PrepRaw { v4u x[6]; f32x4 fx[4][2]; float ab_a, ab_b; };
struct PrepW { f32x4 w[4][2]; };
__device__ __forceinline__ void gdn_prep_load(Frame& F, int ch, PrepRaw& R) {
    if (ch >= NCHR) return;
    const int tid = F.tid, h = ch & 7, bc = ch >> 3, b = bc >> 5, c = bc & 31, row0 = b * SEQ + c * 64;
    const bf16* QKVZ = (const bf16*)(F.ws + WS_QKVZ);
#pragma unroll
    for (int k = 0; k < 6; ++k) { const int uu = tid + 512 * k, tok = uu / 48, cg = uu - tok * 48, col0 = cg * 8, gcol = (col0 >> 7) * 1024 + h * 128 + (col0 & 127);
        R.x[k] = *(const v4u*)(QKVZ + (size_t)(row0 + tok) * 4096 + gcol); }
    if (tid < 144) { const int tok = tid / 48, cg = tid - tok * 48, col0 = cg * 8, gcol = (col0 >> 7) * 1024 + h * 128 + (col0 & 127), grp = b * 32 + c; const float* RAWQ = (const float*)(F.ws + WS_RAWQ);
#pragma unroll
        for (int j = 0; j < 4; ++j) { const int r = tok - 3 + j;
            if (r >= 0 || c > 0) { const float* p = RAWQ + ((size_t)(r >= 0 ? grp : grp - 1) * 6 + (r >= 0 ? r : 6 + r)) * GQKV + gcol; R.fx[j][0] = *(const f32x4*)p; R.fx[j][1] = *(const f32x4*)(p + 4); }
            else { const v4u q = *(const v4u*)(QKVZ + (size_t)(XM + NMETA + r) * 4096 + gcol); R.fx[j][0] = (f32x4){bflo(q.x), bfhi(q.x), bflo(q.y), bfhi(q.y)}; R.fx[j][1] = (f32x4){bflo(q.z), bfhi(q.z), bflo(q.w), bfhi(q.w)}; } } }
    if (F.wave == 7) { const float* AB = (const float*)(F.ws + WS_AB); R.ab_a = AB[(size_t)(row0 + F.lane) * 16 + h]; R.ab_b = AB[(size_t)(row0 + F.lane) * 16 + 8 + h]; }
}
__device__ __forceinline__ void gdn_prep_item(Frame& F, int ch, PrepRaw& R, int next_ch, const float* cwbase, float Ah, float dtb, const PrepW& W) {
    asm volatile("" : "+v"(F.tid), "+v"(F.lane));
    const int tid = F.tid, lane = F.lane, wave = F.wave;
    const bool meta = ch >= NCHR; const int h = ch & 7, bc = ch >> 3, b = bc >> 5, c = bc & 31;
    const int row0 = meta ? XM : b * SEQ + c * 64;
    LAS float* qf = (LAS float*)F.lds; LAS float* kf = qf + 64 * TS; LAS float* vf = kf + 64 * TS; LAS float* gcs = vf + 64 * TS; LAS float* bes = gcs + 64;
    GAS unsigned char* srec = F.ws + WS_SREC + (size_t)ch * SREC;
    const bf16* QKVZ = (const bf16*)(F.ws + WS_QKVZ);
    if (!meta) {
#pragma unroll
        for (int k = 0; k < 6; ++k) { const int uu = tid + 512 * k, tok = uu / 48, cg = uu - tok * 48, col0 = cg * 8, part = col0 >> 7, cc = col0 & 127;
            if (k == 0 && tid < 144) continue;
            const v4u q = R.x[k]; LAS float* tile = (part == 0 ? qf : (part == 1 ? kf : vf)) + tok * TS + cc;
            *(LAS f32x4*)tile = (f32x4){bflo(q.x), bfhi(q.x), bflo(q.y), bfhi(q.y)}; *(LAS f32x4*)(tile + 4) = (f32x4){bflo(q.z), bfhi(q.z), bflo(q.w), bfhi(q.w)}; }
        if (tid < 144) { const int tok = tid / 48, cg = tid - tok * 48, col0 = cg * 8, part = col0 >> 7, cc = col0 & 127;
            float acc8[8];
#pragma unroll
            for (int e = 0; e < 8; ++e) acc8[e] = 0.f;
#pragma unroll
            for (int j = 0; j < 4; ++j) { const float wj[8] = {W.w[j][0].x, W.w[j][0].y, W.w[j][0].z, W.w[j][0].w, W.w[j][1].x, W.w[j][1].y, W.w[j][1].z, W.w[j][1].w};
                const float xr[8] = {R.fx[j][0].x, R.fx[j][0].y, R.fx[j][0].z, R.fx[j][0].w, R.fx[j][1].x, R.fx[j][1].y, R.fx[j][1].z, R.fx[j][1].w};
#pragma unroll
                for (int e = 0; e < 8; ++e) acc8[e] += wj[e] * xr[e]; }
            LAS float* tile = (part == 0 ? qf : (part == 1 ? kf : vf)) + tok * TS + cc;
            *(LAS f32x4*)tile = (f32x4){siluf(acc8[0]), siluf(acc8[1]), siluf(acc8[2]), siluf(acc8[3])}; *(LAS f32x4*)(tile + 4) = (f32x4){siluf(acc8[4]), siluf(acc8[5]), siluf(acc8[6]), siluf(acc8[7])}; }
    } else if (tid < 384) {
        const int cg = tid % 48, tg = tid / 48, col0 = cg * 8, part = col0 >> 7, cc = col0 & 127, gcol = part * 1024 + h * 128 + cc;
        const float* cw = cwbase + gcol;
        float w[4][8];
#pragma unroll
        for (int j = 0; j < 4; ++j) ld8f(cw + j * GQKV, w[j]);
        float x[11][8];
#pragma unroll
        for (int r = 0; r < 11; ++r) { const int tt = 8 * tg - 3 + r; const bool ok = tt >= 0 && tt < NMETA; const float m_ = ok ? 1.f : 0.f;
            ld8(QKVZ + (size_t)(ok ? XM + tt : XM) * 4096 + gcol, x[r]);
#pragma unroll
            for (int e = 0; e < 8; ++e) x[r][e] *= m_; }
        LAS float* tile = part == 0 ? qf : (part == 1 ? kf : vf);
#pragma unroll
        for (int t = 0; t < 8; ++t) { const int tok = 8 * tg + t; float o[8];
#pragma unroll
            for (int e = 0; e < 8; ++e) { const float a = (w[0][e] * x[t][e] + w[1][e] * x[t + 1][e]) + (w[2][e] * x[t + 2][e] + w[3][e] * x[t + 3][e]); o[e] = tok >= NMETA ? 0.f : siluf(a); }
            *(LAS f32x4*)(tile + tok * TS + cc) = (f32x4){o[0], o[1], o[2], o[3]}; *(LAS f32x4*)(tile + tok * TS + cc + 4) = (f32x4){o[4], o[5], o[6], o[7]}; }
    }
    const float ab_a = R.ab_a, ab_b = R.ab_b;
    asm volatile("" ::: "memory"); gdn_prep_load(F, next_ch, R);
    if (wave == 7) {
        const bool nul = meta && lane >= NMETA; float a = ab_a, bb = ab_b;
        if (meta) { const float* AB = (const float*)(F.ws + WS_AB); const int row = nul ? XM : row0 + lane; a = AB[(size_t)row * 16 + h]; bb = AB[(size_t)row * 16 + 8 + h]; }
        const float x = a + dtb, sp = x > 20.f ? x : log1pf(__expf(x)); float g = nul ? 0.f : -Ah * sp;
#pragma unroll
        for (int o = 1; o < 64; o <<= 1) { const float t = __shfl_up(g, o); if (lane >= o) g += t; }
        gcs[lane] = g; bes[lane] = nul ? 0.f : 1.f / (1.f + __expf(-bb));
    }
    __syncthreads();
#ifndef PR2
#define PR2 1
#define PR3 1
#define PR4 1
#endif
    _Pragma("unroll 1") for (int pr2 = 0; pr2 < PR2; ++pr2)
#pragma unroll 8
    for (int v = wave * 16; v < wave * 16 + 16; ++v) { const int tok = v >> 1, isk = v & 1; LAS float* p = (isk ? kf : qf) + tok * TS; const float x0 = p[lane], x1 = p[lane + 64];
        const float ss = wave_sum(x0 * x0 + x1 * x1); const float r = rsqrtf(ss + EPS) * (isk ? 1.f : 0.08838834764831845f); p[lane] = x0 * r; p[lane + 64] = x1 * r; }
    __syncthreads();
    const int r16 = lane & 15, g = lane >> 4;
#pragma unroll 2
    for (int jj = wave; jj < 32 * PR3; jj += 8) {
        const bool isA = (jj & 31) < 16; const int ta = (jj >> 2) & 3, tb = jj & 3;
        const bool live = isA ? (tb <= ta) : (tb >= ta);
        f32x4 acc = {0.f, 0.f, 0.f, 0.f};
        if (live) {
            const LAS float* pa = kf + (16 * ta + r16) * TS + 8 * g; const LAS float* pb = (isA ? kf : qf) + (16 * tb + r16) * TS + 8 * g;
#pragma unroll
            for (int ks = 0; ks < 4; ++ks) { const bf16x8 fa = pack8f(*(const LAS f32x4*)(pa + 32 * ks), *(const LAS f32x4*)(pa + 32 * ks + 4)), fb = pack8f(*(const LAS f32x4*)(pb + 32 * ks), *(const LAS f32x4*)(pb + 32 * ks + 4));
                acc = mfma16(fa, fb, acc); }
        }
        if (isA) { if (live) { float* GA = (float*)(F.ws + WS_GA) + (size_t)ch * 4096; const int j = 16 * tb + r16; const float gj = gcs[j];
#pragma unroll
                for (int r = 0; r < 4; ++r) { const int i = 16 * ta + 4 * g + r; GA[i * 64 + j] = i > j ? bes[i] * __expf(gcs[i] - gj) * acc[r] : 0.f; } } }
        else { const int i = 16 * tb + r16; const float gi = gcs[i]; float v[4];
#pragma unroll
            for (int r = 0; r < 4; ++r) { const int j = 16 * ta + 4 * g + r; v[r] = (live && i >= j) ? __expf(gi - gcs[j]) * acc[r] : 0.f; }
            *(v2u*)(srec + SR_AT + ((tb * 2 + (ta >> 1)) * 64 + lane) * 16 + 8 * (ta & 1)) = (v2u){cvtpk(v[0], v[1]), cvtpk(v[2], v[3])}; }
    }
    const float glast = gcs[63];
#pragma unroll 4
    for (int q_ = 0; q_ < 8 * PR4; ++q_) { const int q = q_ & 7;
        const int which = q >> 1, f = (q & 1) * 8 + wave; float v[8];
        if (which == 0) { const int t = f >> 2, ks = f & 3, tok = 16 * t + r16; const float sc = __expf(gcs[tok]); const LAS float* p = qf + tok * TS + 32 * ks + 4 * g;
            const f32x4 a = *(const LAS f32x4*)p, bq = *(const LAS f32x4*)(p + 16);
            *(bf16x8*)(srec + SR_Q + (f * 64 + lane) * 16) = pack8f(a * sc, bq * sc); }
        else if (which == 1) { const int mt = f >> 1, ks = f & 1, dk = 16 * mt + r16;
#pragma unroll
            for (int e = 0; e < 8; ++e) { const int tok = 32 * ks + 16 * (e >> 2) + 4 * g + (e & 3); v[e] = kf[tok * TS + dk] * __expf(glast - gcs[tok]); }
            *(bf16x8*)(srec + SR_KT + (f * 64 + lane) * 16) = pack8f((f32x4){v[0], v[1], v[2], v[3]}, (f32x4){v[4], v[5], v[6], v[7]}); }
        else { const int nt = f >> 1, ks = f & 1, col = 16 * nt + r16; const LAS float* tile = which == 2 ? vf : kf;
#pragma unroll
            for (int e = 0; e < 8; ++e) { const int tok = 32 * ks + 8 * g + e; v[e] = tile[tok * TS + col] * bes[tok] * (which == 2 ? 1.f : __expf(gcs[tok])); }
            *(bf16x8*)(F.ws + (which == 2 ? WS_GRV : WS_GRK) + (size_t)ch * 16384 + (f * 64 + lane) * 16) = pack8f((f32x4){v[0], v[1], v[2], v[3]}, (f32x4){v[4], v[5], v[6], v[7]}); }
    }
    if (tid == 0) ((float*)(F.ws + WS_GEG))[ch] = __expf(glast);
    __syncthreads();
}

template <bool META> __device__ __forceinline__ void gdn_solve_item(Frame& F, int ch) {
    const int lane = F.lane, r16 = lane & 15, g = lane >> 4;
    LAS float* As = (LAS float*)F.lds + F.wave * 4096;
    { const f32x4* ga = (const f32x4*)((const float*)(F.ws + WS_GA) + (size_t)ch * 4096); f32x4 gr[16];
#pragma unroll
      for (int it = 0; it < 16; ++it) { const int e = it * 64 + lane; gr[it] = ga[((e & 15) < ((e >> 8) + 1) * 4) ? e : lane]; }
#pragma unroll
      for (int it = 0; it < 16; ++it) ((LAS f32x4*)As)[it * 64 + lane] = gr[it]; }
    LDS_WAIT();
    float x[64];
    x[0] = (lane == 0) ? 1.f : 0.f;
#pragma unroll
    for (int i = NMETA; i < 64; ++i) x[i] = (lane == i) ? 1.f : 0.f;
#pragma unroll
    for (int i = 1; i < (META ? NMETA : 64); ++i) {
        f32x4 av[16];
#pragma unroll
        for (int j4 = 0; j4 < (i + 3) / 4; ++j4) av[j4] = *(const LAS f32x4*)(As + i * 64 + 4 * j4);
        __builtin_amdgcn_sched_barrier(0);
        float a0 = (lane == i) ? 1.f : 0.f, a1 = 0.f, a2 = 0.f, a3 = 0.f;
#pragma unroll
        for (int j4 = 0; j4 < (i + 3) / 4; ++j4) {
            if (4 * j4 + 0 < i) a0 -= av[j4].x * x[4 * j4 + 0]; if (4 * j4 + 1 < i) a1 -= av[j4].y * x[4 * j4 + 1]; if (4 * j4 + 2 < i) a2 -= av[j4].z * x[4 * j4 + 2]; if (4 * j4 + 3 < i) a3 -= av[j4].w * x[4 * j4 + 3]; }
        x[i] = (a0 + a1) + (a2 + a3);
        __builtin_amdgcn_sched_barrier(0);
    }
    LDS_WAIT();
#pragma unroll
    for (int i = 0; i < 64; ++i) As[i * 64 + lane] = x[i];
    LDS_WAIT();
    bf16x8 Tf[4][2];
#pragma unroll
    for (int t = 0; t < 4; ++t)
#pragma unroll
        for (int ks = 0; ks < 2; ++ks) { const LAS float* p = As + (16 * t + r16) * 64 + 32 * ks + 8 * g; Tf[t][ks] = pack8f(*(const LAS f32x4*)p, *(const LAS f32x4*)(p + 4)); }
    const GAS unsigned char* grv = F.ws + WS_GRV + (size_t)ch * 16384; const GAS unsigned char* grk = F.ws + WS_GRK + (size_t)ch * 16384;
    GAS unsigned char* gu = F.ws + WS_GU + (size_t)ch * 16384; GAS unsigned char* gw = F.ws + WS_SREC + (size_t)ch * SREC + SR_W;
#pragma unroll 4
    for (int nt = 0; nt < 8; ++nt) { const bf16x8 b0 = *(const bf16x8*)(grv + ((nt * 2) * 64 + lane) * 16), b1 = *(const bf16x8*)(grv + ((nt * 2 + 1) * 64 + lane) * 16);
#pragma unroll
        for (int t = 0; t < 4; ++t) { f32x4 acc = {0.f, 0.f, 0.f, 0.f}; acc = mfma16(Tf[t][0], b0, acc); acc = mfma16(Tf[t][1], b1, acc);
            *(v2u*)(gu + ((nt * 4 + t) * 64 + lane) * 8) = (v2u){cvtpk(acc[0], acc[1]), cvtpk(acc[2], acc[3])}; } }
#pragma unroll 4
    for (int mt = 0; mt < 8; ++mt) { const bf16x8 a0 = *(const bf16x8*)(grk + ((mt * 2) * 64 + lane) * 16), a1 = *(const bf16x8*)(grk + ((mt * 2 + 1) * 64 + lane) * 16);
#pragma unroll
        for (int t = 0; t < 4; ++t) { f32x4 acc = {0.f, 0.f, 0.f, 0.f}; acc = mfma16(a0, Tf[t][0], acc); acc = mfma16(a1, Tf[t][1], acc);
            *(v2u*)(gw + ((t * 4 + (mt >> 1)) * 64 + lane) * 16 + 8 * (mt & 1)) = (v2u){cvtpk(-acc[0], -acc[1]), cvtpk(-acc[2], -acc[3])}; } }
}

__device__ __forceinline__ void gdn_scan_item(Frame& F, int item) {
    const int lane = F.lane, wave = F.wave, g = lane >> 4, c16 = lane & 15;
    const int half = item & 1, h = (item >> 1) & 7, b = item >> 4;
    const bool comp = wave < 4; const int cs0 = half * 64 + (wave & 3) * 16, ntu = cs0 >> 4;
    bf16* OB = (bf16*)(F.ws + WS_TMP); const float* GEG = (const float*)(F.ws + WS_GEG);
    LAS unsigned char* lds = F.lds;
#define SCAN_CH(n) ((n) == 0 ? NCHR + h : (b * 32 + (n) - 1) * 8 + h)
#define SCAN_DMA(n) do { const GAS unsigned char* src_ = F.ws + WS_SREC + (size_t)SCAN_CH(n) * SREC + lane * 16; LAS unsigned char* dst_ = lds + ((n) & 1) * SREC; \
        _Pragma("unroll") for (int i_ = 0; i_ < 7; ++i_) { const int p_ = i_ * 8 + wave; __builtin_amdgcn_global_load_lds((const unsigned*)(src_ + p_ * 1024), (LAS unsigned*)(dst_ + p_ * 1024), 16, 0, 0); } } while (0)
#define SCAN_U(n, dst) do { const GAS unsigned char* gu_ = F.ws + WS_GU + (size_t)SCAN_CH(n) * 16384; _Pragma("unroll") for (int t_ = 0; t_ < 4; ++t_) dst[t_] = *(const v2u*)(gu_ + ((ntu * 4 + t_) * 64 + lane) * 8); } while (0)
    f32x4 S[8];
#pragma unroll
    for (int m = 0; m < 8; ++m) S[m] = (f32x4){0.f, 0.f, 0.f, 0.f};
    v2u un[4] = {};
    SCAN_DMA(0); if (comp) SCAN_U(0, un);
#pragma unroll 1
    for (int n = 0; n <= 32; ++n) {
        VM_WAIT(); __syncthreads();
        v2u uc[4];
#pragma unroll
        for (int t = 0; t < 4; ++t) uc[t] = un[t];
        if (n < 32) { SCAN_DMA(n + 1); if (comp) SCAN_U(n + 1, un); }
        if (comp) {
            const LAS unsigned char* buf = lds + (n & 1) * SREC + lane * 16;
            const float eg = GEG[SCAN_CH(n)];
            bf16x8 Sb[4];
#pragma unroll
            for (int ks = 0; ks < 4; ++ks) Sb[ks] = pack8f(S[2 * ks], S[2 * ks + 1]);
            f32x4 av[4], ao[4];
#pragma unroll
            for (int t = 0; t < 4; ++t) { av[t] = (f32x4){bflo(uc[t].x), bfhi(uc[t].x), bflo(uc[t].y), bfhi(uc[t].y)}; ao[t] = (f32x4){0.f, 0.f, 0.f, 0.f}; }
#pragma unroll
            for (int t = 0; t < 4; ++t)
#pragma unroll
                for (int ks = 0; ks < 4; ++ks) { av[t] = mfma16(*(const LAS bf16x8*)(buf + SR_W + (t * 4 + ks) * 1024), Sb[ks], av[t]); ao[t] = mfma16(*(const LAS bf16x8*)(buf + SR_Q + (t * 4 + ks) * 1024), Sb[ks], ao[t]); }
            bf16x8 vb[2];
#pragma unroll
            for (int k = 0; k < 2; ++k) vb[k] = pack8f(av[2 * k], av[2 * k + 1]);
#pragma unroll
            for (int t = 0; t < 4; ++t)
#pragma unroll
                for (int k = 0; k < 2; ++k) if (32 * k <= 16 * t + 15) ao[t] = mfma16(*(const LAS bf16x8*)(buf + SR_AT + (t * 2 + k) * 1024), vb[k], ao[t]);
            if (n == 0) { if (b == 0) {
#pragma unroll
                    for (int r = 0; r < 4; ++r) { const float v = ao[0][r], vn = DPPF(v, 0xB1); if ((c16 & 1) == 0) *(unsigned*)(OB + (size_t)(XM + 4 * g + r) * DM + h * 128 + cs0 + c16) = cvtpk(v, vn); } } }
            else { bf16* op = OB + (size_t)(b * SEQ + (n - 1) * 64 + 4 * g) * DM + h * 128 + cs0 + c16;
#pragma unroll
                for (int t = 0; t < 4; ++t)
#pragma unroll
                    for (int r = 0; r < 4; ++r) { const float v = ao[t][r], vn = DPPF(v, 0xB1); if ((c16 & 1) == 0) *(unsigned*)(op + (size_t)(16 * t + r) * DM) = cvtpk(v, vn); } }
#pragma unroll
            for (int m = 0; m < 8; ++m) { S[m] = S[m] * eg;
#pragma unroll
                for (int k = 0; k < 2; ++k) S[m] = mfma16(*(const LAS bf16x8*)(buf + SR_KT + (m * 2 + k) * 1024), vb[k], S[m]); }
        }
    }
    if (comp) { GAS float* so = F.out + O_PDS + ((size_t)(b * GH + h) * GDK + 4 * g) * GDV + cs0 + c16;
#pragma unroll
        for (int m = 0; m < 8; ++m)
#pragma unroll
            for (int r = 0; r < 4; ++r) so[(size_t)(16 * m + r) * GDV] = S[m][r]; }
    __syncthreads();
#undef SCAN_CH
#undef SCAN_DMA
#undef SCAN_U
}

template <bool OUT_BF16> __device__ __forceinline__ void mini_gemm(Frame& F, const bf16* A, const bf16* Bt, int N, int K, void* out, int ldo) {
    const int lane = F.lane, c16 = lane & 15, g = lane >> 4, gw = F.wave * F.G + F.bid, NGW = F.G * 8;
    const int nct = N / 16;
#pragma unroll 1
    for (int task = gw; task < nct * 3; task += NGW) {
        const int ct = task % nct, rg = task / nct;
        const bf16* b0 = Bt + (size_t)(16 * ct + c16) * K + 8 * g; const bf16* a0 = A + (size_t)(TR + 48 * rg + c16) * K + 8 * g;
        f32x4 acc[3];
#pragma unroll
        for (int rt = 0; rt < 3; ++rt) acc[rt] = (f32x4){0.f, 0.f, 0.f, 0.f};
#define MG_LOAD(BF, AF, kk) do { _Pragma("unroll") for (int q = 0; q < 4; ++q) { BF[q] = *(const bf16x8*)(b0 + (kk) + 32 * q); \
            _Pragma("unroll") for (int rt = 0; rt < 3; ++rt) AF[q][rt] = *(const bf16x8*)(a0 + (size_t)(16 * rt) * K + (kk) + 32 * q); } } while (0)
#define MG_MMA(BF, AF) do { _Pragma("unroll") for (int q = 0; q < 4; ++q) { _Pragma("unroll") for (int rt = 0; rt < 3; ++rt) acc[rt] = mfma16(BF[q], AF[q][rt], acc[rt]); } } while (0)
        bf16x8 bfA[4], afA[4][3], bfB[4], afB[4][3];
        MG_LOAD(bfA, afA, 0);
#pragma unroll 1
        for (int k = 0; k < K; k += 256) {
            const bool hasB = k + 128 < K, hasA2 = k + 256 < K;
            if (hasB) MG_LOAD(bfB, afB, k + 128);
            __builtin_amdgcn_sched_barrier(0);
            MG_MMA(bfA, afA);
            __builtin_amdgcn_sched_barrier(0);
            if (hasA2) MG_LOAD(bfA, afA, k + 256);
            __builtin_amdgcn_sched_barrier(0);
            if (hasB) MG_MMA(bfB, afB);
            __builtin_amdgcn_sched_barrier(0);
        }
#undef MG_LOAD
#undef MG_MMA
#pragma unroll
        for (int rt = 0; rt < 3; ++rt) { const size_t o = (size_t)(48 * rg + 16 * rt + c16) * ldo + 16 * ct + 4 * g;
            if (OUT_BF16) *(v2u*)((bf16*)out + o) = (v2u){cvtpk(acc[rt][0], acc[rt][1]), cvtpk(acc[rt][2], acc[rt][3])};
            else *(f32x4*)((float*)out + o) = acc[rt]; }
    }
}

template <bool OUT_BF16> __device__ __forceinline__ void mini_gemm_deep(Frame& F, const bf16* A, const bf16* Bt, int N, int K, void* out, int ldo) {
    const int lane = F.lane, c16 = lane & 15, g = lane >> 4, gw = F.wave * F.G + F.bid, NGW = F.G * 8;
    const int nct = N / 16, nb = K / 128;
#pragma unroll 1
    for (int task = gw; task < nct * 9; task += NGW) {
        const int ct = task % nct, rt9 = task / nct;
        const bf16* b0 = Bt + (size_t)(16 * ct + c16) * K + 8 * g; const bf16* a0 = A + (size_t)(TR + 16 * rt9 + c16) * K + 8 * g;
        f32x4 acc = {0.f, 0.f, 0.f, 0.f};
        bf16x8 bq[4][4], aq[4][4];
#define MD_LOAD(i, kk) do { _Pragma("unroll") for (int q = 0; q < 4; ++q) { bq[i][q] = *(const bf16x8*)(b0 + (kk) + 32 * q); aq[i][q] = *(const bf16x8*)(a0 + (kk) + 32 * q); } } while (0)
#pragma unroll
        for (int i = 0; i < 4; ++i) MD_LOAD(i, 128 * i);
#pragma unroll 1
        for (int kb = 0; kb < nb; kb += 4) {
#pragma unroll
            for (int i = 0; i < 4; ++i) {
                if (kb + i < nb) {
#pragma unroll
                    for (int q = 0; q < 4; ++q) acc = mfma16(bq[i][q], aq[i][q], acc);
                    __builtin_amdgcn_sched_barrier(0);
                    if (kb + i + 4 < nb) MD_LOAD(i, 128 * (kb + i + 4));
                    __builtin_amdgcn_sched_barrier(0);
                }
            }
        }
#undef MD_LOAD
        const size_t o = (size_t)(16 * rt9 + c16) * ldo + 16 * ct + 4 * g;
        if (OUT_BF16) *(v2u*)((bf16*)out + o) = (v2u){cvtpk(acc[0], acc[1]), cvtpk(acc[2], acc[3])};
        else *(f32x4*)((float*)out + o) = acc;
    }
}

constexpr int NPHASE = 24;
__global__ void __launch_bounds__(512, 2) mk_fwd(Params P) {
    extern __shared__ __attribute__((aligned(16))) unsigned char lds_raw[];
    Frame F;
    F.lds = (LAS unsigned char*)lds_raw; F.tid = threadIdx.x; F.lane = F.tid & 63; F.wave = __builtin_amdgcn_readfirstlane(F.tid >> 6);
    F.G = gridDim.x; F.bid = blockIdx.x; F.in.t = (const LAS unsigned*)(F.lds + INTAB_OFF); F.out = (GAS float*)P.out; F.ws = (GAS unsigned char*)P.ws;
    volatile LAS unsigned* MISC = (volatile LAS unsigned*)(F.lds + MISC_OFF);
    for (int u = F.tid; u < (LDS_BYTES - CTLLDS_OFF) / 4; u += 512) ((LAS unsigned*)(F.lds + CTLLDS_OFF))[u] = 0u;
    __syncthreads();
    if (F.tid == 0) { LAS unsigned long long* tab = (LAS unsigned long long*)(F.lds + INTAB_OFF);
#pragma unroll
        for (int i = 0; i < N_IN; ++i) tab[i] = (unsigned long long)P.in[i]; }
    __syncthreads();
    const int lo = P.ph_lo, hi = P.ph_hi;
    XcdBarrier bar; bar.bar = (unsigned*)(P.ws + WS_CTL) + CW_BAR; bar.x = 0; bar.st = nullptr;
    if (hi - lo > 1) bar = xcd_barrier_post((unsigned*)(P.ws + WS_CTL) + CW_BAR, MISC + 8);
#ifndef REP_MASK
#define REP_MASK 0
#endif
#define REPN(k) ((((REP_MASK) >> (k)) & 1) + 1)
#define REP1(k) _Pragma("unroll 1") for (int r1_ = 0; r1_ < (((REP_MASK) >> (k)) & 1) + 1; ++r1_)
#define REP(k) _Pragma("unroll") for (int r_ = 0; r_ < (((REP_MASK) >> (k)) & 1) + 1; ++r_)
#define IN(k) (lo <= (k) && (k) < hi)
#define SEAM(k) do { if (IN(k) && IN((k) + 1)) { XcdBarrier b_; b_.bar = (unsigned*)(F.ws + WS_CTL) + CW_BAR; b_.x = bar.x; b_.st = (volatile LAS unsigned*)(F.lds + MISC_OFF) + 8; xcd_barrier(b_); } asm volatile("" : "+v"(F.tid), "+v"(F.lane)); asm volatile("" : "+s"(F.ws), "+s"(F.out)); ws = F.ws; } while (0)
    GAS unsigned char* ws = F.ws;
#define XH ((bf16*)(ws + WS_XH))
#define TMP ((float*)(ws + WS_TMP))

    if (IN(0)) REP(0) { p0_prologue(F, P); } SEAM(0);
    if (IN(1)) { pg8::Gemm g{XH, (const bf16*)(ws + WS_WIN), TR, 4096, DM}; pg8::StaticOrder S; S.init(TR, 4096, F.G, F.bid, REPN(1)); pg8::EpiInConv E{(bf16*)(ws + WS_QKVZ), (float*)(ws + WS_RAWQ), F.in[I_ACONV]};
        _Pragma("unroll 1") for (int pass_ = 0; pass_ < 2; ++pass_) { asm volatile("" : "+v"(F.tid), "+v"(F.lane));
            if (pass_ == ((F.bid >> 3) & 1)) pg8::gemm_phase<pg8::EpiInConv, pg8::StaticOrder, true, true>(F.lds, g, S, E);
            else mini_gemm<true>(F, XH, (const bf16*)(ws + WS_WIN), 4096, DM, (bf16*)(ws + WS_QKVZ) + (size_t)TR * 4096, 4096); } } SEAM(1);
    if (IN(2)) {
        REP1(2) { PrepRaw R; gdn_prep_load(F, F.bid, R); const int h_ = F.bid & 7; const float* cwbase = F.in[I_ACONV]; const float Ah = __expf(F.in[I_ALOG][h_]), dtb = F.in[I_ADT][h_];
          PrepW W; { const int t_ = F.tid < 144 ? F.tid : 0, cg = t_ % 48, col0 = cg * 8, gcol = (col0 >> 7) * 1024 + h_ * 128 + (col0 & 127);
#pragma unroll
            for (int j = 0; j < 4; ++j) { W.w[j][0] = *(const f32x4*)(cwbase + j * GQKV + gcol); W.w[j][1] = *(const f32x4*)(cwbase + j * GQKV + gcol + 4); } }
#pragma unroll 1
          for (int ch = F.bid; ch < NCH; ch += F.G) gdn_prep_item(F, ch, R, ch + F.G < NCH ? ch + F.G : ch, cwbase, Ah, dtb, W); }
        REP1(25)
#pragma unroll 1
        for (int it = F.bid; it < NS * GH; it += F.G) gdn_item(F, NB * GH + it); } SEAM(2);
    if (IN(3)) REP(3) {
#pragma unroll 1
        for (int ch = F.bid * 8 + F.wave; ch < NCHR; ch += F.G * 8) gdn_solve_item<false>(F, ch);
        { const int mw = (F.G - 1 - F.bid) * 8 + F.wave; if (mw < GH) gdn_solve_item<true>(F, NCHR + mw); } } SEAM(3);
    if (IN(4)) REP(4) {
#pragma unroll 1
        for (int it_ = F.bid; it_ < NB * GH * 2; it_ += F.G) { const int it = (F.G == 256) ? ((((it_ & 7) + 8 * (it_ >> 4)) << 1) | ((it_ >> 3) & 1)) : it_; gdn_scan_item(F, it); } } SEAM(4);
    if (IN(5)) REP(5) { p3_gate(F); } SEAM(5);
    if (IN(6)) { pg8::Gemm g{(const bf16*)(ws + WS_GO), (const bf16*)(ws + WS_WGOUT), TR, DM, DM}; pg8::StaticOrder S; S.init(TR, DM, F.G, F.bid, REPN(6)); pg8::EpiBf16 E{(bf16*)TMP, DM};
        pg8::gemm_phase<pg8::EpiBf16, pg8::StaticOrder, true, true>(F.lds, g, S, E);
        mini_gemm_deep<true>(F, (const bf16*)(ws + WS_GO), (const bf16*)(ws + WS_WGOUT), DM, DM, (bf16*)TMP + (size_t)TR * DM, DM); } SEAM(6);
    if (IN(7)) { p_postnorm<false, true>(F, F.in[I_ANPOST]); } SEAM(7);
    if (IN(8)) { pg8::Gemm g{XH, (const bf16*)(ws + WS_WUP0), TR, FF2, DM}; pg8::StaticOrder S; S.init(TR, FF2, F.G, F.bid, REPN(8)); pg8::EpiFfnAct E{(bf16*)(ws + WS_ACT), (float*)(ws + WS_RAWH), (float*)(ws + WS_RAWX), F.in[I_FCONVW] + (size_t)0 * 3 * FF2, F.in[I_FCONVB] + (size_t)0 * FF2, TR / 256};
        _Pragma("unroll 1") for (int pass_ = 0; pass_ < 2; ++pass_) { asm volatile("" : "+v"(F.tid), "+v"(F.lane));
            if (pass_ == ((F.bid >> 3) & 1)) pg8::gemm_phase<pg8::EpiFfnAct, pg8::StaticOrder, true, true>(F.lds, g, S, E);
            else mini_gemm<false>(F, XH, (const bf16*)(ws + WS_WUP0), FF2, DM, (float*)(ws + WS_RAWX), FF2); } } SEAM(8);
    if (IN(9)) REP(9) { p_ffn_fix(F, 0); } SEAM(9);
    if (IN(10)) { pg8::Gemm g{(const bf16*)(ws + WS_ACT), (const bf16*)(ws + WS_WDN0), TR, DM, FF}; pg8::StaticOrder S; S.init(TR, DM, F.G, F.bid, REPN(10)); pg8::EpiBf16 E{(bf16*)TMP, DM};
        pg8::gemm_phase<pg8::EpiBf16, pg8::StaticOrder, true, true>(F.lds, g, S, E);
        mini_gemm_deep<true>(F, (const bf16*)(ws + WS_ACT), (const bf16*)(ws + WS_WDN0), DM, FF, (bf16*)TMP + (size_t)TR * DM, DM); } SEAM(10);
    if (IN(11)) { p_postnorm<false>(F, F.in[I_FNPOST]); } SEAM(11);
    if (IN(12)) { pg8::Gemm g{XH, (const bf16*)(ws + WS_WKVQA), TR, 768, DM}; pg8::StaticOrder S; S.init(TR, 768, F.G, F.bid, REPN(12)); pg8::EpiBf16 E{(bf16*)(ws + WS_CKVQ), 768};
        pg8::gemm_phase<pg8::EpiBf16, pg8::StaticOrder, true, true>(F.lds, g, S, E);
        mini_gemm_deep<true>(F, XH, (const bf16*)(ws + WS_WKVQA), 768, DM, (bf16*)(ws + WS_CKVQ) + (size_t)TR * 768, 768); } SEAM(12);
    if (IN(13)) REP(13) { p_kvq(F); } SEAM(13);
    if (IN(14)) {
        { pg8::Gemm g{(const bf16*)(ws + WS_QAN), (const bf16*)(ws + WS_WQB), TR, 1536, QL}; pg8::StaticOrder S; S.init(TR, 1536, F.G, F.bid, REPN(14)); pg8::EpiBf16 E{(bf16*)(ws + WS_Q), 1536};
          pg8::gemm_phase<pg8::EpiBf16, pg8::StaticOrder, true, true>(F.lds, g, S, E); }
        __syncthreads();
        { pg8::Gemm g{(const bf16*)(ws + WS_CB), (const bf16*)(ws + WS_WUKV), TR, 2048, KVL}; pg8::StaticOrder S; S.init(TR, 2048, F.G, F.bid, REPN(14)); pg8::EpiBf16 E{(bf16*)(ws + WS_KNV), 2048};
          pg8::gemm_phase<pg8::EpiBf16, pg8::StaticOrder, true, true>(F.lds, g, S, E); }
        mini_gemm<true>(F, (const bf16*)(ws + WS_QAN), (const bf16*)(ws + WS_WQB), 1536, QL, (bf16*)(ws + WS_Q) + (size_t)TR * 1536, 1536);
        mini_gemm<true>(F, (const bf16*)(ws + WS_CB), (const bf16*)(ws + WS_WUKV), 2048, KVL, (bf16*)(ws + WS_KNV) + (size_t)TR * 2048, 2048);
    } SEAM(14);
    if (IN(16)) {
        if (F.bid == 0) attn_meta(F);
        volatile LAS int* qslot = (volatile LAS int*)(F.lds + MISC_OFF) + 16; unsigned* qctr = (unsigned*)(F.ws + WS_CTL) + CW_QUEUE;
#pragma unroll 1
        for (;;) {
            __syncthreads();
            if (F.tid == 0) qslot[0] = (int)__hip_atomic_fetch_add(qctr, 1u, __ATOMIC_RELAXED, __HIP_MEMORY_SCOPE_AGENT);
            __syncthreads();
            const int item = __builtin_amdgcn_readfirstlane(qslot[0]);
            if (item >= NS + NB * MH * 4) break;
            asm volatile("" : "+v"(F.tid), "+v"(F.lane));
            if (item < NS) attn_sample_item(F, item);
            else { const int L = item - NS, bh = L >> 2, x = L & 3;
#pragma unroll 1
                for (int pass = 0; pass < 2; ++pass) attn_qblock(F, bh >> 3, bh & 7, pass ? 7 - x : x); }
        }
    } SEAM(16);
    if (IN(18)) { pg8::Gemm g{(const bf16*)(ws + WS_AO), (const bf16*)(ws + WS_WMOUT), TR, DM, DM}; pg8::StaticOrder S; S.init(TR, DM, F.G, F.bid, REPN(18)); pg8::EpiBf16 E{(bf16*)TMP, DM};
        pg8::gemm_phase<pg8::EpiBf16, pg8::StaticOrder, true, true>(F.lds, g, S, E);
        mini_gemm_deep<true>(F, (const bf16*)(ws + WS_AO), (const bf16*)(ws + WS_WMOUT), DM, DM, (bf16*)TMP + (size_t)TR * DM, DM); } SEAM(18);
    if (IN(19)) { p_postnorm<false>(F, F.in[I_BNPOST]); } SEAM(19);
    if (IN(20)) { pg8::Gemm g{XH, (const bf16*)(ws + WS_WUP1), TR, FF2, DM}; pg8::StaticOrder S; S.init(TR, FF2, F.G, F.bid, REPN(20)); pg8::EpiFfnAct E{(bf16*)(ws + WS_ACT), (float*)(ws + WS_RAWH), (float*)(ws + WS_RAWX), F.in[I_FCONVW] + (size_t)1 * 3 * FF2, F.in[I_FCONVB] + (size_t)1 * FF2, TR / 256};
        _Pragma("unroll 1") for (int pass_ = 0; pass_ < 2; ++pass_) { asm volatile("" : "+v"(F.tid), "+v"(F.lane));
            if (pass_ == ((F.bid >> 3) & 1)) pg8::gemm_phase<pg8::EpiFfnAct, pg8::StaticOrder, true, true>(F.lds, g, S, E);
            else mini_gemm<false>(F, XH, (const bf16*)(ws + WS_WUP1), FF2, DM, (float*)(ws + WS_RAWX), FF2); } } SEAM(20);
    if (IN(21)) REP(21) { p_ffn_fix(F, 1); } SEAM(21);
    if (IN(22)) { pg8::Gemm g{(const bf16*)(ws + WS_ACT), (const bf16*)(ws + WS_WDN1), TR, DM, FF}; pg8::StaticOrder S; S.init(TR, DM, F.G, F.bid, REPN(22)); pg8::EpiBf16 E{(bf16*)TMP, DM};
        pg8::gemm_phase<pg8::EpiBf16, pg8::StaticOrder, true, true>(F.lds, g, S, E);
        mini_gemm_deep<true>(F, (const bf16*)(ws + WS_ACT), (const bf16*)(ws + WS_WDN1), DM, FF, (bf16*)TMP + (size_t)TR * DM, DM); } SEAM(22);
    if (IN(23)) REP(23) { p_postnorm<true>(F, F.in[I_FNPOST] + DM); }
#undef XH
#undef TMP
#undef IN
#undef SEAM
}

#ifndef MK_PER_PHASE
#define MK_PER_PHASE 0
#endif
extern "C" void kernel_launch(void* const* d_in, const int* in_sizes, int n_in, void* d_out, int out_size, void* d_ws, size_t ws_size, hipStream_t stream) {
    static int grid = 0;
    if (grid == 0) {
        if (n_in != N_IN || (size_t)out_size != O_END || ws_size < WS_END) { fprintf(stderr, "kernel_launch: unexpected shapes: n_in %d out %d ws %zu (need %zu)\n", n_in, out_size, ws_size, (size_t)WS_END); grid = -1; return; }
        int dev = 0, cus = 0, per_cu = 0;
        if (hipGetDevice(&dev) != hipSuccess || hipDeviceGetAttribute(&cus, hipDeviceAttributeMultiprocessorCount, dev) != hipSuccess) { grid = -1; return; }
        if (hipFuncSetAttribute((const void*)mk_fwd, hipFuncAttributeMaxDynamicSharedMemorySize, LDS_BYTES) != hipSuccess) { fprintf(stderr, "kernel_launch: hipFuncSetAttribute failed\n"); grid = -1; return; }
        if (hipOccupancyMaxActiveBlocksPerMultiprocessor(&per_cu, (const void*)mk_fwd, 512, LDS_BYTES) != hipSuccess || per_cu < 1) fprintf(stderr, "kernel_launch: occupancy query says %d\n", per_cu);
        (void)hipGetLastError();
        grid = cus & ~7;
    }
    if (grid < 0) return;
    (void)hipMemsetAsync((char*)d_ws + WS_CTL, 0, CTL_ZERO_BYTES, stream);
    Params P{};
    for (int i = 0; i < N_IN; ++i) P.in[i] = (const float*)d_in[i];
    P.out = (float*)d_out; P.ws = (unsigned char*)d_ws;
    unsigned char* ws = (unsigned char*)d_ws;
    const float* const* in = P.in;
    P.jobs[0] = ConvJob{in[I_AWIN], in[I_ANPRE], (bf16*)(ws + WS_WIN), DM, 4096, GIN, 0, 0, 0};
    P.jobs[1] = ConvJob{in[I_AWOUT], nullptr, (bf16*)(ws + WS_WGOUT), DM, DM, DM, 0, 0, 0};
    P.jobs[2] = ConvJob{in[I_FWUP], in[I_FNPRE], (bf16*)(ws + WS_WUP0), DM, FF2, FF2, 0, 1, 0};
    P.jobs[3] = ConvJob{in[I_FWUP] + (size_t)DM * FF2, in[I_FNPRE] + DM, (bf16*)(ws + WS_WUP1), DM, FF2, FF2, 0, 1, 0};
    P.jobs[4] = ConvJob{in[I_FWDOWN], nullptr, (bf16*)(ws + WS_WDN0), FF, DM, DM, 0, 0, 0};
    P.jobs[5] = ConvJob{in[I_FWDOWN] + (size_t)FF * DM, nullptr, (bf16*)(ws + WS_WDN1), FF, DM, DM, 0, 0, 0};
    P.jobs[6] = ConvJob{in[I_KVWA], in[I_KVNORM], (bf16*)(ws + WS_WKVQA), DM, 320, 320, 0, 0, 0};
    P.jobs[7] = ConvJob{in[I_BWQA], in[I_BNPRE], (bf16*)(ws + WS_WKVQA), DM, QL, QL, 320, 0, 0};
    P.jobs[8] = ConvJob{in[I_BWQB], nullptr, (bf16*)(ws + WS_WQB), QL, 1536, 1536, 0, 0, 0};
    P.jobs[9] = ConvJob{in[I_WUK], nullptr, (bf16*)(ws + WS_WUKV), KVL, 1024, 1024, 0, 0, 0};
    P.jobs[10] = ConvJob{in[I_WUV], nullptr, (bf16*)(ws + WS_WUKV), KVL, 1024, 1024, 1024, 0, 0};
    P.jobs[11] = ConvJob{in[I_BWOUT], nullptr, (bf16*)(ws + WS_WMOUT), DM, DM, DM, 0, 0, 0};
#if MK_PER_PHASE
    for (int ph = 0; ph < NPHASE; ++ph) { P.ph_lo = ph; P.ph_hi = ph + 1; hipLaunchKernelGGL(mk_fwd, dim3(grid), dim3(512), LDS_BYTES, stream, P); }
#else
    P.ph_lo = 0; P.ph_hi = NPHASE; hipLaunchKernelGGL(mk_fwd, dim3(grid), dim3(512), LDS_BYTES, stream, P);
#endif
    const hipError_t le = hipPeekAtLastError();
    if (le != hipSuccess) fprintf(stderr, "kernel_launch: launch failed: %s\n", hipGetErrorName(le));
}
```
